# Optimizing an MI355X kernel written in HIP

```python
import jax, jax.numpy as jnp
from jax import lax
import numpy as np

D_MODEL = 1024
BATCH = 16
SEQ = 2048
DEPTH = 1

HEAD_DIM = 64
N_HEADS_NA = 8
N_HEADS_DIL = 8
D_NA = N_HEADS_NA * HEAD_DIM
D_DIL = N_HEADS_DIL * HEAD_DIM
D_MIX = D_NA + D_DIL
GRID_W = 64
NA_ROWS_MAX = 8
NA_COLS = 16
DIL_CONFIGS = ((128, 1), (512, 4), (2048, 16))
Q_BLOCK = 128
PEER_HEADS = 8
PEER_NKEYS = 128
PEER_N = PEER_NKEYS * PEER_NKEYS
PEER_DKEY = 256
PEER_TOPK = 16
PEER_TOKEN_BLOCK = 128
EPS = 1e-6

kernel_name = "hybrid_na_dilated_peer_block"


def rmsnorm(x, g):
    xf = x.astype(jnp.float32)
    y = xf * lax.rsqrt(jnp.mean(xf * xf, axis=-1, keepdims=True) + EPS)
    return (y * g.astype(jnp.float32)).astype(x.dtype)


def alibi_slopes(n):
    return (2.0 ** (-8.0 * (np.arange(n) + 1) / n)).astype(np.float32)


def na_index(seq):
    rows = seq // GRID_W
    wr = min(NA_ROWS_MAX, rows)
    t = np.arange(seq)
    r, c = t // GRID_W, t % GRID_W
    r0 = np.clip(r - wr // 2, 0, rows - wr)
    c0 = np.clip(c - NA_COLS // 2, 0, GRID_W - NA_COLS)
    kr = r0[:, None, None] + np.arange(wr)[None, :, None]
    kc = c0[:, None, None] + np.arange(NA_COLS)[None, None, :]
    shape = (seq, wr, NA_COLS)
    idx = np.broadcast_to(kr * GRID_W + kc, shape).reshape(seq, -1)
    dr = np.broadcast_to(kr - r[:, None, None] + NA_ROWS_MAX - 1, shape).reshape(seq, -1)
    dc = np.broadcast_to(kc - c[:, None, None] + NA_COLS - 1, shape).reshape(seq, -1)
    return idx.astype(np.int32), dr.astype(np.int32), dc.astype(np.int32)


def dilated_index(seq, window, dilation):
    half = window // (2 * dilation)
    off = dilation * np.arange(-half, half + 1)
    pos = np.arange(seq)[:, None] + off[None, :]
    valid = (pos >= 0) & (pos < seq)
    idx = np.clip(pos, 0, seq - 1).astype(np.int32)
    return idx, valid, np.abs(off).astype(np.float32)


def gathered_attention(q, k, v, idx, bias, valid):
    B, H, S, hd = q.shape
    nblk = S // Q_BLOCK
    K = idx.shape[-1]
    scale = hd ** -0.5
    q_blocks = jnp.moveaxis(q.reshape(B, H, nblk, Q_BLOCK, hd), 2, 0)
    idx_blocks = idx.reshape(nblk, Q_BLOCK, K)
    bias_blocks = jnp.moveaxis(bias.reshape(H, nblk, Q_BLOCK, K), 1, 0)
    valid_blocks = valid.reshape(nblk, Q_BLOCK, K)

    def block(args):
        qb, ib, bb, mb = args
        kg = jnp.take(k, ib, axis=2)
        vg = jnp.take(v, ib, axis=2)
        s = jnp.einsum('bhqd,bhqkd->bhqk', qb, kg, preferred_element_type=jnp.float32) * scale + bb
        s = jnp.where(mb, s, -jnp.inf)
        lse = jax.nn.logsumexp(s, axis=-1)
        p = jnp.exp(s - lse[..., None])
        o = jnp.einsum('bhqk,bhqkd->bhqd', p.astype(v.dtype), vg)
        return o, lse

    o, lse = lax.map(block, (q_blocks, idx_blocks, bias_blocks, valid_blocks))
    o = jnp.moveaxis(o, 0, 2).reshape(B, H, S, hd)
    lse = jnp.moveaxis(lse, 0, 2).reshape(B, H, S)
    return o, lse


def peer(h, wq, subkeys, u_tab, v_tab):
    B, S, D = h.shape
    T = B * S
    hf = h.reshape(T, D)
    q = (hf @ wq).reshape(T, PEER_HEADS, 2, PEER_DKEY // 2)
    sc = jnp.einsum('thpd,pnd->thpn', q, subkeys, preferred_element_type=jnp.float32)
    top_v, top_i = lax.top_k(sc, PEER_TOPK)
    cand_v = (top_v[:, :, 0, :, None] + top_v[:, :, 1, None, :]).reshape(T, PEER_HEADS, -1)
    cand_id = (top_i[:, :, 0, :, None] * PEER_NKEYS + top_i[:, :, 1, None, :]).reshape(T, PEER_HEADS, -1)
    best_v, best_j = lax.top_k(cand_v, PEER_TOPK)
    ids = jnp.take_along_axis(cand_id, best_j, axis=-1)
    gates = jax.nn.softmax(best_v, axis=-1)
    E = PEER_HEADS * PEER_TOPK
    nblk = T // PEER_TOKEN_BLOCK
    x_blocks = hf.reshape(nblk, PEER_TOKEN_BLOCK, D)
    id_blocks = ids.reshape(nblk, PEER_TOKEN_BLOCK, E)
    g_blocks = gates.reshape(nblk, PEER_TOKEN_BLOCK, E)

    def block(args):
        xb, ib, gb = args
        ub = jnp.take(u_tab, ib, axis=0)
        a = jnp.einsum('td,ted->te', xb, ub, preferred_element_type=jnp.float32)
        w = gb * jax.nn.gelu(a, approximate=False)
        vb = jnp.take(v_tab, ib, axis=0)
        return jnp.einsum('te,ted->td', w.astype(vb.dtype), vb)

    y = lax.map(block, (x_blocks, id_blocks, g_blocks))
    return y.reshape(B, S, D)


def setup_inputs(seed: int = 0) -> dict:
    key = jax.random.key(seed)
    ks = jax.random.split(key, 16)
    f32 = jnp.float32
    L, D = DEPTH, D_MODEL

    def nrm(k, shape, std):
        return jax.random.normal(k, shape, f32) * std

    return {
        "x": nrm(ks[0], (BATCH, SEQ, D), 1.0),
        "c": nrm(ks[1], (BATCH, D), 1.0),
        "ada_w": nrm(ks[2], (L, D, 6 * D), 0.5 * D ** -0.5),
        "ada_b": nrm(ks[3], (L, 6 * D), 0.01),
        "norm1_g": 1.0 + nrm(ks[4], (L, D), 0.02),
        "w_in": nrm(ks[5], (L, D, 3 * D_MIX), D ** -0.5),
        "na_rpb": nrm(ks[6], (L, N_HEADS_NA, 2 * NA_ROWS_MAX - 1, 2 * NA_COLS - 1), 0.1),
        "out_norm_na_g": 1.0 + nrm(ks[7], (L, D_NA), 0.02),
        "out_norm_dil_g": 1.0 + nrm(ks[8], (L, D_DIL), 0.02),
        "w_out": nrm(ks[9], (L, D_MIX, D), D_MIX ** -0.5),
        "norm2_g": 1.0 + nrm(ks[10], (L, D), 0.02),
        "peer_wq": nrm(ks[11], (L, D, PEER_HEADS * PEER_DKEY), D ** -0.5),
        "peer_subkeys": nrm(ks[12], (L, 2, PEER_NKEYS, PEER_DKEY // 2), (PEER_DKEY // 2) ** -0.5),
        "peer_u": nrm(ks[13], (L, PEER_N, D), D ** -0.5),
        "peer_v": nrm(ks[14], (L, PEER_N, D), 1.0),
        "final_g": 1.0 + nrm(ks[15], (D,), 0.02),
    }


def reference(x, c, ada_w, ada_b, norm1_g, w_in, na_rpb, out_norm_na_g, out_norm_dil_g,
              w_out, norm2_g, peer_wq, peer_subkeys, peer_u, peer_v, final_g):
    B, S, D = x.shape

    na_idx_np, na_dr, na_dc = na_index(S)
    na_idx = jnp.asarray(na_idx_np)
    na_valid = jnp.ones(na_idx_np.shape, dtype=bool)
    slopes = alibi_slopes(N_HEADS_DIL)
    dil_tables = []
    for (window, dilation) in DIL_CONFIGS:
        idx_np, valid_np, dist = dilated_index(S, window, dilation)
        bias = np.broadcast_to((-slopes[:, None] * dist[None, :])[:, None, :],
                               (N_HEADS_DIL, S, idx_np.shape[1]))
        dil_tables.append((jnp.asarray(idx_np), jnp.asarray(np.ascontiguousarray(bias)), jnp.asarray(valid_np)))

    def heads(t, n):
        return t.reshape(B, S, n, HEAD_DIM).transpose(0, 2, 1, 3)

    def merge(t):
        return t.transpose(0, 2, 1, 3).reshape(B, S, -1)

    for l in range(DEPTH):
        mod = jax.nn.silu(c) @ ada_w[l] + ada_b[l]
        sh1, sc1, g1, sh2, sc2, g2 = jnp.split(mod[:, None, :], 6, axis=-1)

        h = rmsnorm(x, norm1_g[l]) * (1.0 + sc1) + sh1
        proj = h @ w_in[l]
        qa, ka, va, qd, kd, vd = jnp.split(
            proj, [D_NA, 2 * D_NA, 3 * D_NA, 3 * D_NA + D_DIL, 3 * D_NA + 2 * D_DIL], axis=-1)

        na_bias = na_rpb[l][:, na_dr, na_dc].astype(jnp.float32)
        o_na, _ = gathered_attention(heads(qa, N_HEADS_NA), heads(ka, N_HEADS_NA),
                                     heads(va, N_HEADS_NA), na_idx, na_bias, na_valid)

        qdh, kdh, vdh = heads(qd, N_HEADS_DIL), heads(kd, N_HEADS_DIL), heads(vd, N_HEADS_DIL)
        outs, lses = [], []
        for (idx_d, bias_d, valid_d) in dil_tables:
            o_i, lse_i = gathered_attention(qdh, kdh, vdh, idx_d, bias_d, valid_d)
            outs.append(o_i.astype(jnp.float32))
            lses.append(lse_i)
        alpha = jax.nn.softmax(jnp.stack(lses, 0), axis=0)
        o_dil = jnp.einsum('nbhs,nbhsd->bhsd', alpha, jnp.stack(outs, 0)).astype(x.dtype)

        y = jnp.concatenate([rmsnorm(merge(o_na), out_norm_na_g[l]),
                             rmsnorm(merge(o_dil), out_norm_dil_g[l])], axis=-1) @ w_out[l]
        x = x + g1 * y

        h2 = rmsnorm(x, norm2_g[l]) * (1.0 + sc2) + sh2
        x = x + g2 * peer(h2, peer_wq[l], peer_subkeys[l], peer_u[l], peer_v[l])

    return rmsnorm(x, final_g)
```

```cpp
#include <hip/hip_runtime.h>
#include <cstdio>
#include <cstdint>

#ifndef MK_COOP
#define MK_COOP 1
#endif

constexpr int DM = 1024, BATCH = 16, SEQ = 2048, TOK = BATCH * SEQ;
constexpr int NQKV = 3072, NPQ = 2048, NEXP = 16384;
constexpr float EPS = 1e-6f;
constexpr float LOG2E = 1.4426950408889634f;
constexpr float QSCALE = 0.125f * LOG2E;

constexpr size_t MiB = 1u << 20;
constexpr size_t WS_CTL = 0;
constexpr size_t WS_MOD = 1 * MiB;
constexpr size_t WS_WIN = 2 * MiB;
constexpr size_t WS_WOUT = 8 * MiB;
constexpr size_t WS_WSC = 10 * MiB;
constexpr size_t WS_SU = 14 * MiB;
constexpr size_t WS_SV = 14 * MiB + 65536;
constexpr size_t WS_UH = 16 * MiB;
constexpr size_t WS_VH = 48 * MiB;
constexpr size_t WS_H = 80 * MiB;
constexpr size_t WS_QKV = 144 * MiB;
constexpr size_t WS_ONA = 336 * MiB;
constexpr size_t WS_OD = 368 * MiB;
constexpr size_t WS_LSE = 464 * MiB;
constexpr size_t WS_IDS = 468 * MiB;
constexpr size_t WS_GATES = 484 * MiB;
constexpr size_t WS_SC = 144 * MiB;
constexpr size_t WS_PART = 144 * MiB;
constexpr size_t WS_PEER = 272 * MiB;
constexpr size_t WS_Z = 336 * MiB;
constexpr size_t WS_H8 = 400 * MiB;
constexpr size_t WS_W8 = 432 * MiB;
constexpr size_t WS_SH = 436 * MiB;
constexpr size_t WS_SW = 437 * MiB;
constexpr size_t WS_END = 500 * MiB;

constexpr int LDS_BYTES = 147456;

#define LAS __attribute__((address_space(3)))
typedef unsigned short bf16_t;
typedef short bf16x8 __attribute__((ext_vector_type(8)));
typedef float f32x4 __attribute__((ext_vector_type(4)));
typedef unsigned u32x4 __attribute__((ext_vector_type(4)));
typedef unsigned u32x2 __attribute__((ext_vector_type(2)));
typedef float f32x2_t __attribute__((ext_vector_type(2)));
typedef __bf16 bf16x2_t __attribute__((ext_vector_type(2)));
typedef _Float16 h2_t __attribute__((ext_vector_type(2)));
typedef short v4i16_t __attribute__((ext_vector_type(4)));

__device__ __forceinline__ unsigned pkbf(float lo, float hi) { f32x2_t v = {lo, hi}; bf16x2_t b = __builtin_convertvector(v, bf16x2_t); return __builtin_bit_cast(unsigned, b); }
__device__ __forceinline__ unsigned pkh(float lo, float hi) { h2_t h = {(_Float16)lo, (_Float16)hi}; return __builtin_bit_cast(unsigned, h); }
__device__ __forceinline__ float bf_lo(unsigned u) { return __uint_as_float(u << 16); }
__device__ __forceinline__ float bf_hi(unsigned u) { return __uint_as_float(u & 0xffff0000u); }
__device__ __forceinline__ float wave_sum(float v) {
#pragma unroll
    for (int o = 1; o < 64; o <<= 1) v += __shfl_xor(v, o);
    return v;
}

#define XB_TMO      128
#define XB_XCNT(j)  (256  + 64 * (j))
#define XB_XSUB(j)  (1280 + 64 * (j))
#define XB_XGEN(j)  (2304 + 64 * (j))
#define XB_TOP      3328
#define XB_TOPGEN   3392
#define XCD_BAR_WORDS 3456
#define XB_SPIN_CAP (1u << 18)

__device__ __forceinline__ unsigned xb_ld(unsigned* p)              { return __hip_atomic_load(p, __ATOMIC_RELAXED, __HIP_MEMORY_SCOPE_AGENT); }
__device__ __forceinline__ unsigned xb_add(unsigned* p, unsigned v) { return __hip_atomic_fetch_add(p, v, __ATOMIC_RELAXED, __HIP_MEMORY_SCOPE_AGENT); }
__device__ __forceinline__ unsigned xb_xcc_id() { return (unsigned)__builtin_amdgcn_s_getreg((3 << 11) | 20) & 0xFu; }
#define XB_SPIN(cond, bar) do { unsigned _sp = 0; while (cond) { __builtin_amdgcn_s_sleep(1); \
    if ((++_sp & 255u) == 0u) { if (xb_ld(&(bar)[XB_TMO])) break; if (_sp > XB_SPIN_CAP) { atomicAdd(&(bar)[XB_TMO], 1u); break; } } } } while (0)

struct XcdBarrier {
    unsigned* bar; unsigned x;
    volatile LAS unsigned* st;
};

__device__ __forceinline__ XcdBarrier xcd_barrier_post(unsigned* bar, volatile LAS unsigned* st) {
    XcdBarrier b; b.bar = bar; b.x = xb_xcc_id(); b.st = st;
    if (threadIdx.x == 0) (void)xb_add(&bar[XB_XCNT(b.x)], 1u);
    return b;
}
__device__ __forceinline__ void xcd_barrier_complete(unsigned* bar, unsigned x, unsigned& nloc, unsigned& nx) {
    const unsigned G = gridDim.x * gridDim.y * gridDim.z;
    unsigned sum, cnt, mine, sp = 0u;
    for (;;) {
        sum = 0u; cnt = 0u; mine = 0u;
#pragma unroll
        for (unsigned j = 0; j < 16; ++j) { const unsigned c = xb_ld(&bar[XB_XCNT(j)]); sum += c; cnt += (c > 0u) ? 1u : 0u; mine = (j == x) ? c : mine; }
        if (sum == G) break;
        __builtin_amdgcn_s_sleep(1);
        if ((++sp & 255u) == 0u) { if (xb_ld(&bar[XB_TMO])) break; if (sp > XB_SPIN_CAP) { atomicAdd(&bar[XB_TMO], 1u); break; } }
    }
    nloc = mine > 0u ? mine : 1u; nx = cnt > 0u ? cnt : 1u;
}

__device__ __forceinline__ void xcd_barrier(const XcdBarrier& b) {
    asm volatile("s_waitcnt vmcnt(0)" ::: "memory");
    __syncthreads();
    if (threadIdx.x == 0) {
        unsigned* bar = b.bar;
        __builtin_amdgcn_s_waitcnt(0);
        unsigned nloc = b.st[0], nx = b.st[1];
        if (nloc == 0u) { xcd_barrier_complete(bar, b.x, nloc, nx); b.st[0] = nloc; b.st[1] = nx; }
        const unsigned old = xb_add(&bar[XB_XSUB(b.x)], 1u);
        const unsigned gen = old / nloc;
        if (old + 1u == (gen + 1u) * nloc) {
            __builtin_amdgcn_fence(__ATOMIC_RELEASE, "agent");
            asm volatile("s_waitcnt vmcnt(0)" ::: "memory");
            const unsigned og = xb_add(&bar[XB_TOP], 1u);
            const unsigned tg = og / nx;
            if (og + 1u == (tg + 1u) * nx) xb_add(&bar[XB_TOPGEN], 1u);
            else XB_SPIN(xb_ld(&bar[XB_TOPGEN]) == tg, bar);
            __builtin_amdgcn_fence(__ATOMIC_ACQUIRE, "agent");
            xb_add(&bar[XB_XGEN(b.x)], 1u);
            asm volatile("s_waitcnt vmcnt(0)" ::: "memory");
        } else {
            XB_SPIN(xb_ld(&bar[XB_XGEN(b.x)]) == gen, bar);
            __builtin_amdgcn_fence(__ATOMIC_ACQUIRE, "agent");
            asm volatile("s_waitcnt vmcnt(0)" ::: "memory");
        }
    }
    __syncthreads();
}

namespace pg8 {
#define PG8_LAS __attribute__((address_space(3)))
typedef unsigned short bf16_t;
typedef short bf16x8 __attribute__((ext_vector_type(8)));
typedef float f32x4 __attribute__((ext_vector_type(4)));
typedef unsigned u32x4 __attribute__((ext_vector_type(4)));
constexpr int BM = 256, BK = 64, HALF = 128, HTB = HALF * BK * 2  , STAGE_BYTES = 8 * HTB, NXCD = 8, WGM = 8;

__host__ __device__ __forceinline__ int lds_byte(int r, int c) { const int st = (r >> 4) * 2 + (c >> 5), rr = r & 15, cc = c & 31, ob = rr * 64 + cc * 2; return st * 1024 + (ob ^ (((ob >> 9) & 1) << 5)); }
__host__ __device__ __forceinline__ void stage_rc(int b, int& R, int& C) { const int st = b / 1024, sb = b % 1024, swz = sb ^ (((sb >> 9) & 1) << 5); R = (st >> 1) * 16 + swz / 64; C = (st & 1) * 32 + (swz % 64) / 2; }
__host__ __device__ __forceinline__ int perm32(int rho) { const int n = rho >> 4, i = rho & 15; return 8 * (i >> 2) + 4 * n + (i & 3); }

struct Unit { int pm, pn; };
struct Gemm { const bf16_t* A; const bf16_t* Bt; int M, N, K; };

struct StaticOrder {
    int nM, nN, nwg, G, c;
    __host__ __device__ void init(int M, int N, int G_, int c_) { nM = M / BM; nN = N / BM; nwg = nM * nN; G = G_; c = c_; }
    __host__ __device__ bool next(int i, Unit& u) const {
        const long L = (long)i * G + c; if (L >= nwg) return false;
        int wgid = (int)L; { const int q = nwg / NXCD, r = nwg % NXCD, xcd = wgid % NXCD, off = wgid / NXCD; wgid = (xcd < r ? xcd * (q + 1) : r * (q + 1) + (xcd - r) * q) + off; }
        const int nig = WGM * nN, gid = wgid / nig, fm = gid * WGM, gsz = (nM - fm) < WGM ? (nM - fm) : WGM;
        u.pm = fm + ((wgid % nig) % gsz); u.pn = (wgid % nig) / gsz; return true;
    }
    __device__ __forceinline__ void a_ready(const Unit&) const {}
    __device__ __forceinline__ void done(const Unit&) const {}
};


__device__ __forceinline__ unsigned cvt_pk_bf16(float lo, float hi) { unsigned r; asm volatile("v_cvt_pk_bf16_f32 %0, %1, %2" : "=v"(r) : "v"(lo), "v"(hi)); return r; }

__device__ __forceinline__ __amdgpu_buffer_rsrc_t wt_rsrc(void* base) { return __builtin_amdgcn_make_buffer_rsrc(base, 0, 0x7fffffff, 0x00020000); }
__device__ __forceinline__ void wt_store16(__amdgpu_buffer_rsrc_t r, size_t byte_off, u32x4 v) { __builtin_amdgcn_raw_buffer_store_b128(v, r, (unsigned)byte_off, 0, 16); }
struct EpiQKV {
    static constexpr bool PERM = true, AFTER_DRAIN = false;
    bf16_t* O; int ldc; float qscale;
    __device__ __forceinline__ void operator()(const f32x4 (&acc)[2][2][4][2], const Unit& u, int wr, int wc, int fr, int fq) const {
        const int bb = u.pm >> 3, s0 = (u.pm & 7) * BM + wr * 64 + fr, slot0 = 4 * u.pn + (wc >> 1), d0 = (wc & 1) * 32 + 8 * fq;
        const float sc = (u.pn < 2 || u.pn == 6 || u.pn == 7) ? qscale : 1.f;
        const __amdgpu_buffer_rsrc_t rs_ = wt_rsrc(O);
#pragma unroll
        for (int bj = 0; bj < 2; ++bj) { const size_t hp = ((((size_t)bb * 48 + slot0 + 2 * bj) * 2048 + s0) * 64 + d0) * 2;
#pragma unroll
            for (int ai = 0; ai < 2; ++ai)
#pragma unroll
                for (int m = 0; m < 4; ++m) { const f32x4 v0 = acc[ai][bj][m][0] * sc, v1 = acc[ai][bj][m][1] * sc;
                    u32x4 w; w.x = cvt_pk_bf16(v0[0], v0[1]); w.y = cvt_pk_bf16(v0[2], v0[3]); w.z = cvt_pk_bf16(v1[0], v1[1]); w.w = cvt_pk_bf16(v1[2], v1[3]);
                    wt_store16(rs_, hp + (size_t)(ai * HALF + m * 16) * 128, w); } }
    }
};
struct EpiZ {
    static constexpr bool PERM = true, AFTER_DRAIN = false;
    bf16_t* Z; const float* mod;
    __device__ __forceinline__ void operator()(const f32x4 (&acc)[2][2][4][2], const Unit& u, int wr, int wc, int fr, int fq) const {
        const int row0 = u.pm * BM + wr * 64 + fr, col0 = u.pn * BM + wc * 32 + 8 * fq;
        const float* g1 = mod + (size_t)(u.pm >> 3) * 6144 + 2048 + col0;
        const __amdgpu_buffer_rsrc_t rs_ = wt_rsrc(Z);
        f32x4 gv[2][2];
#pragma unroll
        for (int bj = 0; bj < 2; ++bj)
#pragma unroll
            for (int n = 0; n < 2; ++n) gv[bj][n] = *(const f32x4*)(g1 + bj * HALF + 4 * n);
#pragma unroll
        for (int ai = 0; ai < 2; ++ai)
#pragma unroll
            for (int m = 0; m < 4; ++m) { const size_t off = (size_t)(row0 + ai * HALF + m * 16) * 1024 + col0;
#pragma unroll
                for (int bj = 0; bj < 2; ++bj) { const f32x4 v0 = acc[ai][bj][m][0] * gv[bj][0], v1 = acc[ai][bj][m][1] * gv[bj][1];
                    u32x4 w; w.x = cvt_pk_bf16(v0[0], v0[1]); w.y = cvt_pk_bf16(v0[2], v0[3]); w.z = cvt_pk_bf16(v1[0], v1[1]); w.w = cvt_pk_bf16(v1[2], v1[3]);
                    wt_store16(rs_, (off + bj * HALF) * 2, w); } }
    }
};
struct EpiSC {
    static constexpr bool PERM = true, AFTER_DRAIN = false;
    _Float16* O; int ldc;
    __device__ __forceinline__ void operator()(const f32x4 (&acc)[2][2][4][2], const Unit& u, int wr, int wc, int fr, int fq) const {
        const int row0 = u.pm * BM + wr * 64 + fr, col0 = u.pn * BM + wc * 32 + 8 * fq;
        const __amdgpu_buffer_rsrc_t rs_ = wt_rsrc(O);
#pragma unroll
        for (int ai = 0; ai < 2; ++ai)
#pragma unroll
            for (int m = 0; m < 4; ++m) { const size_t rowp = ((size_t)(row0 + ai * HALF + m * 16) * ldc + col0) * 2;
#pragma unroll
                for (int bj = 0; bj < 2; ++bj) { const f32x4 v0 = acc[ai][bj][m][0], v1 = acc[ai][bj][m][1];
                    u32x4 w; w.x = pkh(v0[0], v0[1]); w.y = pkh(v0[2], v0[3]); w.z = pkh(v1[0], v1[1]); w.w = pkh(v1[2], v1[3]);
                    wt_store16(rs_, rowp + bj * HALF * 2, w); } }
    }
};

template <class Epi, class Sched, bool ALIGN_EPI = false, bool SP2 = false>
__device__ __forceinline__ void gemm_phase(PG8_LAS unsigned char* lds, const Gemm g, const Sched& S, const Epi& E) {
    const int tid = threadIdx.x, wid = __builtin_amdgcn_readfirstlane(tid >> 6), lane = tid & 63, wr = wid >> 2, wc = wid & 3, fr = lane & 15, fq = lane >> 4;
    const int K = g.K, nt = K / BK;
    unsigned voffA[2], voffB[2];
#pragma unroll
    for (int i = 0; i < 2; ++i) { int R, C; stage_rc(tid * 16 + i * 8192, R, C); const int Rb = Epi::PERM ? ((R & ~31) + perm32(R & 31)) : R;
        voffA[i] = (unsigned)(R * K + C) * 2u; voffB[i] = (unsigned)(Rb * K + C) * 2u; }
    const size_t kstep = (size_t)(BK * 2);
    const size_t hstep = (size_t)HALF * K * 2;
    const size_t tstep = 2 * hstep;
    const unsigned ldsw = (unsigned)wid * 1024u;
    const int aoff = lds_byte(wr * 64 + fr, fq * 8), boff = lds_byte(wc * 32 + fr, fq * 8);
#define PG8_SA(b, h) (((b) * 2 + (h)) * HTB)
#define PG8_SB(b, h) ((4 + (b) * 2 + (h)) * HTB)
#define PG8_STAGE(bufoff, gbase, voff) do { _Pragma("unroll") for (int _i = 0; _i < 2; ++_i) \
        __builtin_amdgcn_global_load_lds((const unsigned*)((const char*)(gbase) + (voff)[_i]), (PG8_LAS unsigned*)(lds + (bufoff) + ldsw + _i * 8192), 16, 0, 0); } while (0)
#define PG8_LDA(dst, b, h) do { _Pragma("unroll") for (int m = 0; m < 4; ++m) _Pragma("unroll") for (int k = 0; k < 2; ++k) dst[m][k] = *(const PG8_LAS bf16x8*)(lds + PG8_SA(b, h) + aoff + m * 2048 + k * 1024); } while (0)
#define PG8_LDB(dst, b, h) do { _Pragma("unroll") for (int n = 0; n < 2; ++n) _Pragma("unroll") for (int k = 0; k < 2; ++k) dst[n][k] = *(const PG8_LAS bf16x8*)(lds + PG8_SB(b, h) + boff + n * 2048 + k * 1024); } while (0)
#define PG8_MMA(ai, bj, At, Bt) do { __builtin_amdgcn_s_setprio(1); _Pragma("unroll") for (int m = 0; m < 4; ++m) _Pragma("unroll") for (int n = 0; n < 2; ++n) _Pragma("unroll") for (int k = 0; k < 2; ++k) \
        acc[ai][bj][m][n] = __builtin_amdgcn_mfma_f32_16x16x32_bf16(Bt[n][k], At[m][k], acc[ai][bj][m][n], 0, 0, 0); __builtin_amdgcn_s_setprio(0); } while (0)
#define PG8_WAIT_V(n) asm volatile("s_waitcnt vmcnt(" #n ")" ::: "memory")
#define PG8_WAIT_L(n) asm volatile("s_waitcnt lgkmcnt(" #n ")" ::: "memory")
#define PG8_BAR __builtin_amdgcn_s_barrier()
#define PG8_SCHED __builtin_amdgcn_sched_barrier(0)
    Unit cur, nxt; int ui = 0;
    if (!S.next(0, cur)) return;
    f32x4 acc[2][2][4][2];
#pragma unroll
    for (int a = 0; a < 2; ++a)
#pragma unroll
        for (int b = 0; b < 2; ++b)
#pragma unroll
            for (int m = 0; m < 4; ++m)
#pragma unroll
                for (int n = 0; n < 2; ++n) acc[a][b][m][n] = (f32x4){0.f, 0.f, 0.f, 0.f};
    bf16x8 At[4][2], B0[2][2], B1[2][2];
    const char* cA = (const char*)g.A + (size_t)cur.pm * tstep; const char* cB = (const char*)g.Bt + (size_t)cur.pn * tstep;
    S.a_ready(cur);
    if constexpr (SP2) {
        PG8_STAGE(PG8_SB(0, 0), cB, voffB); PG8_STAGE(PG8_SB(0, 1), cB + hstep, voffB); PG8_STAGE(PG8_SA(0, 0), cA, voffA); PG8_STAGE(PG8_SA(0, 1), cA + hstep, voffA);
        if (wr == 1) PG8_BAR;
        PG8_WAIT_V(2); PG8_BAR;
        PG8_STAGE(PG8_SB(1, 0), cB + kstep, voffB); PG8_STAGE(PG8_SA(1, 0), cA + kstep, voffA); PG8_STAGE(PG8_SB(1, 1), cB + hstep + kstep, voffB);
        PG8_WAIT_V(6); PG8_BAR;
    } else {
        PG8_STAGE(PG8_SB(0, 0), cB, voffB); PG8_STAGE(PG8_SA(0, 0), cA, voffA); PG8_STAGE(PG8_SB(0, 1), cB + hstep, voffB); PG8_STAGE(PG8_SA(0, 1), cA + hstep, voffA);
        if (wr == 1) PG8_BAR;
        PG8_WAIT_V(4); PG8_BAR;
        PG8_STAGE(PG8_SB(1, 0), cB + kstep, voffB); PG8_STAGE(PG8_SA(1, 0), cA + kstep, voffA); PG8_STAGE(PG8_SB(1, 1), cB + hstep + kstep, voffB);
        PG8_WAIT_V(6); PG8_BAR;
    }
    for (;;) {
        const bool has_next = S.next(ui + 1, nxt);
        const char* nA = has_next ? (const char*)g.A + (size_t)nxt.pm * tstep : cA; const char* nB = has_next ? (const char*)g.Bt + (size_t)nxt.pn * tstep : cB;
        for (int t = 0; t < nt; t += 2) {
            const bool last = (t == nt - 2);
            const char* a1 = cA + (size_t)(t + 1) * kstep;
            const char* a2 = last ? nA : cA + (size_t)(t + 2) * kstep; const char* b2 = last ? nB : cB + (size_t)(t + 2) * kstep;
            const char* a3 = a2 + kstep; const char* b3 = b2 + kstep;
            if (last && has_next) S.a_ready(nxt);
            if constexpr (SP2) {
            PG8_LDB(B0, 0, 0); PG8_LDB(B1, 0, 1); PG8_SCHED; PG8_LDA(At, 0, 0); PG8_STAGE(PG8_SA(1, 1), a1 + hstep, voffA);
            PG8_WAIT_V(8); PG8_WAIT_L(0); PG8_BAR; PG8_MMA(0, 0, At, B0); PG8_MMA(0, 1, At, B1); PG8_BAR; PG8_SCHED;
            PG8_LDA(At, 0, 1); PG8_STAGE(PG8_SB(0, 0), b2, voffB); PG8_STAGE(PG8_SB(0, 1), b2 + hstep, voffB); PG8_STAGE(PG8_SA(0, 0), a2, voffA);
            PG8_WAIT_V(8); PG8_WAIT_L(0); PG8_BAR; PG8_MMA(1, 0, At, B0); PG8_MMA(1, 1, At, B1); PG8_BAR; PG8_SCHED;
            PG8_LDB(B0, 1, 0); PG8_LDB(B1, 1, 1); PG8_SCHED; PG8_LDA(At, 1, 0); PG8_STAGE(PG8_SA(0, 1), a2 + hstep, voffA);
            PG8_WAIT_V(8); PG8_WAIT_L(0); PG8_BAR; PG8_MMA(0, 0, At, B0); PG8_MMA(0, 1, At, B1); PG8_BAR; PG8_SCHED;
            PG8_LDA(At, 1, 1); PG8_STAGE(PG8_SB(1, 0), b3, voffB); PG8_STAGE(PG8_SB(1, 1), b3 + hstep, voffB); PG8_STAGE(PG8_SA(1, 0), a3, voffA);
            PG8_WAIT_V(8); PG8_WAIT_L(0); PG8_BAR; PG8_MMA(1, 0, At, B0); PG8_MMA(1, 1, At, B1); PG8_BAR; PG8_SCHED;
            } else {
            PG8_LDB(B0, 0, 0); PG8_SCHED; PG8_LDA(At, 0, 0); PG8_STAGE(PG8_SA(1, 1), a1 + hstep, voffA);
            PG8_WAIT_L(8); PG8_BAR; PG8_WAIT_L(0); PG8_MMA(0, 0, At, B0); PG8_BAR; PG8_SCHED;
            PG8_LDB(B1, 0, 1); PG8_STAGE(PG8_SB(0, 0), b2, voffB);
            PG8_BAR; PG8_WAIT_L(0); PG8_MMA(0, 1, At, B1); PG8_BAR;
            PG8_LDA(At, 0, 1); PG8_STAGE(PG8_SA(0, 0), a2, voffA);
            PG8_BAR; PG8_WAIT_L(0); PG8_MMA(1, 0, At, B0); PG8_BAR; PG8_SCHED;
            PG8_STAGE(PG8_SB(0, 1), b2 + hstep, voffB);
            PG8_WAIT_V(6); PG8_BAR; PG8_MMA(1, 1, At, B1); PG8_BAR;
            PG8_LDB(B0, 1, 0); PG8_SCHED; PG8_LDA(At, 1, 0); PG8_STAGE(PG8_SA(0, 1), a2 + hstep, voffA);
            PG8_WAIT_L(8); PG8_BAR; PG8_WAIT_L(0); PG8_MMA(0, 0, At, B0); PG8_BAR; PG8_SCHED;
            PG8_LDB(B1, 1, 1); PG8_STAGE(PG8_SB(1, 0), b3, voffB);
            PG8_BAR; PG8_WAIT_L(0); PG8_MMA(0, 1, At, B1); PG8_BAR;
            PG8_LDA(At, 1, 1); PG8_STAGE(PG8_SA(1, 0), a3, voffA);
            PG8_BAR; PG8_WAIT_L(0); PG8_MMA(1, 0, At, B0); PG8_BAR; PG8_SCHED;
            PG8_STAGE(PG8_SB(1, 1), b3 + hstep, voffB);
            PG8_WAIT_V(6); PG8_BAR; PG8_MMA(1, 1, At, B1); PG8_BAR;
            }
        }
        if constexpr (ALIGN_EPI) { if (wr == 0) PG8_BAR; }
        if constexpr (!Epi::AFTER_DRAIN) { E(acc, cur, wr, wc, fr, fq); S.done(cur); }
        if (!has_next) break;
#pragma unroll
        for (int a = 0; a < 2; ++a)
#pragma unroll
            for (int b = 0; b < 2; ++b)
#pragma unroll
                for (int m = 0; m < 4; ++m)
#pragma unroll
                    for (int n = 0; n < 2; ++n) acc[a][b][m][n] = (f32x4){0.f, 0.f, 0.f, 0.f};
        cur = nxt; cA = nA; cB = nB; ++ui;
        if constexpr (ALIGN_EPI) { if (wr == 1) PG8_BAR; }
    }
    PG8_WAIT_V(0);
    if constexpr (!ALIGN_EPI) { if (wr == 0) PG8_BAR; }
    PG8_BAR;
    if constexpr (Epi::AFTER_DRAIN) { E.fused(acc, cur, wr, wc, fr, fq, lds, wid, lane); S.done(cur); }
#undef PG8_SA
#undef PG8_SB
#undef PG8_STAGE
#undef PG8_LDA
#undef PG8_LDB
#undef PG8_MMA
#undef PG8_WAIT_V
#undef PG8_WAIT_L
#undef PG8_BAR
#undef PG8_SCHED
}
}

struct Params {
    const float *x, *c, *ada_w, *ada_b, *norm1_g, *w_in, *na_rpb, *ong_na, *ong_dil, *w_out, *norm2_g, *peer_wq, *peer_sk, *peer_u, *peer_v, *final_g;
    float* out; unsigned char* ws; int ph_lo, ph_hi;
};
constexpr int NPHASE = 13;

__device__ __forceinline__ void p0_mod(const Params& p, LAS unsigned char* lds, int tid, int lane, int wave) {
    LAS float* s = (LAS float*)lds;
    LAS float* red = (LAS float*)(lds + 65536);
    for (int idx = tid; idx < 16 * 1024; idx += 512) { const int b = idx >> 10, k = idx & 1023; const float cv = p.c[idx]; s[k * 16 + b] = cv / (1.f + __expf(-cv)); }
    __syncthreads();
    float* mod = (float*)(p.ws + WS_MOD);
    for (int it = blockIdx.x; it < 256; it += gridDim.x) {
        const int j0 = it * 24, c = lane & 31, kq = lane >> 5; const bool act = c < 24;
        float acc[16];
#pragma unroll
        for (int b = 0; b < 16; ++b) acc[b] = 0.f;
        const float* wp = p.ada_w + (size_t)(wave * 128 + kq) * 6144 + j0 + (act ? c : 0);
#pragma unroll 4
        for (int i = 0; i < 64; ++i) {
            const int k = wave * 128 + 2 * i + kq;
            const float wv = act ? __builtin_nontemporal_load(wp + (size_t)i * 2 * 6144) : 0.f;
            const LAS f32x4* sp = (const LAS f32x4*)(s + k * 16);
            const f32x4 s0 = sp[0], s1 = sp[1], s2 = sp[2], s3 = sp[3];
#pragma unroll
            for (int e = 0; e < 4; ++e) { acc[e] += s0[e] * wv; acc[4 + e] += s1[e] * wv; acc[8 + e] += s2[e] * wv; acc[12 + e] += s3[e] * wv; }
        }
#pragma unroll
        for (int b = 0; b < 16; ++b) red[((wave * 2 + kq) * 16 + b) * 32 + c] = acc[b];
        __syncthreads();
        if (tid < 384) { const int b = tid / 24, cc = tid - b * 24; float sum = p.ada_b[j0 + cc];
#pragma unroll
            for (int pp = 0; pp < 16; ++pp) sum += red[(pp * 16 + b) * 32 + cc];
            mod[(size_t)b * 6144 + j0 + cc] = sum; }
        __syncthreads();
    }
}
__device__ __forceinline__ void p0_wsc(const Params& p, LAS unsigned char* lds, int tid) {
    LAS float* wq_s = (LAS float*)lds;
    LAS float* sk_s = (LAS float*)(lds + 32768);
    bf16_t* WscT = (bf16_t*)(p.ws + WS_WSC);
    for (int it = blockIdx.x; it < 256; it += gridDim.x) {
        const int hp = it >> 4, kc = it & 15, pp = hp & 1, k0 = kc * 64;
        for (int i = tid; i < 2048; i += 512) { const int r = i >> 5, c4 = i & 31; *(LAS f32x4*)(wq_s + r * 128 + c4 * 4) = *(const f32x4*)(p.peer_wq + (size_t)(k0 + r) * 2048 + hp * 128 + c4 * 4); }
        for (int i = tid; i < 4096; i += 512) { const int r = i >> 5, c4 = i & 31; *(LAS f32x4*)(sk_s + r * 132 + c4 * 4) = *(const f32x4*)(p.peer_sk + (size_t)pp * 16384 + r * 128 + c4 * 4); }
        __syncthreads();
        const int n = tid & 127, kg = tid >> 7;
        float acc[16];
#pragma unroll
        for (int i = 0; i < 16; ++i) acc[i] = 0.f;
        for (int d = 0; d < 128; d += 4) {
            const f32x4 sv = *(const LAS f32x4*)(sk_s + n * 132 + d);
#pragma unroll
            for (int i = 0; i < 16; ++i) { const f32x4 wv = *(const LAS f32x4*)(wq_s + (kg * 16 + i) * 128 + d); acc[i] += (wv[0] * sv[0] + wv[1] * sv[1]) + (wv[2] * sv[2] + wv[3] * sv[3]); }
        }
        bf16_t* op = WscT + (size_t)(hp * 128 + n) * 1024 + k0 + kg * 16;
        u32x4 w0, w1;
        w0.x = pkbf(acc[0], acc[1]); w0.y = pkbf(acc[2], acc[3]); w0.z = pkbf(acc[4], acc[5]); w0.w = pkbf(acc[6], acc[7]);
        w1.x = pkbf(acc[8], acc[9]); w1.y = pkbf(acc[10], acc[11]); w1.z = pkbf(acc[12], acc[13]); w1.w = pkbf(acc[14], acc[15]);
        *(u32x4*)op = w0; *(u32x4*)(op + 8) = w1;
        __syncthreads();
    }
}
__device__ __forceinline__ void p0_transpose_item(const float* W, int K, int N, bf16_t* WT, const float* ks0, const float* ks1, LAS float* scr, int item, int lane) {
    const int nblk = N / 32, kb = item / nblk, nb = item % nblk, k0 = 64 * kb, n0 = 32 * nb;
#pragma unroll 8
    for (int i = 0; i < 32; ++i) { const int kk = 2 * i + (lane >> 5), kabs = k0 + kk;
        const float sc = ks0 ? (kabs < 512 ? ks0[kabs] : ks1[kabs - 512]) : 1.f;
        scr[kk * 33 + (lane & 31)] = W[(size_t)kabs * N + n0 + (lane & 31)] * sc; }
    asm volatile("s_waitcnt lgkmcnt(0)" ::: "memory");
    const int c = lane & 7;
#pragma unroll
    for (int j = 0; j < 4; ++j) { const int n = (lane >> 3) + 8 * j; const LAS float* s = scr + (8 * c) * 33 + n;
        u32x4 o; o.x = pkbf(s[0 * 33], s[1 * 33]); o.y = pkbf(s[2 * 33], s[3 * 33]); o.z = pkbf(s[4 * 33], s[5 * 33]); o.w = pkbf(s[6 * 33], s[7 * 33]);
        *(u32x4*)(WT + (size_t)(n0 + n) * K + k0 + 8 * c) = o; }
    asm volatile("s_waitcnt lgkmcnt(0)" ::: "memory");
}
__device__ __forceinline__ void p0_weights(const Params& p, LAS unsigned char* lds, int tid, int lane, int wave) {
    p0_wsc(p, lds, tid);
    const int G = gridDim.x, gw = blockIdx.x * 8 + wave, NGW = G * 8;
    LAS float* scr = (LAS float*)(lds + wave * 16384);
    constexpr int I_IN = (DM / 64) * (NQKV / 32), I_OUT = (DM / 64) * (DM / 32);
    for (int it = gw; it < I_IN + I_OUT; it += NGW) {
        if (it < I_IN) p0_transpose_item(p.w_in, DM, NQKV, (bf16_t*)(p.ws + WS_WIN), nullptr, nullptr, scr, it, lane);
        else p0_transpose_item(p.w_out, DM, DM, (bf16_t*)(p.ws + WS_WOUT), p.ong_na, p.ong_dil, scr, it - I_IN, lane);
    }
}

template <bool Q8>
__device__ __forceinline__ void norm_rows(const float* src, const bf16_t* zadd, const float* gain, const float* mod, int sh_off, int sc_off, bf16_t* dst, unsigned char* dst8, float* scale8, int gw, int NGW, int lane) {
    for (int it = gw; it < TOK / 16; it += NGW) {
        const int t0 = it * 16, b = t0 >> 11; const float* mb = mod + (size_t)b * 6144;
        f32x4 Gv[4], Sv[4];
#pragma unroll
        for (int j = 0; j < 4; ++j) { const int k = 4 * lane + 256 * j; const f32x4 g = *(const f32x4*)(gain + k), sc = *(const f32x4*)(mb + sc_off + k); Gv[j] = g * (1.f + sc); Sv[j] = *(const f32x4*)(mb + sh_off + k); }
        f32x4 n1[4], n2[4], n3[4];
#pragma unroll
        for (int j = 0; j < 4; ++j) { n1[j] = __builtin_nontemporal_load((const f32x4*)(src + (size_t)t0 * DM) + lane + 64 * j); n2[j] = __builtin_nontemporal_load((const f32x4*)(src + (size_t)(t0 + 1) * DM) + lane + 64 * j); n3[j] = __builtin_nontemporal_load((const f32x4*)(src + (size_t)(t0 + 2) * DM) + lane + 64 * j); }
        u32x2 z1[4], z2[4], z3[4];
        if (Q8) {
#pragma unroll
            for (int j = 0; j < 4; ++j) { z1[j] = __builtin_nontemporal_load((const u32x2*)(zadd + (size_t)t0 * DM) + lane + 64 * j); z2[j] = __builtin_nontemporal_load((const u32x2*)(zadd + (size_t)(t0 + 1) * DM) + lane + 64 * j); z3[j] = __builtin_nontemporal_load((const u32x2*)(zadd + (size_t)(t0 + 2) * DM) + lane + 64 * j); }
        }
#pragma unroll 4
        for (int r = 0; r < 16; ++r) {
            f32x4 v[4]; float ss = 0.f;
            const f32x4* xn = (const f32x4*)(src + (size_t)(t0 + (r + 3 < 16 ? r + 3 : 15)) * DM) + lane;
#pragma unroll
            for (int j = 0; j < 4; ++j) { v[j] = n1[j]; n1[j] = n2[j]; n2[j] = n3[j]; n3[j] = __builtin_nontemporal_load(xn + 64 * j);
                if (Q8) { const u32x2 zz = z1[j]; v[j] = v[j] + (f32x4){bf_lo(zz.x), bf_hi(zz.x), bf_lo(zz.y), bf_hi(zz.y)}; z1[j] = z2[j]; z2[j] = z3[j]; z3[j] = __builtin_nontemporal_load((const u32x2*)(zadd + (size_t)(t0 + (r + 3 < 16 ? r + 3 : 15)) * DM) + lane + 64 * j); }
                ss += (v[j][0] * v[j][0] + v[j][1] * v[j][1]) + (v[j][2] * v[j][2] + v[j][3] * v[j][3]); }
            const float rs = rsqrtf(wave_sum(ss) * (1.f / DM) + EPS);
            u32x2* o8 = (u32x2*)(dst + (size_t)(t0 + r) * DM) + lane;
            float am = 0.f;
#pragma unroll
            for (int j = 0; j < 4; ++j) { const f32x4 h = v[j] * rs * Gv[j] + Sv[j]; v[j] = h; u32x2 w; w.x = pkbf(h[0], h[1]); w.y = pkbf(h[2], h[3]); o8[64 * j] = w;
                if (Q8) am = fmaxf(fmaxf(am, fmaxf(fabsf(h[0]), fabsf(h[1]))), fmaxf(fabsf(h[2]), fabsf(h[3]))); }
            if (Q8) {
#pragma unroll
                for (int o = 1; o < 64; o <<= 1) am = fmaxf(am, __shfl_xor(am, o));
                const float inv = am > 0.f ? 127.f / am : 0.f;
                unsigned* q8 = (unsigned*)(dst8 + (size_t)(t0 + r) * DM) + lane;
#pragma unroll
                for (int j = 0; j < 4; ++j) { const int q0 = (int)rintf(v[j][0] * inv), q1 = (int)rintf(v[j][1] * inv), q2 = (int)rintf(v[j][2] * inv), q3 = (int)rintf(v[j][3] * inv);
                    q8[64 * j] = ((unsigned)q0 & 255u) | (((unsigned)q1 & 255u) << 8) | (((unsigned)q2 & 255u) << 16) | ((unsigned)q3 << 24); }
                if (lane == 0) scale8[t0 + r] = am * (1.f / 127.f);
            }
        }
    }
}

struct TabRow { f32x4 v[4]; };
__device__ __forceinline__ void tab_row_load(const Params& p, int row, int lane, TabRow& r) {
    const bool second = row >= NEXP; const int e = second ? row - NEXP : row;
    const f32x4* src = (const f32x4*)((second ? p.peer_v : p.peer_u) + (size_t)e * 1024) + lane;
#pragma unroll
    for (int j = 0; j < 4; ++j) r.v[j] = __builtin_nontemporal_load(src + 64 * j);
}
__device__ __forceinline__ void tab_row_finish(const Params& p, int row, int lane, const TabRow& r) {
    asm volatile("" : "+v"(lane));
    const bool second = row >= NEXP; const int e = second ? row - NEXP : row;
    float am = 0.f;
#pragma unroll
    for (int j = 0; j < 4; ++j) am = fmaxf(fmaxf(am, fmaxf(fabsf(r.v[j][0]), fabsf(r.v[j][1]))), fmaxf(fabsf(r.v[j][2]), fabsf(r.v[j][3])));
#pragma unroll
    for (int o = 1; o < 64; o <<= 1) am = fmaxf(am, __shfl_xor(am, o));
    const float inv = am > 0.f ? 127.f / am : 0.f;
    unsigned char* tb_ = p.ws + (second ? WS_VH : WS_UH) + (size_t)e * 128 + 4 * (lane & 31);
#pragma unroll
    for (int j = 0; j < 4; ++j) { const int q0 = (int)rintf(r.v[j][0] * inv), q1 = (int)rintf(r.v[j][1] * inv), q2 = (int)rintf(r.v[j][2] * inv), q3 = (int)rintf(r.v[j][3] * inv);
        *(unsigned*)(tb_ + (size_t)(2 * j + (lane >> 5)) * NEXP * 128) = ((unsigned)q0 & 255u) | (((unsigned)q1 & 255u) << 8) | (((unsigned)q2 & 255u) << 16) | ((unsigned)q3 << 24); }
    if (lane == 0) ((float*)(p.ws + WS_SU))[row] = am * (1.f / 127.f);
}


constexpr int VROW = 160;
constexpr int RPB_OFF = 98304;
constexpr int NUNIT_NA = 2048, NUNIT_DIL = 6144;


template <int NCH> __device__ __forceinline__ void softmax_pack(f32x4 (&S)[NCH][2], bf16x8 (&pa)[NCH], float& mx_out, float& l_out) {
    float mx = -1e30f, mx2 = -1e30f;
#pragma unroll
    for (int ch = 0; ch < NCH; ++ch)
#pragma unroll
        for (int xy = 0; xy < 2; ++xy) { mx = fmaxf(mx, fmaxf(S[ch][xy][0], S[ch][xy][1])); mx2 = fmaxf(mx2, fmaxf(S[ch][xy][2], S[ch][xy][3])); }
    mx = fmaxf(mx, mx2);
    mx = fmaxf(mx, __shfl_xor(mx, 16)); mx = fmaxf(mx, __shfl_xor(mx, 32));
    float l = 0.f;
#pragma unroll
    for (int ch = 0; ch < NCH; ++ch) {
#pragma unroll
        for (int xy = 0; xy < 2; ++xy)
#pragma unroll
            for (int r = 0; r < 4; ++r) { const float e = __builtin_amdgcn_exp2f(S[ch][xy][r] - mx); S[ch][xy][r] = e; l += e; }
        u32x4 w; w.x = pkbf(S[ch][0][0], S[ch][0][1]); w.y = pkbf(S[ch][0][2], S[ch][0][3]); w.z = pkbf(S[ch][1][0], S[ch][1][1]); w.w = pkbf(S[ch][1][2], S[ch][1][3]);
        pa[ch] = __builtin_bit_cast(bf16x8, w);
    }
    l += __shfl_xor(l, 16); l += __shfl_xor(l, 32);
    mx_out = mx; l_out = l;
}
template <int NCH, int CSB> __device__ __forceinline__ void pv_accum(const LAS unsigned char* vb, const bf16x8 (&pa)[NCH], f32x4 (&o)[4]) {
#pragma unroll
    for (int ch = 0; ch < NCH; ++ch)
#pragma unroll
        for (int nt = 0; nt < 4; ++nt) {
            const v4i16_t t0 = __builtin_amdgcn_ds_read_tr16_b64_v4i16((LAS v4i16_t*)(vb + ch * CSB + nt * 32));
            const v4i16_t t1 = __builtin_amdgcn_ds_read_tr16_b64_v4i16((LAS v4i16_t*)(vb + ch * CSB + 16 * VROW + nt * 32));
            const bf16x8 vf = {t0[0], t0[1], t0[2], t0[3], t1[0], t1[1], t1[2], t1[3]};
            o[nt] = __builtin_amdgcn_mfma_f32_16x16x32_bf16(vf, pa[ch], o[nt], 0, 0, 0);
        }
}

__device__ __forceinline__ void o_store16(__amdgpu_buffer_rsrc_t rs, size_t elem_off  , const f32x4 (&o)[4], float inv, int g) {
    const bool odd = (g & 1) != 0;
#pragma unroll
    for (int pr = 0; pr < 2; ++pr) {
        const unsigned x0 = pkbf(o[2 * pr][0] * inv, o[2 * pr][1] * inv), x1 = pkbf(o[2 * pr][2] * inv, o[2 * pr][3] * inv);
        const unsigned y0 = pkbf(o[2 * pr + 1][0] * inv, o[2 * pr + 1][1] * inv), y1 = pkbf(o[2 * pr + 1][2] * inv, o[2 * pr + 1][3] * inv);
        auto r0 = __builtin_amdgcn_permlane16_swap(x0, y0, false, false), r1 = __builtin_amdgcn_permlane16_swap(x1, y1, false, false);
        const u32x4 w = {r0[0], r1[0], r0[1], r1[1]};
        const int d0 = 16 * (2 * pr + (odd ? 1 : 0)) + 4 * (g & ~1);
        pg8::wt_store16(rs, (elem_off + d0) * 2, w);
    }
}

__device__ __forceinline__ void lds_barrier() { asm volatile("s_waitcnt lgkmcnt(0)\n\ts_barrier" ::: "memory"); }
struct NaGeo { int b, h, rp, rr, cg, r0, cw; };
__device__ __forceinline__ NaGeo na_geo(int u, int wave) {
    NaGeo z; z.b = u >> 7; z.h = (u >> 4) & 7; z.rp = u & 15; z.rr = 2 * z.rp + (wave >> 2); z.cg = wave & 3;
    z.r0 = min(max(z.rr - 4, 0), 24); z.cw = min(max(16 * z.cg - 8, 0), 32); return z;
}
__device__ __forceinline__ void na_qload(const bf16_t* QKV, const NaGeo& z, int lane, bf16x8& qf0, bf16x8& qf1) {
    const bf16_t* qp = QKV + (((size_t)z.b * 48 + z.h) * SEQ + z.rr * 64 + 16 * z.cg + (lane & 15)) * 64 + 8 * (lane >> 4);
    qf0 = *(const bf16x8*)qp; qf1 = *(const bf16x8*)(qp + 32);
}
__device__ __forceinline__ void na_kload(const bf16_t* QKV, const NaGeo& z, int hf, int lane, bf16x8 (&kf)[4][2][2]) {
#pragma unroll
    for (int c4 = 0; c4 < 4; ++c4)
#pragma unroll
        for (int xy = 0; xy < 2; ++xy) {
            const bf16_t* kp = QKV + (((size_t)z.b * 48 + 8 + z.h) * SEQ + (z.r0 + 4 * hf + c4) * 64 + z.cw + 16 * xy + (lane & 15)) * 64 + 8 * (lane >> 4);
            kf[c4][xy][0] = *(const bf16x8*)kp; kf[c4][xy][1] = *(const bf16x8*)(kp + 32);
        }
}
__device__ __forceinline__ void s_mfma4(const bf16x8 (&kf)[4][2][2], const bf16x8 qf0, const bf16x8 qf1, f32x4 (&S)[8][2], int base) {
#pragma unroll
    for (int c4 = 0; c4 < 4; ++c4)
#pragma unroll
        for (int xy = 0; xy < 2; ++xy) S[base + c4][xy] = __builtin_amdgcn_mfma_f32_16x16x32_bf16(kf[c4][xy][0], qf0, (f32x4){0.f, 0.f, 0.f, 0.f}, 0, 0, 0);
#pragma unroll
    for (int c4 = 0; c4 < 4; ++c4)
#pragma unroll
        for (int xy = 0; xy < 2; ++xy) S[base + c4][xy] = __builtin_amdgcn_mfma_f32_16x16x32_bf16(kf[c4][xy][1], qf1, S[base + c4][xy], 0, 0, 0);
}
__device__ __forceinline__ void na_unit(const Params& p, LAS unsigned char* lds, int u, int un, int tid, int lane, int wave, bf16x8 (&kfA)[4][2][2], bf16x8 (&kfB)[4][2][2], bf16x8& qf0, bf16x8& qf1) {
    const bf16_t* QKV = (const bf16_t*)(p.ws + WS_QKV);
    const LAS float* rpb = (const LAS float*)(lds + RPB_OFF) + 64;
    const NaGeo z = na_geo(u, wave);
    const int b = z.b, h = z.h, rp = z.rp, rr = z.rr, cg = z.cg, r0 = z.r0, cw = z.cw;
    const int q = lane & 15, g = lane >> 4, c = 16 * cg + q, c0 = min(max(c - 8, 0), 48);
    const int vbase = min(max(2 * rp - 4, 0), 24);
    const size_t tb = (size_t)b * SEQ;
    f32x4 S[8][2];
    s_mfma4(kfA, qf0, qf1, S, 0);
    s_mfma4(kfB, qf0, qf1, S, 4);
    __builtin_amdgcn_sched_barrier(0);
    u32x4 vreg[9];
    const int vr = tid >> 3, vpiece = tid & 7;
#pragma unroll
    for (int ps = 0; ps < 9; ++ps) { const int kr = min(vbase + ps, 31);
        vreg[ps] = *(const u32x4*)(QKV + (((size_t)b * 48 + 16 + h) * SEQ + kr * 64 + vr) * 64 + vpiece * 8); }
    const int thr = c0 - cw;
    const int bbase = h * 465 + (r0 - rr + 7) * 31 + (cw + 4 * g - c + 15);
    bool ux[4]; int bi[4];
#pragma unroll
    for (int r = 0; r < 4; ++r) { ux[r] = (4 * g + r) >= thr; bi[r] = bbase + r + (ux[r] ? 0 : 16); }
    f32x4 Sm[8];
#pragma unroll
    for (int ch = 0; ch < 8; ++ch)
#pragma unroll
        for (int r = 0; r < 4; ++r) Sm[ch][r] = (ux[r] ? S[ch][0][r] : S[ch][1][r]) + rpb[bi[r] + ch * 31];
    bf16x8 pa[8]; float mx, l;
    {
        float m0 = -1e30f, m1 = -1e30f;
#pragma unroll
        for (int ch = 0; ch < 8; ++ch) { m0 = fmaxf(m0, fmaxf(Sm[ch][0], Sm[ch][1])); m1 = fmaxf(m1, fmaxf(Sm[ch][2], Sm[ch][3])); }
        mx = fmaxf(m0, m1);
        mx = fmaxf(mx, __shfl_xor(mx, 16)); mx = fmaxf(mx, __shfl_xor(mx, 32));
        l = 0.f;
#pragma unroll
        for (int ch = 0; ch < 8; ++ch) {
            float ex[4], ey[4];
#pragma unroll
            for (int r = 0; r < 4; ++r) { const float e = __builtin_amdgcn_exp2f(Sm[ch][r] - mx); l += e; ex[r] = ux[r] ? e : 0.f; ey[r] = ux[r] ? 0.f : e; }
            u32x4 w; w.x = pkbf(ex[0], ex[1]); w.y = pkbf(ex[2], ex[3]); w.z = pkbf(ey[0], ey[1]); w.w = pkbf(ey[2], ey[3]);
            pa[ch] = __builtin_bit_cast(bf16x8, w);
        }
        l += __shfl_xor(l, 16); l += __shfl_xor(l, 32);
    }
    __builtin_amdgcn_sched_barrier(0);
    { const NaGeo zn = na_geo(un, wave); na_qload(QKV, zn, lane, qf0, qf1); na_kload(QKV, zn, 0, lane, kfA); na_kload(QKV, zn, 1, lane, kfB); }
    __builtin_amdgcn_sched_barrier(0);
    lds_barrier();
#pragma unroll
    for (int ps = 0; ps < 9; ++ps) *(LAS u32x4*)(lds + (ps * 64 + vr) * VROW + vpiece * 16) = vreg[ps];
    lds_barrier();
    f32x4 o[4];
#pragma unroll
    for (int nt = 0; nt < 4; ++nt) o[nt] = (f32x4){0.f, 0.f, 0.f, 0.f};
    const int i16 = lane & 15, qq = i16 >> 2, pp = i16 & 3;
    const LAS unsigned char* vb = lds + ((r0 - vbase) * 64 + cw + 4 * g + qq) * VROW + pp * 8;
    pv_accum<8, 64 * VROW>(vb, pa, o);
    const float inv = 1.f / l;
    o_store16(pg8::wt_rsrc(p.ws + WS_ONA), (tb + rr * 64 + c) * 512 + h * 64, o, inv, g);
}

struct DilGeo { int b, h, cfg, Dl, L, rho, m0; };
__device__ __forceinline__ DilGeo dil_geo(int v) {
    DilGeo z; z.b = v / 384; int rem = v - z.b * 384; z.h = rem / 48; rem -= z.h * 48; z.cfg = rem >> 4; const int sub = rem & 15;
    z.Dl = z.cfg * 2; z.L = SEQ >> z.Dl; const int nbl = 4 - z.Dl; z.rho = sub >> nbl; z.m0 = (sub & ((1 << nbl) - 1)) * 128; return z;
}
constexpr int DIL_KOFF = 0, DIL_VOFF = 272 * VROW;
struct DilRegs { u32x4 k[4], v[4]; bf16x8 qf0, qf1; };
__device__ __forceinline__ void dil_prefetch(const bf16_t* QKV, const DilGeo& z, int tid, int lane, int wave, DilRegs& R) {
    const int vr = tid >> 3, vpiece = tid & 7;
#pragma unroll
    for (int ps = 0; ps < 4; ++ps) { const int j = ps * 64 + vr; const int mm = min(max(z.m0 - 64 + j, 0), z.L - 1);
        const size_t tok = ((size_t)mm << z.Dl) + z.rho;
        R.k[ps] = *(const u32x4*)(QKV + (((size_t)z.b * 48 + 32 + z.h) * SEQ + tok) * 64 + vpiece * 8);
        R.v[ps] = *(const u32x4*)(QKV + (((size_t)z.b * 48 + 40 + z.h) * SEQ + tok) * 64 + vpiece * 8); }
    const int mq = z.m0 + 16 * wave + (lane & 15);
    const bf16_t* qp = QKV + (((size_t)z.b * 48 + 24 + z.h) * SEQ + ((size_t)mq << z.Dl) + z.rho) * 64 + 8 * (lane >> 4);
    R.qf0 = *(const bf16x8*)qp; R.qf1 = *(const bf16x8*)(qp + 32);
}
__device__ __forceinline__ void dil_unit(const Params& p, LAS unsigned char* lds, int v, int vn, int tid, int lane, int wave, DilRegs& R) {
    const bf16_t* QKV = (const bf16_t*)(p.ws + WS_QKV);
    const DilGeo z = dil_geo(v);
    const int h = z.h, cfg = z.cfg, Dl = z.Dl, L = z.L, rho = z.rho, m0 = z.m0;
    const int q = lane & 15, g = lane >> 4;
    const size_t tb = (size_t)z.b * SEQ;
    const int mq = m0 + 16 * wave + q;
    const int vr = tid >> 3, vpiece = tid & 7;
    lds_barrier();
#pragma unroll
    for (int ps = 0; ps < 4; ++ps) { const int j = ps * 64 + vr;
        *(LAS u32x4*)(lds + DIL_KOFF + j * VROW + vpiece * 16) = R.k[ps]; *(LAS u32x4*)(lds + DIL_VOFF + j * VROW + vpiece * 16) = R.v[ps]; }
    const bf16x8 qf0 = R.qf0, qf1 = R.qf1;
    lds_barrier();
    { const DilGeo zn = dil_geo(vn); dil_prefetch(QKV, zn, tid, lane, wave, R); }
    TabRow trw; const bool tconv = v < 2 * NEXP / 8;
    tab_row_load(p, tconv ? 8 * v + wave : 0, lane, trw);
    __builtin_amdgcn_sched_barrier(0);
    f32x4 S[5][2];
    {
        const LAS unsigned char* kb = lds + DIL_KOFF + (16 * wave + q) * VROW + 16 * g;
#pragma unroll
        for (int ch = 0; ch < 5; ++ch)
#pragma unroll
            for (int xy = 0; xy < 2; ++xy) S[ch][xy] = __builtin_amdgcn_mfma_f32_16x16x32_bf16(*(const LAS bf16x8*)(kb + (32 * ch + 16 * xy) * VROW), qf0, (f32x4){0.f, 0.f, 0.f, 0.f}, 0, 0, 0);
#pragma unroll
        for (int ch = 0; ch < 5; ++ch)
#pragma unroll
            for (int xy = 0; xy < 2; ++xy) S[ch][xy] = __builtin_amdgcn_mfma_f32_16x16x32_bf16(*(const LAS bf16x8*)(kb + (32 * ch + 16 * xy) * VROW + 64), qf1, S[ch][xy], 0, 0, 0);
    }
    const float slope2 = __builtin_amdgcn_exp2f(-(float)(h + 1)) * (float)(1 << Dl) * LOG2E;
#pragma unroll
    for (int ch = 0; ch < 5; ++ch)
#pragma unroll
        for (int xy = 0; xy < 2; ++xy)
#pragma unroll
            for (int r = 0; r < 4; ++r) { const int delta = 32 * ch + 16 * xy + 4 * g + r - 64 - q, ad = delta < 0 ? -delta : delta, mm = mq + delta;
                const bool valid = (ad <= 64) && (mm >= 0) && (mm < L);
                S[ch][xy][r] = valid ? S[ch][xy][r] - slope2 * (float)ad : -1e30f; }
    bf16x8 pa[5]; float mx, l;
    softmax_pack<5>(S, pa, mx, l);
    f32x4 o[4];
#pragma unroll
    for (int nt = 0; nt < 4; ++nt) o[nt] = (f32x4){0.f, 0.f, 0.f, 0.f};
    const int i16 = lane & 15, qq = i16 >> 2, pp = i16 & 3;
    const LAS unsigned char* vb = lds + DIL_VOFF + (16 * wave + 4 * g + qq) * VROW + pp * 8;
    pv_accum<5, 32 * VROW>(vb, pa, o);
    const float inv = 1.f / l;
    int g7 = g; asm volatile("" : "+v"(g7));
    const size_t tq = tb + ((size_t)(m0 + 16 * wave + (lane & 15)) << Dl) + rho;
    o_store16(pg8::wt_rsrc(p.ws + WS_OD), (size_t)cfg * TOK * 512 + tq * 512 + h * 64, o, inv, g7);
    if (g7 == 0) ((float*)(p.ws + WS_LSE))[((size_t)cfg * TOK + tq) * 8 + h] = mx + __builtin_amdgcn_logf(l);
    if (tconv) tab_row_finish(p, 8 * v + wave, lane, trw);
}

__device__ __forceinline__ void attn_phase(const Params& p, LAS unsigned char* lds, int tid, int lane, int wave, int vcu, int G) {
    const bf16_t* QKV = (const bf16_t*)(p.ws + WS_QKV);
    LAS float* rp = (LAS float*)(lds + RPB_OFF);
    for (int i = tid; i < 64 + 8 * 465 + 64; i += 512) { const int k = i - 64; rp[i] = (k >= 0 && k < 8 * 465) ? p.na_rpb[k] * LOG2E : 0.f; }
    __syncthreads();
    {
        bf16x8 kfA[4][2][2], kfB[4][2][2], qf0, qf1;
        int u = vcu;
        if (u < NUNIT_NA) { const NaGeo z = na_geo(u, wave); na_qload(QKV, z, lane, qf0, qf1); na_kload(QKV, z, 0, lane, kfA); na_kload(QKV, z, 1, lane, kfB); }
        for (; u < NUNIT_NA; u += G) na_unit(p, lds, u, (u + G < NUNIT_NA) ? u + G : u, tid, lane, wave, kfA, kfB, qf0, qf1);
    }
    {
        DilRegs R0, R1;
        int v = vcu;
        lds_barrier();
        if (tid < 16 * 8) { const int j = 256 + (tid >> 3); *(LAS u32x4*)(lds + DIL_KOFF + j * VROW + (tid & 7) * 16) = (u32x4){0u, 0u, 0u, 0u}; *(LAS u32x4*)(lds + DIL_VOFF + j * VROW + (tid & 7) * 16) = (u32x4){0u, 0u, 0u, 0u}; }
        if (v < NUNIT_DIL) { const DilGeo z = dil_geo(v); dil_prefetch(QKV, z, tid, lane, wave, R0); }
        if (v + G < NUNIT_DIL) { const DilGeo z = dil_geo(v + G); dil_prefetch(QKV, z, tid, lane, wave, R1); }
        for (; v < NUNIT_DIL; v += 2 * G) {
            dil_unit(p, lds, v, (v + 2 * G < NUNIT_DIL) ? v + 2 * G : v, tid, lane, wave, R0);
            if (v + G < NUNIT_DIL) dil_unit(p, lds, v + G, (v + 3 * G < NUNIT_DIL) ? v + 3 * G : v + G, tid, lane, wave, R1);
        }
    }
}

__device__ __forceinline__ void unpack8(const u32x4 w, float (&f)[8]) { f[0] = bf_lo(w.x); f[1] = bf_hi(w.x); f[2] = bf_lo(w.y); f[3] = bf_hi(w.y); f[4] = bf_lo(w.z); f[5] = bf_hi(w.z); f[6] = bf_lo(w.w); f[7] = bf_hi(w.w); }
__device__ __forceinline__ void merge_norm(const Params& p, int gw, int NGW, int lane) {
    const bf16_t* ONA = (const bf16_t*)(p.ws + WS_ONA); const bf16_t* OD = (const bf16_t*)(p.ws + WS_OD); const float* LSE = (const float*)(p.ws + WS_LSE);
    bf16_t* Hn = (bf16_t*)(p.ws + WS_H);
    const __amdgpu_buffer_rsrc_t hrs = pg8::wt_rsrc(Hn);
    for (int t = gw; t < TOK; t += NGW) {
        float na[8], d0[8], d1[8], d2[8];
        unpack8(__builtin_nontemporal_load((const u32x4*)(ONA + (size_t)t * 512 + 8 * lane)), na);
        unpack8(__builtin_nontemporal_load((const u32x4*)(OD + (size_t)t * 512 + 8 * lane)), d0);
        unpack8(__builtin_nontemporal_load((const u32x4*)(OD + ((size_t)TOK + t) * 512 + 8 * lane)), d1);
        unpack8(__builtin_nontemporal_load((const u32x4*)(OD + ((size_t)2 * TOK + t) * 512 + 8 * lane)), d2);
        const int hh = lane >> 3;
        const float l0 = LSE[(size_t)t * 8 + hh], l1 = LSE[((size_t)TOK + t) * 8 + hh], l2 = LSE[((size_t)2 * TOK + t) * 8 + hh];
        const float m = fmaxf(l0, fmaxf(l1, l2));
        const float e0 = __builtin_amdgcn_exp2f(l0 - m), e1 = __builtin_amdgcn_exp2f(l1 - m), e2 = __builtin_amdgcn_exp2f(l2 - m), ie = 1.f / (e0 + e1 + e2);
        const float al0 = e0 * ie, al1 = e1 * ie, al2 = e2 * ie;
        float ssa = 0.f, ssb = 0.f, dl[8];
#pragma unroll
        for (int k = 0; k < 8; ++k) { dl[k] = al0 * d0[k] + al1 * d1[k] + al2 * d2[k]; ssa += na[k] * na[k]; ssb += dl[k] * dl[k]; }
        const float rsa = rsqrtf(wave_sum(ssa) * (1.f / 512.f) + EPS), rsb = rsqrtf(wave_sum(ssb) * (1.f / 512.f) + EPS);
        u32x4 wa, wb;
        wa.x = pkbf(na[0] * rsa, na[1] * rsa); wa.y = pkbf(na[2] * rsa, na[3] * rsa); wa.z = pkbf(na[4] * rsa, na[5] * rsa); wa.w = pkbf(na[6] * rsa, na[7] * rsa);
        wb.x = pkbf(dl[0] * rsb, dl[1] * rsb); wb.y = pkbf(dl[2] * rsb, dl[3] * rsb); wb.z = pkbf(dl[4] * rsb, dl[5] * rsb); wb.w = pkbf(dl[6] * rsb, dl[7] * rsb);
        pg8::wt_store16(hrs, ((size_t)t * DM + 8 * lane) * 2, wa);
        pg8::wt_store16(hrs, ((size_t)t * DM + 512 + 8 * lane) * 2, wb);
    }
}

__device__ __forceinline__ void ce(float& a, float& b) { const float hi = fmaxf(a, b), lo = fminf(a, b); a = hi; b = lo; }
template <int N> __device__ __forceinline__ void bitonic_sort_desc(float (&v)[N]) {
#pragma unroll
    for (int k = 2; k <= N; k <<= 1)
#pragma unroll
        for (int j = k >> 1; j > 0; j >>= 1)
#pragma unroll
            for (int i = 0; i < N; ++i) { const int l = i ^ j; if (l > i) { if ((i & k) == 0) ce(v[i], v[l]); else ce(v[l], v[i]); } }
}
__device__ __forceinline__ void sort16_desc(float (&v)[16]) {
    ce(v[0], v[1]); ce(v[2], v[3]); ce(v[0], v[2]); ce(v[1], v[3]); ce(v[1], v[2]); ce(v[4], v[5]); ce(v[6], v[7]); ce(v[4], v[6]); ce(v[5], v[7]); ce(v[5], v[6]); ce(v[0], v[4]); ce(v[2], v[6]); ce(v[2], v[4]); ce(v[1], v[5]); ce(v[3], v[7]); ce(v[3], v[5]); ce(v[1], v[2]); ce(v[3], v[4]); ce(v[5], v[6]); ce(v[8], v[9]); ce(v[10], v[11]); ce(v[8], v[10]); ce(v[9], v[11]); ce(v[9], v[10]); ce(v[12], v[13]); ce(v[14], v[15]); ce(v[12], v[14]); ce(v[13], v[15]); ce(v[13], v[14]); ce(v[8], v[12]); ce(v[10], v[14]); ce(v[10], v[12]); ce(v[9], v[13]); ce(v[11], v[15]); ce(v[11], v[13]); ce(v[9], v[10]); ce(v[11], v[12]); ce(v[13], v[14]); ce(v[0], v[8]); ce(v[4], v[12]); ce(v[4], v[8]); ce(v[2], v[10]); ce(v[6], v[14]); ce(v[6], v[10]); ce(v[2], v[4]); ce(v[6], v[8]); ce(v[10], v[12]); ce(v[1], v[9]); ce(v[5], v[13]); ce(v[5], v[9]); ce(v[3], v[11]); ce(v[7], v[15]); ce(v[7], v[11]); ce(v[3], v[5]); ce(v[7], v[9]); ce(v[11], v[13]); ce(v[1], v[2]); ce(v[3], v[4]); ce(v[5], v[6]); ce(v[7], v[8]); ce(v[9], v[10]); ce(v[11], v[12]); ce(v[13], v[14]);
}
template <int N> __device__ __forceinline__ void bitonic_merge_desc(float (&v)[N]) {
#pragma unroll
    for (int j = N >> 1; j > 0; j >>= 1)
#pragma unroll
        for (int i = 0; i < N; ++i) if ((i & j) == 0) ce(v[i], v[i | j]);
}
__device__ __forceinline__ float h2f_lo(unsigned u) { return (float)__builtin_bit_cast(_Float16, (unsigned short)(u & 0xffffu)); }
__device__ __forceinline__ float h2f_hi(unsigned u) { return (float)__builtin_bit_cast(_Float16, (unsigned short)(u >> 16)); }
__device__ __forceinline__ void top16_of_128(const LAS unsigned char* row, float (&run)[16]) {
#pragma unroll
    for (int gi = 0; gi < 8; ++gi) {
        float grp[16];
#pragma unroll
        for (int q4 = 0; q4 < 2; ++q4) { const u32x4 v = *(const LAS u32x4*)(row + gi * 32 + q4 * 16);
#pragma unroll
            for (int e = 0; e < 4; ++e) {
                grp[8 * q4 + 2 * e] = __uint_as_float(__float_as_uint(h2f_lo(v[e])) | (unsigned)(gi * 16 + 8 * q4 + 2 * e));
                grp[8 * q4 + 2 * e + 1] = __uint_as_float(__float_as_uint(h2f_hi(v[e])) | (unsigned)(gi * 16 + 8 * q4 + 2 * e + 1)); } }
        sort16_desc(grp);
        if (gi == 0) {
#pragma unroll
            for (int i = 0; i < 16; ++i) run[i] = grp[i];
        } else {
#pragma unroll
            for (int i = 0; i < 16; ++i) run[i] = fmaxf(run[i], grp[15 - i]);
            bitonic_merge_desc<16>(run);
        }
    }
}
#define CAND(i, j) __uint_as_float((__float_as_uint(v1[i] + v2[j]) & ~0xFFu) | (unsigned)((i) * 16 + (j)))
constexpr int TK_ROW = 272;
__device__ __forceinline__ void tk_stage(const _Float16* SC, LAS unsigned char* wb, int t0, int col0, int lane) {
    u32x4 v[16];
#pragma unroll
    for (int i = 0; i < 16; ++i) { const int pi = i * 64 + lane, row = pi >> 4, ch = pi & 15; v[i] = __builtin_nontemporal_load((const u32x4*)(SC + (size_t)(t0 + row) * NPQ + col0 + ch * 8)); }
#pragma unroll
    for (int i = 0; i < 16; ++i) { const int pi = i * 64 + lane, row = pi >> 4, ch = pi & 15; *(LAS u32x4*)(wb + row * TK_ROW + ch * 16) = v[i]; }
}
__device__ __forceinline__ void topk_phase(const Params& p, LAS unsigned char* lds, int gw, int NGW, int lane, int wave) {
    const _Float16* SC = (const _Float16*)(p.ws + WS_SC);
    int* IDS = (int*)(p.ws + WS_IDS); float* GATES = (float*)(p.ws + WS_GATES);
    LAS unsigned char* wb = lds + wave * (64 * TK_ROW);
    LAS unsigned char* my = wb + lane * TK_ROW;
    const float NEG = -3.0e38f;
    for (int wi = gw; wi < (TOK / 64) * 8; wi += NGW) {
        const int t0 = (wi >> 3) * 64, hh = wi & 7, it = (t0 + lane) * 8 + hh;
        float v1[16], v2[16];
        tk_stage(SC, wb, t0, hh * 256, lane);
        top16_of_128(my, v1);
        tk_stage(SC, wb, t0, hh * 256 + 128, lane);
        top16_of_128(my, v2);
        {
            u32x4 w1, w2;
#define PK4(v, o) ((__float_as_uint(v[o]) & 0x7Fu) | ((__float_as_uint(v[o + 1]) & 0x7Fu) << 8) | ((__float_as_uint(v[o + 2]) & 0x7Fu) << 16) | ((__float_as_uint(v[o + 3]) & 0x7Fu) << 24))
            w1.x = PK4(v1, 0); w1.y = PK4(v1, 4); w1.z = PK4(v1, 8); w1.w = PK4(v1, 12);
            w2.x = PK4(v2, 0); w2.y = PK4(v2, 4); w2.z = PK4(v2, 8); w2.w = PK4(v2, 12);
#undef PK4
            *(LAS u32x4*)my = w1; *(LAS u32x4*)(my + 16) = w2;
        }
        float best[16], grp[16];
        best[0] = CAND(0, 0); best[1] = CAND(0, 1); best[2] = CAND(0, 2); best[3] = CAND(0, 3); best[4] = CAND(0, 4); best[5] = CAND(0, 5); best[6] = CAND(0, 6); best[7] = CAND(0, 7);
        best[8] = CAND(0, 8); best[9] = CAND(0, 9); best[10] = CAND(0, 10); best[11] = CAND(0, 11); best[12] = CAND(0, 12); best[13] = CAND(0, 13); best[14] = CAND(0, 14); best[15] = CAND(0, 15);
        sort16_desc(best);
        grp[0] = CAND(1, 0); grp[1] = CAND(1, 1); grp[2] = CAND(1, 2); grp[3] = CAND(1, 3); grp[4] = CAND(1, 4); grp[5] = CAND(1, 5); grp[6] = CAND(1, 6); grp[7] = CAND(1, 7);
        grp[8] = CAND(2, 0); grp[9] = CAND(2, 1); grp[10] = CAND(2, 2); grp[11] = CAND(2, 3); grp[12] = CAND(2, 4); grp[13] = CAND(3, 0); grp[14] = CAND(3, 1); grp[15] = CAND(3, 2);
        sort16_desc(grp);
#pragma unroll
        for (int i = 0; i < 16; ++i) best[i] = fmaxf(best[i], grp[15 - i]);
        bitonic_merge_desc<16>(best);
        grp[0] = CAND(3, 3); grp[1] = CAND(4, 0); grp[2] = CAND(4, 1); grp[3] = CAND(4, 2); grp[4] = CAND(5, 0); grp[5] = CAND(5, 1); grp[6] = CAND(6, 0); grp[7] = CAND(6, 1);
        grp[8] = CAND(7, 0); grp[9] = CAND(7, 1); grp[10] = CAND(8, 0); grp[11] = CAND(9, 0); grp[12] = CAND(10, 0); grp[13] = CAND(11, 0); grp[14] = CAND(12, 0); grp[15] = CAND(13, 0);
        sort16_desc(grp);
#pragma unroll
        for (int i = 0; i < 16; ++i) best[i] = fmaxf(best[i], grp[15 - i]);
        bitonic_merge_desc<16>(best);
        grp[0] = CAND(14, 0); grp[1] = CAND(15, 0);
#pragma unroll
        for (int i = 2; i < 16; ++i) grp[i] = NEG;
        sort16_desc(grp);
#pragma unroll
        for (int i = 0; i < 16; ++i) best[i] = fmaxf(best[i], grp[15 - i]);
        bitonic_merge_desc<16>(best);
        float e[16], sum = 0.f;
#pragma unroll
        for (int k = 0; k < 16; ++k) { e[k] = __expf(best[k] - best[0]); sum += e[k]; }
        const float isum = 1.f / sum;
        int idv[16];
        asm volatile("s_waitcnt lgkmcnt(0)" ::: "memory");
#pragma unroll
        for (int k = 0; k < 16; ++k) { const unsigned code = __float_as_uint(best[k]) & 0xFFu; const unsigned i1 = my[code >> 4], i2 = my[16 + (code & 15u)]; idv[k] = (int)(i1 * 128u + i2); }
        const int tt = it >> 3;
        int* ip = IDS + (size_t)tt * 128 + 2 * hh; float* gp = GATES + (size_t)tt * 128 + 2 * hh;
#pragma unroll
        for (int j = 0; j < 8; ++j) {
            *(u32x2*)(ip + 16 * j) = (u32x2){(unsigned)idv[j], (unsigned)idv[j + 8]};
            *(f32x2_t*)(gp + 16 * j) = (f32x2_t){e[j] * isum, e[j + 8] * isum};
        }
    }
}
#undef CAND

struct Topo { int xi, nx, rank, nloc; };
constexpr int CW_XCNT = 8192;
__device__ __forceinline__ float wave_max(float v) {
#pragma unroll
    for (int o = 1; o < 64; o <<= 1) v = fmaxf(v, __shfl_xor(v, o));
    return v;
}
__device__ __forceinline__ unsigned pack4(int a, int b, int c, int d) { return ((unsigned)a & 255u) | (((unsigned)b & 255u) << 8) | (((unsigned)c & 255u) << 16) | ((unsigned)d << 24); }
template <int CTRL> __device__ __forceinline__ int dppi(int v) { return __builtin_amdgcn_update_dpp(0, v, CTRL, 0xF, 0xF, false); }

#define PE_LOAD_IDS(ids, tok) do { const u32x4* ip_ = (const u32x4*)(IDST + (size_t)(tok) * 128 + 16 * j); ids[0] = ip_[0]; ids[1] = ip_[1]; ids[2] = ip_[2]; ids[3] = ip_[3]; } while (0)
#define PE_LOAD_SEGS(seg, ids, tab) do { _Pragma("unroll") for (int i_ = 0; i_ < 16; ++i_) seg[i_] = *(const u32x4*)((tab) + (size_t)ids[i_ >> 2][i_ & 3] * 128); } while (0)

__device__ __forceinline__ void pe_u_compute(const u32x4 (&seg)[16], const u32x4 h8, unsigned* dst, bool live, int lane) {
    int a[16];
#pragma unroll
    for (int i = 0; i < 16; ++i) { int s_ = 0;
#pragma unroll
        for (int w = 0; w < 4; ++w) s_ = __builtin_amdgcn_sdot4((int)seg[i][w], (int)h8[w], s_, false);
        a[i] = s_; }
    const bool q2 = (lane & 4) != 0, q1 = (lane & 2) != 0, q0 = (lane & 1) != 0;
    int c[8], d[4], e[2];
#pragma unroll
    for (int i = 0; i < 8; ++i) { const int keep = q2 ? a[i + 8] : a[i], send = q2 ? a[i] : a[i + 8]; c[i] = keep + dppi<0x141>(send); }
#pragma unroll
    for (int i = 0; i < 4; ++i) { const int keep = q1 ? c[i + 4] : c[i], send = q1 ? c[i] : c[i + 4]; d[i] = keep + dppi<0x4E>(send); }
#pragma unroll
    for (int i = 0; i < 2; ++i) { const int keep = q0 ? d[i + 2] : d[i], send = q0 ? d[i] : d[i + 2]; e[i] = keep + dppi<0xB1>(send); }
    if (live) *dst = pkh((float)e[0] * (1.f / 64.f), (float)e[1] * (1.f / 64.f));
}
__device__ __forceinline__ void peer_u_phase(const Params& p, const Topo& tp, int lane, int wave) {
    const int* IDST = (const int*)(p.ws + WS_IDS); const unsigned char* H8 = p.ws + WS_H8; unsigned* PART = (unsigned*)(p.ws + WS_PART);
    const int j = lane >> 3, q = lane & 7;
    const int wv = tp.rank * 8 + wave, nwv = tp.nloc * 8;
    for (int s = tp.xi; s < 8; s += tp.nx) {
        const unsigned char* tab = p.ws + WS_UH + (size_t)s * NEXP * 128 + 16 * q;
        const unsigned char* hb = H8 + 128 * s + 16 * q;
        unsigned* pb = PART + (size_t)s * TOK * 64 + j * 8 + q;
        u32x4 idsA[4], idsB[4], segA[16], segB[16], h8A, h8B;
        int t = wv;
#define TC(x) ((x) < TOK ? (x) : TOK - 1)
        PE_LOAD_IDS(idsA, TC(t));
        PE_LOAD_IDS(idsB, TC(t + nwv));
        PE_LOAD_SEGS(segA, idsA, tab); h8A = *(const u32x4*)(hb + (size_t)TC(t) * 1024);
        for (; t < TOK; t += 8 * nwv) {
            PE_LOAD_IDS(idsA, TC(t + (2 + 0) * nwv));
            __builtin_amdgcn_sched_barrier(0);
            PE_LOAD_SEGS(segB, idsB, tab); h8B = *(const u32x4*)(hb + (size_t)TC(t + (1 + 0) * nwv) * 1024);
            __builtin_amdgcn_sched_barrier(0);
            pe_u_compute(segA, h8A, pb + (size_t)TC(t + (0) * nwv) * 64, t + (0) * nwv < TOK, lane);
            PE_LOAD_IDS(idsB, TC(t + (3 + 0) * nwv));
            __builtin_amdgcn_sched_barrier(0);
            PE_LOAD_SEGS(segA, idsA, tab); h8A = *(const u32x4*)(hb + (size_t)TC(t + (2 + 0) * nwv) * 1024);
            __builtin_amdgcn_sched_barrier(0);
            pe_u_compute(segB, h8B, pb + (size_t)TC(t + (1 + 0) * nwv) * 64, t + (1 + 0) * nwv < TOK, lane);
            PE_LOAD_IDS(idsA, TC(t + (2 + 2) * nwv));
            __builtin_amdgcn_sched_barrier(0);
            PE_LOAD_SEGS(segB, idsB, tab); h8B = *(const u32x4*)(hb + (size_t)TC(t + (1 + 2) * nwv) * 1024);
            __builtin_amdgcn_sched_barrier(0);
            pe_u_compute(segA, h8A, pb + (size_t)TC(t + (2) * nwv) * 64, t + (2) * nwv < TOK, lane);
            PE_LOAD_IDS(idsB, TC(t + (3 + 2) * nwv));
            __builtin_amdgcn_sched_barrier(0);
            PE_LOAD_SEGS(segA, idsA, tab); h8A = *(const u32x4*)(hb + (size_t)TC(t + (2 + 2) * nwv) * 1024);
            __builtin_amdgcn_sched_barrier(0);
            pe_u_compute(segB, h8B, pb + (size_t)TC(t + (1 + 2) * nwv) * 64, t + (1 + 2) * nwv < TOK, lane);
            PE_LOAD_IDS(idsA, TC(t + (2 + 4) * nwv));
            __builtin_amdgcn_sched_barrier(0);
            PE_LOAD_SEGS(segB, idsB, tab); h8B = *(const u32x4*)(hb + (size_t)TC(t + (1 + 4) * nwv) * 1024);
            __builtin_amdgcn_sched_barrier(0);
            pe_u_compute(segA, h8A, pb + (size_t)TC(t + (4) * nwv) * 64, t + (4) * nwv < TOK, lane);
            PE_LOAD_IDS(idsB, TC(t + (3 + 4) * nwv));
            __builtin_amdgcn_sched_barrier(0);
            PE_LOAD_SEGS(segA, idsA, tab); h8A = *(const u32x4*)(hb + (size_t)TC(t + (2 + 4) * nwv) * 1024);
            __builtin_amdgcn_sched_barrier(0);
            pe_u_compute(segB, h8B, pb + (size_t)TC(t + (1 + 4) * nwv) * 64, t + (1 + 4) * nwv < TOK, lane);
            PE_LOAD_IDS(idsA, TC(t + (2 + 6) * nwv));
            __builtin_amdgcn_sched_barrier(0);
            PE_LOAD_SEGS(segB, idsB, tab); h8B = *(const u32x4*)(hb + (size_t)TC(t + (1 + 6) * nwv) * 1024);
            __builtin_amdgcn_sched_barrier(0);
            pe_u_compute(segA, h8A, pb + (size_t)TC(t + (6) * nwv) * 64, t + (6) * nwv < TOK, lane);
            PE_LOAD_IDS(idsB, TC(t + (3 + 6) * nwv));
            __builtin_amdgcn_sched_barrier(0);
            PE_LOAD_SEGS(segA, idsA, tab); h8A = *(const u32x4*)(hb + (size_t)TC(t + (2 + 6) * nwv) * 1024);
            __builtin_amdgcn_sched_barrier(0);
            pe_u_compute(segB, h8B, pb + (size_t)TC(t + (1 + 6) * nwv) * 64, t + (1 + 6) * nwv < TOK, lane);
        }
    }
}
__device__ __forceinline__ void peer_w_phase(const Params& p, int gw, int NGW, int lane) {
    const int* IDST = (const int*)(p.ws + WS_IDS); const float* GT = (const float*)(p.ws + WS_GATES); const unsigned* PART = (const unsigned*)(p.ws + WS_PART);
    const float* SU = (const float*)(p.ws + WS_SU); const float* SV = (const float*)(p.ws + WS_SV); const float* SH = (const float*)(p.ws + WS_SH);
    unsigned short* W8 = (unsigned short*)(p.ws + WS_W8); float* SW = (float*)(p.ws + WS_SW);
    for (int t = gw; t < TOK; t += NGW) {
        const size_t ix = (size_t)t * 128 + 2 * lane;
        float a0 = 0.f, a1 = 0.f;
#pragma unroll
        for (int s = 0; s < 8; ++s) { const unsigned v = __builtin_nontemporal_load(PART + (size_t)s * TOK * 64 + (ix >> 1)); a0 += h2f_lo(v); a1 += h2f_hi(v); }
        const u32x2 id = *(const u32x2*)(IDST + ix); const f32x2_t g = *(const f32x2_t*)(GT + ix);
        const float sh = SH[t];
        const float x0 = a0 * 64.f * SU[id.x] * sh, x1 = a1 * 64.f * SU[id.y] * sh;
        const float w0 = g.x * 0.5f * x0 * (1.f + erff(x0 * 0.70710678118654752f)) * SV[id.x];
        const float w1 = g.y * 0.5f * x1 * (1.f + erff(x1 * 0.70710678118654752f)) * SV[id.y];
        const float wm = wave_max(fmaxf(fabsf(w0), fabsf(w1)));
        const float inv = wm > 0.f ? 127.f / wm : 0.f;
        W8[ix >> 1] = (unsigned short)(((unsigned)((int)rintf(w0 * inv)) & 255u) | (((unsigned)((int)rintf(w1 * inv)) & 255u) << 8));
        if (lane == 0) SW[t] = wm * (1.f / 127.f);
    }
}
__device__ __forceinline__ void pe_v_compute(const u32x4 (&seg)[16], const u32x4 w8, float sw, bf16_t* dst, bool live, int lane) {
    int o[16];
#pragma unroll
    for (int i = 0; i < 16; ++i) o[i] = 0;
#pragma unroll
    for (int qd = 0; qd < 4; ++qd)
#pragma unroll
        for (int w = 0; w < 4; ++w) {
            const unsigned ra = seg[4 * qd][w], rb = seg[4 * qd + 1][w], rc = seg[4 * qd + 2][w], rd = seg[4 * qd + 3][w];
            const unsigned abl = __builtin_amdgcn_perm(rb, ra, 0x05010400u), abh = __builtin_amdgcn_perm(rb, ra, 0x07030602u);
            const unsigned cdl = __builtin_amdgcn_perm(rd, rc, 0x05010400u), cdh = __builtin_amdgcn_perm(rd, rc, 0x07030602u);
            o[4 * w + 0] = __builtin_amdgcn_sdot4((int)__builtin_amdgcn_perm(cdl, abl, 0x05040100u), (int)w8[qd], o[4 * w + 0], false);
            o[4 * w + 1] = __builtin_amdgcn_sdot4((int)__builtin_amdgcn_perm(cdl, abl, 0x07060302u), (int)w8[qd], o[4 * w + 1], false);
            o[4 * w + 2] = __builtin_amdgcn_sdot4((int)__builtin_amdgcn_perm(cdh, abh, 0x05040100u), (int)w8[qd], o[4 * w + 2], false);
            o[4 * w + 3] = __builtin_amdgcn_sdot4((int)__builtin_amdgcn_perm(cdh, abh, 0x07060302u), (int)w8[qd], o[4 * w + 3], false);
        }
    int b[8], c[4], d[2];
#pragma unroll
    for (int m = 0; m < 8; ++m) { auto r = __builtin_amdgcn_permlane32_swap((unsigned)o[m], (unsigned)o[m + 8], false, false); b[m] = (int)r[0] + (int)r[1]; }
#pragma unroll
    for (int m = 0; m < 4; ++m) { auto r = __builtin_amdgcn_permlane16_swap((unsigned)b[m], (unsigned)b[m + 4], false, false); c[m] = (int)r[0] + (int)r[1]; }
    const bool b3 = (lane & 8) != 0;
#pragma unroll
    for (int m = 0; m < 2; ++m) { const int keep = b3 ? c[m + 2] : c[m], send = b3 ? c[m] : c[m + 2]; d[m] = keep + dppi<0x128>(send); }
    if (live) *(unsigned*)dst = pkbf((float)d[0] * sw, (float)d[1] * sw);
}
__device__ __forceinline__ void peer_v_phase(const Params& p, const Topo& tp, int lane, int wave) {
    const int* IDST = (const int*)(p.ws + WS_IDS); const unsigned char* W8 = p.ws + WS_W8; const float* SW = (const float*)(p.ws + WS_SW); bf16_t* PEER = (bf16_t*)(p.ws + WS_PEER);
    const int j = lane >> 3, q = lane & 7;
    const int wv = tp.rank * 8 + wave, nwv = tp.nloc * 8;
    for (int s = tp.xi; s < 8; s += tp.nx) {
        const unsigned char* tab = p.ws + WS_VH + (size_t)s * NEXP * 128 + 16 * q;
        const unsigned char* wb = W8 + 16 * j;
        bf16_t* ob = PEER + 128 * s + 16 * q + 2 * j;
        u32x4 idsA[4], idsB[4], segA[16], segB[16], w8A, w8B; float swA, swB;
        int t = wv;
        PE_LOAD_IDS(idsA, TC(t));
        PE_LOAD_IDS(idsB, TC(t + nwv));
        PE_LOAD_SEGS(segA, idsA, tab); w8A = *(const u32x4*)(wb + (size_t)TC(t) * 128); swA = SW[TC(t)];
        for (; t < TOK; t += 8 * nwv) {
            PE_LOAD_IDS(idsA, TC(t + (2 + 0) * nwv));
            __builtin_amdgcn_sched_barrier(0);
            PE_LOAD_SEGS(segB, idsB, tab); w8B = *(const u32x4*)(wb + (size_t)TC(t + (1 + 0) * nwv) * 128); swB = SW[TC(t + (1 + 0) * nwv)];
            __builtin_amdgcn_sched_barrier(0);
            pe_v_compute(segA, w8A, swA, ob + (size_t)TC(t + (0) * nwv) * DM, t + (0) * nwv < TOK, lane);
            PE_LOAD_IDS(idsB, TC(t + (3 + 0) * nwv));
            __builtin_amdgcn_sched_barrier(0);
            PE_LOAD_SEGS(segA, idsA, tab); w8A = *(const u32x4*)(wb + (size_t)TC(t + (2 + 0) * nwv) * 128); swA = SW[TC(t + (2 + 0) * nwv)];
            __builtin_amdgcn_sched_barrier(0);
            pe_v_compute(segB, w8B, swB, ob + (size_t)TC(t + (1 + 0) * nwv) * DM, t + (1 + 0) * nwv < TOK, lane);
            PE_LOAD_IDS(idsA, TC(t + (2 + 2) * nwv));
            __builtin_amdgcn_sched_barrier(0);
            PE_LOAD_SEGS(segB, idsB, tab); w8B = *(const u32x4*)(wb + (size_t)TC(t + (1 + 2) * nwv) * 128); swB = SW[TC(t + (1 + 2) * nwv)];
            __builtin_amdgcn_sched_barrier(0);
            pe_v_compute(segA, w8A, swA, ob + (size_t)TC(t + (2) * nwv) * DM, t + (2) * nwv < TOK, lane);
            PE_LOAD_IDS(idsB, TC(t + (3 + 2) * nwv));
            __builtin_amdgcn_sched_barrier(0);
            PE_LOAD_SEGS(segA, idsA, tab); w8A = *(const u32x4*)(wb + (size_t)TC(t + (2 + 2) * nwv) * 128); swA = SW[TC(t + (2 + 2) * nwv)];
            __builtin_amdgcn_sched_barrier(0);
            pe_v_compute(segB, w8B, swB, ob + (size_t)TC(t + (1 + 2) * nwv) * DM, t + (1 + 2) * nwv < TOK, lane);
            PE_LOAD_IDS(idsA, TC(t + (2 + 4) * nwv));
            __builtin_amdgcn_sched_barrier(0);
            PE_LOAD_SEGS(segB, idsB, tab); w8B = *(const u32x4*)(wb + (size_t)TC(t + (1 + 4) * nwv) * 128); swB = SW[TC(t + (1 + 4) * nwv)];
            __builtin_amdgcn_sched_barrier(0);
            pe_v_compute(segA, w8A, swA, ob + (size_t)TC(t + (4) * nwv) * DM, t + (4) * nwv < TOK, lane);
            PE_LOAD_IDS(idsB, TC(t + (3 + 4) * nwv));
            __builtin_amdgcn_sched_barrier(0);
            PE_LOAD_SEGS(segA, idsA, tab); w8A = *(const u32x4*)(wb + (size_t)TC(t + (2 + 4) * nwv) * 128); swA = SW[TC(t + (2 + 4) * nwv)];
            __builtin_amdgcn_sched_barrier(0);
            pe_v_compute(segB, w8B, swB, ob + (size_t)TC(t + (1 + 4) * nwv) * DM, t + (1 + 4) * nwv < TOK, lane);
            PE_LOAD_IDS(idsA, TC(t + (2 + 6) * nwv));
            __builtin_amdgcn_sched_barrier(0);
            PE_LOAD_SEGS(segB, idsB, tab); w8B = *(const u32x4*)(wb + (size_t)TC(t + (1 + 6) * nwv) * 128); swB = SW[TC(t + (1 + 6) * nwv)];
            __builtin_amdgcn_sched_barrier(0);
            pe_v_compute(segA, w8A, swA, ob + (size_t)TC(t + (6) * nwv) * DM, t + (6) * nwv < TOK, lane);
            PE_LOAD_IDS(idsB, TC(t + (3 + 6) * nwv));
            __builtin_amdgcn_sched_barrier(0);
            PE_LOAD_SEGS(segA, idsA, tab); w8A = *(const u32x4*)(wb + (size_t)TC(t + (2 + 6) * nwv) * 128); swA = SW[TC(t + (2 + 6) * nwv)];
            __builtin_amdgcn_sched_barrier(0);
            pe_v_compute(segB, w8B, swB, ob + (size_t)TC(t + (1 + 6) * nwv) * DM, t + (1 + 6) * nwv < TOK, lane);
        }
    }
}
#undef TC
#undef PE_LOAD_IDS
#undef PE_LOAD_SEGS
__device__ __forceinline__ void final_phase(const Params& p, float* dstbase, int gw, int NGW, int lane) {
    const float* mod = (const float*)(p.ws + WS_MOD); const bf16_t* PEER = (const bf16_t*)(p.ws + WS_PEER);
    f32x4 fg[4];
#pragma unroll
    for (int j = 0; j < 4; ++j) fg[j] = *(const f32x4*)(p.final_g + 4 * lane + 256 * j);
    const __amdgpu_buffer_rsrc_t ors = pg8::wt_rsrc(dstbase);
    for (int t = gw; t < TOK; t += NGW) {
        const float* mb = mod + (size_t)(t >> 11) * 6144 + 5120;
        const f32x4* xr = (const f32x4*)(p.x + (size_t)t * DM) + lane; const u32x2* pr = (const u32x2*)(PEER + (size_t)t * DM) + lane; const u32x2* zr = (const u32x2*)((const bf16_t*)(p.ws + WS_Z) + (size_t)t * DM) + lane;
        f32x4* xw = (f32x4*)(dstbase + (size_t)t * DM) + lane;
        f32x4 x2[4]; float ss = 0.f;
#pragma unroll
        for (int j = 0; j < 4; ++j) { const f32x4 g2 = *(const f32x4*)(mb + 4 * lane + 256 * j); const u32x2 pv = __builtin_nontemporal_load(pr + 64 * j), zv = __builtin_nontemporal_load(zr + 64 * j); x2[j] = __builtin_nontemporal_load(xr + 64 * j) + (f32x4){bf_lo(zv.x), bf_hi(zv.x), bf_lo(zv.y), bf_hi(zv.y)} + g2 * (f32x4){bf_lo(pv.x), bf_hi(pv.x), bf_lo(pv.y), bf_hi(pv.y)};
            ss += (x2[j][0] * x2[j][0] + x2[j][1] * x2[j][1]) + (x2[j][2] * x2[j][2] + x2[j][3] * x2[j][3]); }
        const float rs = rsqrtf(wave_sum(ss) * (1.f / DM) + EPS);
#pragma unroll
        for (int j = 0; j < 4; ++j) pg8::wt_store16(ors, ((size_t)t * DM + 4 * lane + 256 * j) * 4, __builtin_bit_cast(u32x4, x2[j] * rs * fg[j]));
    }
}

__global__ void __launch_bounds__(512, 2) mk_fwd(Params p) {
    extern __shared__ __attribute__((aligned(16))) unsigned char lds_raw[];
    LAS unsigned char* lds = (LAS unsigned char*)lds_raw;
    const int tid = threadIdx.x, lane = tid & 63, wave = __builtin_amdgcn_readfirstlane(tid >> 6);
    const int G = gridDim.x, bx = blockIdx.x;
    const int vcu = (G % 8 == 0) ? (bx % 8) * (G / 8) + bx / 8 : bx;
    const int gw = vcu * 8 + wave, NGW = G * 8;
    const float* mod = (const float*)(p.ws + WS_MOD);
    bf16_t* Hb = (bf16_t*)(p.ws + WS_H);
#if MK_COOP
    volatile LAS unsigned* bst = (volatile LAS unsigned*)(lds + LDS_BYTES - 16);
    if (tid < 4) bst[tid] = 0u;
    __syncthreads();
    const XcdBarrier xb = xcd_barrier_post((unsigned*)(p.ws + WS_CTL) + 1024, bst);
    if (tid == 0) bst[2] = __hip_atomic_fetch_add((unsigned*)(p.ws + WS_CTL) + CW_XCNT + 64 * xb.x, 1u, __ATOMIC_RELAXED, __HIP_MEMORY_SCOPE_AGENT);
#define PHASE_END(k) do { if ((k) + 1 < p.ph_hi) xcd_barrier(xb); } while (0)
#else
#define PHASE_END(k) do { } while (0)
#endif
#define IN(k) (p.ph_lo <= (k) && (k) < p.ph_hi)
    if (IN(0)) { p0_mod(p, lds, tid, lane, wave); PHASE_END(0); }
    if (IN(1)) { p0_weights(p, lds, tid, lane, wave); norm_rows<false>(p.x, nullptr, p.norm1_g, mod, 0, 1024, Hb, nullptr, nullptr, gw, NGW, lane); PHASE_END(1); }
    if (IN(2)) {
        pg8::Gemm g{Hb, (const bf16_t*)(p.ws + WS_WIN), TOK, NQKV, DM}; pg8::StaticOrder S; S.init(TOK, NQKV, G, bx);
        pg8::EpiQKV E{(bf16_t*)(p.ws + WS_QKV), NQKV, QSCALE};
        pg8::gemm_phase<pg8::EpiQKV, pg8::StaticOrder, true, true>(lds, g, S, E);
        PHASE_END(2);
    }
    if (IN(3)) { attn_phase(p, lds, tid, lane, wave, vcu, G); PHASE_END(3); }
    if (IN(4)) { merge_norm(p, gw, NGW, lane); PHASE_END(4); }
    if (IN(5)) {
        pg8::Gemm g{Hb, (const bf16_t*)(p.ws + WS_WOUT), TOK, DM, DM}; pg8::StaticOrder S; S.init(TOK, DM, G, bx);
        pg8::EpiZ E{(bf16_t*)(p.ws + WS_Z), mod};
        pg8::gemm_phase<pg8::EpiZ, pg8::StaticOrder, true, true>(lds, g, S, E);
        PHASE_END(5);
    }
    if (IN(6)) { norm_rows<true>(p.x, (const bf16_t*)(p.ws + WS_Z), p.norm2_g, mod, 3072, 4096, Hb, p.ws + WS_H8, (float*)(p.ws + WS_SH), gw, NGW, lane); PHASE_END(6); }
    if (IN(7)) {
        pg8::Gemm g{Hb, (const bf16_t*)(p.ws + WS_WSC), TOK, NPQ, DM}; pg8::StaticOrder S; S.init(TOK, NPQ, G, bx);
        pg8::EpiSC E{(_Float16*)(p.ws + WS_SC), NPQ};
        pg8::gemm_phase<pg8::EpiSC, pg8::StaticOrder, true, true>(lds, g, S, E);
        PHASE_END(7);
    }
    if (IN(8)) { topk_phase(p, lds, gw, NGW, lane, wave); PHASE_END(8); }
    Topo tp; tp.xi = 0; tp.nx = 1; tp.rank = bx; tp.nloc = G;
#if MK_COOP
    if (IN(9) || IN(11)) {
        const unsigned* xc = (const unsigned*)(p.ws + WS_CTL) + CW_XCNT; int nx = 0, xi = 0, nloc = 1;
        for (int jx = 0; jx < 16; ++jx) { const unsigned cnt = __hip_atomic_load(xc + 64 * jx, __ATOMIC_RELAXED, __HIP_MEMORY_SCOPE_AGENT); if (cnt) { if (jx < (int)xb.x) ++xi; if (jx == (int)xb.x) nloc = (int)cnt; ++nx; } }
        tp.xi = xi; tp.nx = nx > 0 ? nx : 1; tp.rank = (int)bst[2]; tp.nloc = nloc;
    }
#endif
    if (IN(9)) { peer_u_phase(p, tp, lane, wave); PHASE_END(9); }
    if (IN(10)) { peer_w_phase(p, gw, NGW, lane); PHASE_END(10); }
    if (IN(11)) { peer_v_phase(p, tp, lane, wave); PHASE_END(11); }
    if (IN(12)) { final_phase(p, p.out, gw, NGW, lane); }
#undef IN
#undef PHASE_END
}

extern "C" void kernel_launch(void* const* d_in, const int* in_sizes, int n_in, void* d_out, int out_size, void* d_ws, size_t ws_size, hipStream_t stream) {
    static int grid = 0;
    if (grid == 0) {
        if (n_in != 16 || in_sizes[0] != TOK * DM || out_size != TOK * DM || ws_size < WS_END) {
            fprintf(stderr, "kernel_launch: unexpected shapes (n_in %d, in0 %d, out %d, ws %zu)\n", n_in, n_in > 0 ? in_sizes[0] : -1, out_size, ws_size); grid = -1; return; }
        int dev = 0, cus = 0, per_cu = 0;
        if (hipGetDevice(&dev) != hipSuccess || hipDeviceGetAttribute(&cus, hipDeviceAttributeMultiprocessorCount, dev) != hipSuccess) { grid = -1; return; }
        if (hipFuncSetAttribute((const void*)mk_fwd, hipFuncAttributeMaxDynamicSharedMemorySize, LDS_BYTES) != hipSuccess) { fprintf(stderr, "kernel_launch: hipFuncSetAttribute failed\n"); grid = -1; return; }
        if (hipOccupancyMaxActiveBlocksPerMultiprocessor(&per_cu, (const void*)mk_fwd, 512, LDS_BYTES) != hipSuccess || per_cu < 1) { fprintf(stderr, "kernel_launch: occupancy query says %d blocks per CU\n", per_cu); per_cu = 1; }
        (void)hipGetLastError();
        grid = cus;
        if (grid > 2048) { fprintf(stderr, "kernel_launch: %d CUs: the attention phase's table-conversion schedule assumes at most 2048 workgroups\n", grid); grid = -1; return; }
    }
    if (grid < 0) return;
    Params p{};
    p.x = (const float*)d_in[0]; p.c = (const float*)d_in[1]; p.ada_w = (const float*)d_in[2]; p.ada_b = (const float*)d_in[3]; p.norm1_g = (const float*)d_in[4];
    p.w_in = (const float*)d_in[5]; p.na_rpb = (const float*)d_in[6]; p.ong_na = (const float*)d_in[7]; p.ong_dil = (const float*)d_in[8]; p.w_out = (const float*)d_in[9];
    p.norm2_g = (const float*)d_in[10]; p.peer_wq = (const float*)d_in[11]; p.peer_sk = (const float*)d_in[12]; p.peer_u = (const float*)d_in[13]; p.peer_v = (const float*)d_in[14];
    p.final_g = (const float*)d_in[15]; p.out = (float*)d_out; p.ws = (unsigned char*)d_ws;
#if MK_COOP
    if (hipMemsetAsync((char*)d_ws + WS_CTL, 0, 65536, stream) != hipSuccess) { fprintf(stderr, "kernel_launch: memset of the barrier words failed\n"); return; }
    p.ph_lo = 0; p.ph_hi = NPHASE;
    void* args[] = {&p};
    const hipError_t e = hipLaunchCooperativeKernel((const void*)mk_fwd, dim3(grid), dim3(512), args, LDS_BYTES, stream);
    if (e != hipSuccess) fprintf(stderr, "kernel_launch: cooperative launch failed: %s (grid %d)\n", hipGetErrorString(e), grid);
#else
    for (int k = 0; k < NPHASE; ++k) { p.ph_lo = k; p.ph_hi = k + 1; hipLaunchKernelGGL(mk_fwd, dim3(grid), dim3(512), LDS_BYTES, stream, p); }
#endif
}
```

```cpp
#include <hip/hip_runtime.h>
#include <cstdio>
#include <cstdint>

#ifndef MK_COOP
#define MK_COOP 1
#endif

constexpr int DM = 1024, BATCH = 16, SEQ = 2048, TOK = BATCH * SEQ;
constexpr int NQKV = 3072, NPQ = 2048, NEXP = 16384;
constexpr float EPS = 1e-6f;
constexpr float LOG2E = 1.4426950408889634f;
constexpr float QSCALE = 0.125f * LOG2E;

constexpr size_t MiB = 1u << 20;
constexpr size_t WS_CTL = 0;
constexpr size_t WS_MOD = 1 * MiB;
constexpr size_t WS_WIN = 2 * MiB;
constexpr size_t WS_WOUT = 8 * MiB;
constexpr size_t WS_WSC = 10 * MiB;
constexpr size_t WS_SU = 14 * MiB;
constexpr size_t WS_SV = 14 * MiB + 65536;
constexpr size_t WS_UH = 16 * MiB;
constexpr size_t WS_VH = 48 * MiB;
constexpr size_t WS_H = 80 * MiB;
constexpr size_t WS_QKV = 144 * MiB;
constexpr size_t WS_ONA = 336 * MiB;
constexpr size_t WS_OD = 368 * MiB;
constexpr size_t WS_LSE = 464 * MiB;
constexpr size_t WS_IDS = 468 * MiB;
constexpr size_t WS_GATES = 484 * MiB;
constexpr size_t WS_SC = 144 * MiB;
constexpr size_t WS_PART = 144 * MiB;
constexpr size_t WS_PEER = 272 * MiB;
constexpr size_t WS_Z = 336 * MiB;
constexpr size_t WS_H8 = 400 * MiB;
constexpr size_t WS_W8 = 432 * MiB;
constexpr size_t WS_SH = 436 * MiB;
constexpr size_t WS_SW = 437 * MiB;
constexpr size_t WS_END = 500 * MiB;

constexpr int LDS_BYTES = 147456;

#define LAS __attribute__((address_space(3)))
typedef unsigned short bf16_t;
typedef short bf16x8 __attribute__((ext_vector_type(8)));
typedef float f32x4 __attribute__((ext_vector_type(4)));
typedef unsigned u32x4 __attribute__((ext_vector_type(4)));
typedef unsigned u32x2 __attribute__((ext_vector_type(2)));
typedef float f32x2_t __attribute__((ext_vector_type(2)));
typedef __bf16 bf16x2_t __attribute__((ext_vector_type(2)));
typedef _Float16 h2_t __attribute__((ext_vector_type(2)));
typedef short v4i16_t __attribute__((ext_vector_type(4)));

__device__ __forceinline__ unsigned pkbf(float lo, float hi) { f32x2_t v = {lo, hi}; bf16x2_t b = __builtin_convertvector(v, bf16x2_t); return __builtin_bit_cast(unsigned, b); }
__device__ __forceinline__ unsigned pkh(float lo, float hi) { h2_t h = {(_Float16)lo, (_Float16)hi}; return __builtin_bit_cast(unsigned, h); }
__device__ __forceinline__ float bf_lo(unsigned u) { return __uint_as_float(u << 16); }
__device__ __forceinline__ float bf_hi(unsigned u) { return __uint_as_float(u & 0xffff0000u); }
__device__ __forceinline__ float wave_sum(float v) {
#pragma unroll
    for (int o = 1; o < 64; o <<= 1) v += __shfl_xor(v, o);
    return v;
}

#define XB_TMO      128
#define XB_XCNT(j)  (256  + 64 * (j))
#define XB_XSUB(j)  (1280 + 64 * (j))
#define XB_XGEN(j)  (2304 + 64 * (j))
#define XB_TOP      3328
#define XB_TOPGEN   3392
#define XCD_BAR_WORDS 3456
#define XB_SPIN_CAP (1u << 18)

__device__ __forceinline__ unsigned xb_ld(unsigned* p)              { return __hip_atomic_load(p, __ATOMIC_RELAXED, __HIP_MEMORY_SCOPE_AGENT); }
__device__ __forceinline__ unsigned xb_add(unsigned* p, unsigned v) { return __hip_atomic_fetch_add(p, v, __ATOMIC_RELAXED, __HIP_MEMORY_SCOPE_AGENT); }
__device__ __forceinline__ unsigned xb_xcc_id() { return (unsigned)__builtin_amdgcn_s_getreg((3 << 11) | 20) & 0xFu; }
#define XB_SPIN(cond, bar) do { unsigned _sp = 0; while (cond) { __builtin_amdgcn_s_sleep(1); \
    if ((++_sp & 255u) == 0u) { if (xb_ld(&(bar)[XB_TMO])) break; if (_sp > XB_SPIN_CAP) { atomicAdd(&(bar)[XB_TMO], 1u); break; } } } } while (0)

struct XcdBarrier {
    unsigned* bar; unsigned x;
    volatile LAS unsigned* st;
};

__device__ __forceinline__ XcdBarrier xcd_barrier_post(unsigned* bar, volatile LAS unsigned* st) {
    XcdBarrier b; b.bar = bar; b.x = xb_xcc_id(); b.st = st;
    if (threadIdx.x == 0) (void)xb_add(&bar[XB_XCNT(b.x)], 1u);
    return b;
}
__device__ __forceinline__ void xcd_barrier_complete(unsigned* bar, unsigned x, unsigned& nloc, unsigned& nx) {
    const unsigned G = gridDim.x * gridDim.y * gridDim.z;
    unsigned sum, cnt, mine, sp = 0u;
    for (;;) {
        sum = 0u; cnt = 0u; mine = 0u;
#pragma unroll
        for (unsigned j = 0; j < 16; ++j) { const unsigned c = xb_ld(&bar[XB_XCNT(j)]); sum += c; cnt += (c > 0u) ? 1u : 0u; mine = (j == x) ? c : mine; }
        if (sum == G) break;
        __builtin_amdgcn_s_sleep(1);
        if ((++sp & 255u) == 0u) { if (xb_ld(&bar[XB_TMO])) break; if (sp > XB_SPIN_CAP) { atomicAdd(&bar[XB_TMO], 1u); break; } }
    }
    nloc = mine > 0u ? mine : 1u; nx = cnt > 0u ? cnt : 1u;
}

__device__ __forceinline__ void xcd_barrier(const XcdBarrier& b) {
    asm volatile("s_waitcnt vmcnt(0)" ::: "memory");
    __syncthreads();
    if (threadIdx.x == 0) {
        unsigned* bar = b.bar;
        __builtin_amdgcn_s_waitcnt(0);
        unsigned nloc = b.st[0], nx = b.st[1];
        if (nloc == 0u) { xcd_barrier_complete(bar, b.x, nloc, nx); b.st[0] = nloc; b.st[1] = nx; }
        const unsigned old = xb_add(&bar[XB_XSUB(b.x)], 1u);
        const unsigned gen = old / nloc;
        if (old + 1u == (gen + 1u) * nloc) {
            __builtin_amdgcn_fence(__ATOMIC_RELEASE, "agent");
            asm volatile("s_waitcnt vmcnt(0)" ::: "memory");
            const unsigned og = xb_add(&bar[XB_TOP], 1u);
            const unsigned tg = og / nx;
            if (og + 1u == (tg + 1u) * nx) xb_add(&bar[XB_TOPGEN], 1u);
            else XB_SPIN(xb_ld(&bar[XB_TOPGEN]) == tg, bar);
            __builtin_amdgcn_fence(__ATOMIC_ACQUIRE, "agent");
            xb_add(&bar[XB_XGEN(b.x)], 1u);
            asm volatile("s_waitcnt vmcnt(0)" ::: "memory");
        } else {
            XB_SPIN(xb_ld(&bar[XB_XGEN(b.x)]) == gen, bar);
            __builtin_amdgcn_fence(__ATOMIC_ACQUIRE, "agent");
            asm volatile("s_waitcnt vmcnt(0)" ::: "memory");
        }
    }
    __syncthreads();
}

namespace pg8 {
#define PG8_LAS __attribute__((address_space(3)))
typedef unsigned short bf16_t;
typedef short bf16x8 __attribute__((ext_vector_type(8)));
typedef float f32x4 __attribute__((ext_vector_type(4)));
typedef unsigned u32x4 __attribute__((ext_vector_type(4)));
constexpr int BM = 256, BK = 64, HALF = 128, HTB = HALF * BK * 2  , STAGE_BYTES = 8 * HTB, NXCD = 8, WGM = 8;

__host__ __device__ __forceinline__ int lds_byte(int r, int c) { const int st = (r >> 4) * 2 + (c >> 5), rr = r & 15, cc = c & 31, ob = rr * 64 + cc * 2; return st * 1024 + (ob ^ (((ob >> 9) & 1) << 5)); }
__host__ __device__ __forceinline__ void stage_rc(int b, int& R, int& C) { const int st = b / 1024, sb = b % 1024, swz = sb ^ (((sb >> 9) & 1) << 5); R = (st >> 1) * 16 + swz / 64; C = (st & 1) * 32 + (swz % 64) / 2; }
__host__ __device__ __forceinline__ int perm32(int rho) { const int n = rho >> 4, i = rho & 15; return 8 * (i >> 2) + 4 * n + (i & 3); }

struct Unit { int pm, pn; };
struct Gemm { const bf16_t* A; const bf16_t* Bt; int M, N, K; };

struct StaticOrder {
    int nM, nN, nwg, G, c;
    __host__ __device__ void init(int M, int N, int G_, int c_) { nM = M / BM; nN = N / BM; nwg = nM * nN; G = G_; c = c_; }
    __host__ __device__ bool next(int i, Unit& u) const {
        const long L = (long)i * G + c; if (L >= nwg) return false;
        int wgid = (int)L; { const int q = nwg / NXCD, r = nwg % NXCD, xcd = wgid % NXCD, off = wgid / NXCD; wgid = (xcd < r ? xcd * (q + 1) : r * (q + 1) + (xcd - r) * q) + off; }
        const int nig = WGM * nN, gid = wgid / nig, fm = gid * WGM, gsz = (nM - fm) < WGM ? (nM - fm) : WGM;
        u.pm = fm + ((wgid % nig) % gsz); u.pn = (wgid % nig) / gsz; return true;
    }
    __device__ __forceinline__ void a_ready(const Unit&) const {}
    __device__ __forceinline__ void done(const Unit&) const {}
};


__device__ __forceinline__ unsigned cvt_pk_bf16(float lo, float hi) { unsigned r; asm volatile("v_cvt_pk_bf16_f32 %0, %1, %2" : "=v"(r) : "v"(lo), "v"(hi)); return r; }

__device__ __forceinline__ __amdgpu_buffer_rsrc_t wt_rsrc(void* base) { return __builtin_amdgcn_make_buffer_rsrc(base, 0, 0x7fffffff, 0x00020000); }
__device__ __forceinline__ void wt_store16(__amdgpu_buffer_rsrc_t r, size_t byte_off, u32x4 v) { __builtin_amdgcn_raw_buffer_store_b128(v, r, (unsigned)byte_off, 0, 16); }
struct EpiQKV {
    static constexpr bool PERM = true, AFTER_DRAIN = false;
    bf16_t* O; int ldc; float qscale;
    __device__ __forceinline__ void operator()(const f32x4 (&acc)[2][2][4][2], const Unit& u, int wr, int wc, int fr, int fq) const {
        const int bb = u.pm >> 3, s0 = (u.pm & 7) * BM + wr * 64 + fr, slot0 = 4 * u.pn + (wc >> 1), d0 = (wc & 1) * 32 + 8 * fq;
        const float sc = (u.pn < 2 || u.pn == 6 || u.pn == 7) ? qscale : 1.f;
        const __amdgpu_buffer_rsrc_t rs_ = wt_rsrc(O);
#pragma unroll
        for (int bj = 0; bj < 2; ++bj) { const size_t hp = ((((size_t)bb * 48 + slot0 + 2 * bj) * 2048 + s0) * 64 + d0) * 2;
#pragma unroll
            for (int ai = 0; ai < 2; ++ai)
#pragma unroll
                for (int m = 0; m < 4; ++m) { const f32x4 v0 = acc[ai][bj][m][0] * sc, v1 = acc[ai][bj][m][1] * sc;
                    u32x4 w; w.x = cvt_pk_bf16(v0[0], v0[1]); w.y = cvt_pk_bf16(v0[2], v0[3]); w.z = cvt_pk_bf16(v1[0], v1[1]); w.w = cvt_pk_bf16(v1[2], v1[3]);
                    wt_store16(rs_, hp + (size_t)(ai * HALF + m * 16) * 128, w); } }
    }
};
struct EpiZ {
    static constexpr bool PERM = true, AFTER_DRAIN = false;
    bf16_t* Z; const float* mod;
    __device__ __forceinline__ void operator()(const f32x4 (&acc)[2][2][4][2], const Unit& u, int wr, int wc, int fr, int fq) const {
        const int row0 = u.pm * BM + wr * 64 + fr, col0 = u.pn * BM + wc * 32 + 8 * fq;
        const float* g1 = mod + (size_t)(u.pm >> 3) * 6144 + 2048 + col0;
        const __amdgpu_buffer_rsrc_t rs_ = wt_rsrc(Z);
        f32x4 gv[2][2];
#pragma unroll
        for (int bj = 0; bj < 2; ++bj)
#pragma unroll
            for (int n = 0; n < 2; ++n) gv[bj][n] = *(const f32x4*)(g1 + bj * HALF + 4 * n);
#pragma unroll
        for (int ai = 0; ai < 2; ++ai)
#pragma unroll
            for (int m = 0; m < 4; ++m) { const size_t off = (size_t)(row0 + ai * HALF + m * 16) * 1024 + col0;
#pragma unroll
                for (int bj = 0; bj < 2; ++bj) { const f32x4 v0 = acc[ai][bj][m][0] * gv[bj][0], v1 = acc[ai][bj][m][1] * gv[bj][1];
                    u32x4 w; w.x = cvt_pk_bf16(v0[0], v0[1]); w.y = cvt_pk_bf16(v0[2], v0[3]); w.z = cvt_pk_bf16(v1[0], v1[1]); w.w = cvt_pk_bf16(v1[2], v1[3]);
                    wt_store16(rs_, (off + bj * HALF) * 2, w); } }
    }
};
struct EpiSC {
    static constexpr bool PERM = true, AFTER_DRAIN = false;
    _Float16* O; int ldc;
    __device__ __forceinline__ void operator()(const f32x4 (&acc)[2][2][4][2], const Unit& u, int wr, int wc, int fr, int fq) const {
        const int row0 = u.pm * BM + wr * 64 + fr, col0 = u.pn * BM + wc * 32 + 8 * fq;
        const __amdgpu_buffer_rsrc_t rs_ = wt_rsrc(O);
#pragma unroll
        for (int ai = 0; ai < 2; ++ai)
#pragma unroll
            for (int m = 0; m < 4; ++m) { const size_t rowp = ((size_t)(row0 + ai * HALF + m * 16) * ldc + col0) * 2;
#pragma unroll
                for (int bj = 0; bj < 2; ++bj) { const f32x4 v0 = acc[ai][bj][m][0], v1 = acc[ai][bj][m][1];
                    u32x4 w; w.x = pkh(v0[0], v0[1]); w.y = pkh(v0[2], v0[3]); w.z = pkh(v1[0], v1[1]); w.w = pkh(v1[2], v1[3]);
                    wt_store16(rs_, rowp + bj * HALF * 2, w); } }
    }
};

template <class Epi, class Sched, bool ALIGN_EPI = false, bool SP2 = false>
__device__ __forceinline__ void gemm_phase(PG8_LAS unsigned char* lds, const Gemm g, const Sched& S, const Epi& E) {
    const int tid = threadIdx.x, wid = __builtin_amdgcn_readfirstlane(tid >> 6), lane = tid & 63, wr = wid >> 2, wc = wid & 3, fr = lane & 15, fq = lane >> 4;
    const int K = g.K, nt = K / BK;
    unsigned voffA[2], voffB[2];
#pragma unroll
    for (int i = 0; i < 2; ++i) { int R, C; stage_rc(tid * 16 + i * 8192, R, C); const int Rb = Epi::PERM ? ((R & ~31) + perm32(R & 31)) : R;
        voffA[i] = (unsigned)(R * K + C) * 2u; voffB[i] = (unsigned)(Rb * K + C) * 2u; }
    const size_t kstep = (size_t)(BK * 2);
    const size_t hstep = (size_t)HALF * K * 2;
    const size_t tstep = 2 * hstep;
    const unsigned ldsw = (unsigned)wid * 1024u;
    const int aoff = lds_byte(wr * 64 + fr, fq * 8), boff = lds_byte(wc * 32 + fr, fq * 8);
#define PG8_SA(b, h) (((b) * 2 + (h)) * HTB)
#define PG8_SB(b, h) ((4 + (b) * 2 + (h)) * HTB)
#define PG8_STAGE(bufoff, gbase, voff) do { _Pragma("unroll") for (int _i = 0; _i < 2; ++_i) \
        __builtin_amdgcn_global_load_lds((const unsigned*)((const char*)(gbase) + (voff)[_i]), (PG8_LAS unsigned*)(lds + (bufoff) + ldsw + _i * 8192), 16, 0, 0); } while (0)
#define PG8_LDA(dst, b, h) do { _Pragma("unroll") for (int m = 0; m < 4; ++m) _Pragma("unroll") for (int k = 0; k < 2; ++k) dst[m][k] = *(const PG8_LAS bf16x8*)(lds + PG8_SA(b, h) + aoff + m * 2048 + k * 1024); } while (0)
#define PG8_LDB(dst, b, h) do { _Pragma("unroll") for (int n = 0; n < 2; ++n) _Pragma("unroll") for (int k = 0; k < 2; ++k) dst[n][k] = *(const PG8_LAS bf16x8*)(lds + PG8_SB(b, h) + boff + n * 2048 + k * 1024); } while (0)
#define PG8_MMA(ai, bj, At, Bt) do { __builtin_amdgcn_s_setprio(1); _Pragma("unroll") for (int m = 0; m < 4; ++m) _Pragma("unroll") for (int n = 0; n < 2; ++n) _Pragma("unroll") for (int k = 0; k < 2; ++k) \
        acc[ai][bj][m][n] = __builtin_amdgcn_mfma_f32_16x16x32_bf16(Bt[n][k], At[m][k], acc[ai][bj][m][n], 0, 0, 0); __builtin_amdgcn_s_setprio(0); } while (0)
#define PG8_WAIT_V(n) asm volatile("s_waitcnt vmcnt(" #n ")" ::: "memory")
#define PG8_WAIT_L(n) asm volatile("s_waitcnt lgkmcnt(" #n ")" ::: "memory")
#define PG8_BAR __builtin_amdgcn_s_barrier()
#define PG8_SCHED __builtin_amdgcn_sched_barrier(0)
    Unit cur, nxt; int ui = 0;
    if (!S.next(0, cur)) return;
    f32x4 acc[2][2][4][2];
#pragma unroll
    for (int a = 0; a < 2; ++a)
#pragma unroll
        for (int b = 0; b < 2; ++b)
#pragma unroll
            for (int m = 0; m < 4; ++m)
#pragma unroll
                for (int n = 0; n < 2; ++n) acc[a][b][m][n] = (f32x4){0.f, 0.f, 0.f, 0.f};
    bf16x8 At[4][2], B0[2][2], B1[2][2];
    const char* cA = (const char*)g.A + (size_t)cur.pm * tstep; const char* cB = (const char*)g.Bt + (size_t)cur.pn * tstep;
    S.a_ready(cur);
    if constexpr (SP2) {
        PG8_STAGE(PG8_SB(0, 0), cB, voffB); PG8_STAGE(PG8_SB(0, 1), cB + hstep, voffB); PG8_STAGE(PG8_SA(0, 0), cA, voffA); PG8_STAGE(PG8_SA(0, 1), cA + hstep, voffA);
        if (wr == 1) PG8_BAR;
        PG8_WAIT_V(2); PG8_BAR;
        PG8_STAGE(PG8_SB(1, 0), cB + kstep, voffB); PG8_STAGE(PG8_SA(1, 0), cA + kstep, voffA); PG8_STAGE(PG8_SB(1, 1), cB + hstep + kstep, voffB);
        PG8_WAIT_V(6); PG8_BAR;
    } else {
        PG8_STAGE(PG8_SB(0, 0), cB, voffB); PG8_STAGE(PG8_SA(0, 0), cA, voffA); PG8_STAGE(PG8_SB(0, 1), cB + hstep, voffB); PG8_STAGE(PG8_SA(0, 1), cA + hstep, voffA);
        if (wr == 1) PG8_BAR;
        PG8_WAIT_V(4); PG8_BAR;
        PG8_STAGE(PG8_SB(1, 0), cB + kstep, voffB); PG8_STAGE(PG8_SA(1, 0), cA + kstep, voffA); PG8_STAGE(PG8_SB(1, 1), cB + hstep + kstep, voffB);
        PG8_WAIT_V(6); PG8_BAR;
    }
    for (;;) {
        const bool has_next = S.next(ui + 1, nxt);
        const char* nA = has_next ? (const char*)g.A + (size_t)nxt.pm * tstep : cA; const char* nB = has_next ? (const char*)g.Bt + (size_t)nxt.pn * tstep : cB;
        for (int t = 0; t < nt; t += 2) {
            const bool last = (t == nt - 2);
            const char* a1 = cA + (size_t)(t + 1) * kstep;
            const char* a2 = last ? nA : cA + (size_t)(t + 2) * kstep; const char* b2 = last ? nB : cB + (size_t)(t + 2) * kstep;
            const char* a3 = a2 + kstep; const char* b3 = b2 + kstep;
            if (last && has_next) S.a_ready(nxt);
            if constexpr (SP2) {
            PG8_LDB(B0, 0, 0); PG8_LDB(B1, 0, 1); PG8_SCHED; PG8_LDA(At, 0, 0); PG8_STAGE(PG8_SA(1, 1), a1 + hstep, voffA);
            PG8_WAIT_V(8); PG8_WAIT_L(0); PG8_BAR; PG8_MMA(0, 0, At, B0); PG8_MMA(0, 1, At, B1); PG8_BAR; PG8_SCHED;
            PG8_LDA(At, 0, 1); PG8_STAGE(PG8_SB(0, 0), b2, voffB); PG8_STAGE(PG8_SB(0, 1), b2 + hstep, voffB); PG8_STAGE(PG8_SA(0, 0), a2, voffA);
            PG8_WAIT_V(8); PG8_WAIT_L(0); PG8_BAR; PG8_MMA(1, 0, At, B0); PG8_MMA(1, 1, At, B1); PG8_BAR; PG8_SCHED;
            PG8_LDB(B0, 1, 0); PG8_LDB(B1, 1, 1); PG8_SCHED; PG8_LDA(At, 1, 0); PG8_STAGE(PG8_SA(0, 1), a2 + hstep, voffA);
            PG8_WAIT_V(8); PG8_WAIT_L(0); PG8_BAR; PG8_MMA(0, 0, At, B0); PG8_MMA(0, 1, At, B1); PG8_BAR; PG8_SCHED;
            PG8_LDA(At, 1, 1); PG8_STAGE(PG8_SB(1, 0), b3, voffB); PG8_STAGE(PG8_SB(1, 1), b3 + hstep, voffB); PG8_STAGE(PG8_SA(1, 0), a3, voffA);
            PG8_WAIT_V(8); PG8_WAIT_L(0); PG8_BAR; PG8_MMA(1, 0, At, B0); PG8_MMA(1, 1, At, B1); PG8_BAR; PG8_SCHED;
            } else {
            PG8_LDB(B0, 0, 0); PG8_SCHED; PG8_LDA(At, 0, 0); PG8_STAGE(PG8_SA(1, 1), a1 + hstep, voffA);
            PG8_WAIT_L(8); PG8_BAR; PG8_WAIT_L(0); PG8_MMA(0, 0, At, B0); PG8_BAR; PG8_SCHED;
            PG8_LDB(B1, 0, 1); PG8_STAGE(PG8_SB(0, 0), b2, voffB);
            PG8_BAR; PG8_WAIT_L(0); PG8_MMA(0, 1, At, B1); PG8_BAR;
            PG8_LDA(At, 0, 1); PG8_STAGE(PG8_SA(0, 0), a2, voffA);
            PG8_BAR; PG8_WAIT_L(0); PG8_MMA(1, 0, At, B0); PG8_BAR; PG8_SCHED;
            PG8_STAGE(PG8_SB(0, 1), b2 + hstep, voffB);
            PG8_WAIT_V(6); PG8_BAR; PG8_MMA(1, 1, At, B1); PG8_BAR;
            PG8_LDB(B0, 1, 0); PG8_SCHED; PG8_LDA(At, 1, 0); PG8_STAGE(PG8_SA(0, 1), a2 + hstep, voffA);
            PG8_WAIT_L(8); PG8_BAR; PG8_WAIT_L(0); PG8_MMA(0, 0, At, B0); PG8_BAR; PG8_SCHED;
            PG8_LDB(B1, 1, 1); PG8_STAGE(PG8_SB(1, 0), b3, voffB);
            PG8_BAR; PG8_WAIT_L(0); PG8_MMA(0, 1, At, B1); PG8_BAR;
            PG8_LDA(At, 1, 1); PG8_STAGE(PG8_SA(1, 0), a3, voffA);
            PG8_BAR; PG8_WAIT_L(0); PG8_MMA(1, 0, At, B0); PG8_BAR; PG8_SCHED;
            PG8_STAGE(PG8_SB(1, 1), b3 + hstep, voffB);
            PG8_WAIT_V(6); PG8_BAR; PG8_MMA(1, 1, At, B1); PG8_BAR;
            }
        }
        if constexpr (ALIGN_EPI) { if (wr == 0) PG8_BAR; }
        if constexpr (!Epi::AFTER_DRAIN) { E(acc, cur, wr, wc, fr, fq); S.done(cur); }
        if (!has_next) break;
#pragma unroll
        for (int a = 0; a < 2; ++a)
#pragma unroll
            for (int b = 0; b < 2; ++b)
#pragma unroll
                for (int m = 0; m < 4; ++m)
#pragma unroll
                    for (int n = 0; n < 2; ++n) acc[a][b][m][n] = (f32x4){0.f, 0.f, 0.f, 0.f};
        cur = nxt; cA = nA; cB = nB; ++ui;
        if constexpr (ALIGN_EPI) { if (wr == 1) PG8_BAR; }
    }
    PG8_WAIT_V(0);
    if constexpr (!ALIGN_EPI) { if (wr == 0) PG8_BAR; }
    PG8_BAR;
    if constexpr (Epi::AFTER_DRAIN) { E.fused(acc, cur, wr, wc, fr, fq, lds, wid, lane); S.done(cur); }
#undef PG8_SA
#undef PG8_SB
#undef PG8_STAGE
#undef PG8_LDA
#undef PG8_LDB
#undef PG8_MMA
#undef PG8_WAIT_V
#undef PG8_WAIT_L
#undef PG8_BAR
#undef PG8_SCHED
}
}

struct Params {
    const float *x, *c, *ada_w, *ada_b, *norm1_g, *w_in, *na_rpb, *ong_na, *ong_dil, *w_out, *norm2_g, *peer_wq, *peer_sk, *peer_u, *peer_v, *final_g;
    float* out; unsigned char* ws; int ph_lo, ph_hi;
};
constexpr int NPHASE = 13;

__device__ __forceinline__ void p0_mod(const Params& p, LAS unsigned char* lds, int tid, int lane, int wave) {
    LAS float* s = (LAS float*)lds;
    LAS float* red = (LAS float*)(lds + 65536);
    for (int idx = tid; idx < 16 * 1024; idx += 512) { const int b = idx >> 10, k = idx & 1023; const float cv = p.c[idx]; s[k * 16 + b] = cv / (1.f + __expf(-cv)); }
    __syncthreads();
    float* mod = (float*)(p.ws + WS_MOD);
    for (int it = blockIdx.x; it < 256; it += gridDim.x) {
        const int j0 = it * 24, c = lane & 31, kq = lane >> 5; const bool act = c < 24;
        float acc[16];
#pragma unroll
        for (int b = 0; b < 16; ++b) acc[b] = 0.f;
        const float* wp = p.ada_w + (size_t)(wave * 128 + kq) * 6144 + j0 + (act ? c : 0);
#pragma unroll 4
        for (int i = 0; i < 64; ++i) {
            const int k = wave * 128 + 2 * i + kq;
            const float wv = act ? __builtin_nontemporal_load(wp + (size_t)i * 2 * 6144) : 0.f;
            const LAS f32x4* sp = (const LAS f32x4*)(s + k * 16);
            const f32x4 s0 = sp[0], s1 = sp[1], s2 = sp[2], s3 = sp[3];
#pragma unroll
            for (int e = 0; e < 4; ++e) { acc[e] += s0[e] * wv; acc[4 + e] += s1[e] * wv; acc[8 + e] += s2[e] * wv; acc[12 + e] += s3[e] * wv; }
        }
#pragma unroll
        for (int b = 0; b < 16; ++b) red[((wave * 2 + kq) * 16 + b) * 32 + c] = acc[b];
        __syncthreads();
        if (tid < 384) { const int b = tid / 24, cc = tid - b * 24; float sum = p.ada_b[j0 + cc];
#pragma unroll
            for (int pp = 0; pp < 16; ++pp) sum += red[(pp * 16 + b) * 32 + cc];
            mod[(size_t)b * 6144 + j0 + cc] = sum; }
        __syncthreads();
    }
}
__device__ __forceinline__ void p0_wsc(const Params& p, LAS unsigned char* lds, int tid) {
    LAS float* wq_s = (LAS float*)lds;
    LAS float* sk_s = (LAS float*)(lds + 32768);
    bf16_t* WscT = (bf16_t*)(p.ws + WS_WSC);
    for (int it = blockIdx.x; it < 256; it += gridDim.x) {
        const int hp = it >> 4, kc = it & 15, pp = hp & 1, k0 = kc * 64;
        for (int i = tid; i < 2048; i += 512) { const int r = i >> 5, c4 = i & 31; *(LAS f32x4*)(wq_s + r * 128 + c4 * 4) = *(const f32x4*)(p.peer_wq + (size_t)(k0 + r) * 2048 + hp * 128 + c4 * 4); }
        for (int i = tid; i < 4096; i += 512) { const int r = i >> 5, c4 = i & 31; *(LAS f32x4*)(sk_s + r * 132 + c4 * 4) = *(const f32x4*)(p.peer_sk + (size_t)pp * 16384 + r * 128 + c4 * 4); }
        __syncthreads();
        const int n = tid & 127, kg = tid >> 7;
        float acc[16];
#pragma unroll
        for (int i = 0; i < 16; ++i) acc[i] = 0.f;
        for (int d = 0; d < 128; d += 4) {
            const f32x4 sv = *(const LAS f32x4*)(sk_s + n * 132 + d);
#pragma unroll
            for (int i = 0; i < 16; ++i) { const f32x4 wv = *(const LAS f32x4*)(wq_s + (kg * 16 + i) * 128 + d); acc[i] += (wv[0] * sv[0] + wv[1] * sv[1]) + (wv[2] * sv[2] + wv[3] * sv[3]); }
        }
        bf16_t* op = WscT + (size_t)(hp * 128 + n) * 1024 + k0 + kg * 16;
        u32x4 w0, w1;
        w0.x = pkbf(acc[0], acc[1]); w0.y = pkbf(acc[2], acc[3]); w0.z = pkbf(acc[4], acc[5]); w0.w = pkbf(acc[6], acc[7]);
        w1.x = pkbf(acc[8], acc[9]); w1.y = pkbf(acc[10], acc[11]); w1.z = pkbf(acc[12], acc[13]); w1.w = pkbf(acc[14], acc[15]);
        *(u32x4*)op = w0; *(u32x4*)(op + 8) = w1;
        __syncthreads();
    }
}
__device__ __forceinline__ void p0_transpose_item(const float* W, int K, int N, bf16_t* WT, const float* ks0, const float* ks1, LAS float* scr, int item, int lane) {
    const int nblk = N / 32, kb = item / nblk, nb = item % nblk, k0 = 64 * kb, n0 = 32 * nb;
#pragma unroll 8
    for (int i = 0; i < 32; ++i) { const int kk = 2 * i + (lane >> 5), kabs = k0 + kk;
        const float sc = ks0 ? (kabs < 512 ? ks0[kabs] : ks1[kabs - 512]) : 1.f;
        scr[kk * 33 + (lane & 31)] = W[(size_t)kabs * N + n0 + (lane & 31)] * sc; }
    asm volatile("s_waitcnt lgkmcnt(0)" ::: "memory");
    const int c = lane & 7;
#pragma unroll
    for (int j = 0; j < 4; ++j) { const int n = (lane >> 3) + 8 * j; const LAS float* s = scr + (8 * c) * 33 + n;
        u32x4 o; o.x = pkbf(s[0 * 33], s[1 * 33]); o.y = pkbf(s[2 * 33], s[3 * 33]); o.z = pkbf(s[4 * 33], s[5 * 33]); o.w = pkbf(s[6 * 33], s[7 * 33]);
        *(u32x4*)(WT + (size_t)(n0 + n) * K + k0 + 8 * c) = o; }
    asm volatile("s_waitcnt lgkmcnt(0)" ::: "memory");
}
__device__ __forceinline__ void p0_weights(const Params& p, LAS unsigned char* lds, int tid, int lane, int wave) {
    p0_wsc(p, lds, tid);
    const int G = gridDim.x, gw = blockIdx.x * 8 + wave, NGW = G * 8;
    LAS float* scr = (LAS float*)(lds + wave * 16384);
    constexpr int I_IN = (DM / 64) * (NQKV / 32), I_OUT = (DM / 64) * (DM / 32);
    for (int it = gw; it < I_IN + I_OUT; it += NGW) {
        if (it < I_IN) p0_transpose_item(p.w_in, DM, NQKV, (bf16_t*)(p.ws + WS_WIN), nullptr, nullptr, scr, it, lane);
        else p0_transpose_item(p.w_out, DM, DM, (bf16_t*)(p.ws + WS_WOUT), p.ong_na, p.ong_dil, scr, it - I_IN, lane);
    }
}

template <bool Q8>
__device__ __forceinline__ void norm_rows(const float* src, const bf16_t* zadd, const float* gain, const float* mod, int sh_off, int sc_off, bf16_t* dst, unsigned char* dst8, float* scale8, int gw, int NGW, int lane) {
    for (int it = gw; it < TOK / 16; it += NGW) {
        const int t0 = it * 16, b = t0 >> 11; const float* mb = mod + (size_t)b * 6144;
        f32x4 Gv[4], Sv[4];
#pragma unroll
        for (int j = 0; j < 4; ++j) { const int k = 4 * lane + 256 * j; const f32x4 g = *(const f32x4*)(gain + k), sc = *(const f32x4*)(mb + sc_off + k); Gv[j] = g * (1.f + sc); Sv[j] = *(const f32x4*)(mb + sh_off + k); }
        f32x4 n1[4], n2[4], n3[4];
#pragma unroll
        for (int j = 0; j < 4; ++j) { n1[j] = __builtin_nontemporal_load((const f32x4*)(src + (size_t)t0 * DM) + lane + 64 * j); n2[j] = __builtin_nontemporal_load((const f32x4*)(src + (size_t)(t0 + 1) * DM) + lane + 64 * j); n3[j] = __builtin_nontemporal_load((const f32x4*)(src + (size_t)(t0 + 2) * DM) + lane + 64 * j); }
        u32x2 z1[4], z2[4], z3[4];
        if (Q8) {
#pragma unroll
            for (int j = 0; j < 4; ++j) { z1[j] = __builtin_nontemporal_load((const u32x2*)(zadd + (size_t)t0 * DM) + lane + 64 * j); z2[j] = __builtin_nontemporal_load((const u32x2*)(zadd + (size_t)(t0 + 1) * DM) + lane + 64 * j); z3[j] = __builtin_nontemporal_load((const u32x2*)(zadd + (size_t)(t0 + 2) * DM) + lane + 64 * j); }
        }
#pragma unroll 4
        for (int r = 0; r < 16; ++r) {
            f32x4 v[4]; float ss = 0.f;
            const f32x4* xn = (const f32x4*)(src + (size_t)(t0 + (r + 3 < 16 ? r + 3 : 15)) * DM) + lane;
#pragma unroll
            for (int j = 0; j < 4; ++j) { v[j] = n1[j]; n1[j] = n2[j]; n2[j] = n3[j]; n3[j] = __builtin_nontemporal_load(xn + 64 * j);
                if (Q8) { const u32x2 zz = z1[j]; v[j] = v[j] + (f32x4){bf_lo(zz.x), bf_hi(zz.x), bf_lo(zz.y), bf_hi(zz.y)}; z1[j] = z2[j]; z2[j] = z3[j]; z3[j] = __builtin_nontemporal_load((const u32x2*)(zadd + (size_t)(t0 + (r + 3 < 16 ? r + 3 : 15)) * DM) + lane + 64 * j); }
                ss += (v[j][0] * v[j][0] + v[j][1] * v[j][1]) + (v[j][2] * v[j][2] + v[j][3] * v[j][3]); }
            const float rs = rsqrtf(wave_sum(ss) * (1.f / DM) + EPS);
            u32x2* o8 = (u32x2*)(dst + (size_t)(t0 + r) * DM) + lane;
            float am = 0.f;
#pragma unroll
            for (int j = 0; j < 4; ++j) { const f32x4 h = v[j] * rs * Gv[j] + Sv[j]; v[j] = h; u32x2 w; w.x = pkbf(h[0], h[1]); w.y = pkbf(h[2], h[3]); o8[64 * j] = w;
                if (Q8) am = fmaxf(fmaxf(am, fmaxf(fabsf(h[0]), fabsf(h[1]))), fmaxf(fabsf(h[2]), fabsf(h[3]))); }
            if (Q8) {
#pragma unroll
                for (int o = 1; o < 64; o <<= 1) am = fmaxf(am, __shfl_xor(am, o));
                const float inv = am > 0.f ? 127.f / am : 0.f;
                unsigned* q8 = (unsigned*)(dst8 + (size_t)(t0 + r) * DM) + lane;
#pragma unroll
                for (int j = 0; j < 4; ++j) { const int q0 = (int)rintf(v[j][0] * inv), q1 = (int)rintf(v[j][1] * inv), q2 = (int)rintf(v[j][2] * inv), q3 = (int)rintf(v[j][3] * inv);
                    q8[64 * j] = ((unsigned)q0 & 255u) | (((unsigned)q1 & 255u) << 8) | (((unsigned)q2 & 255u) << 16) | ((unsigned)q3 << 24); }
                if (lane == 0) scale8[t0 + r] = am * (1.f / 127.f);
            }
        }
    }
}

struct TabRow { f32x4 v[4]; };
__device__ __forceinline__ void tab_row_load(const Params& p, int row, int lane, TabRow& r) {
    const bool second = row >= NEXP; const int e = second ? row - NEXP : row;
    const f32x4* src = (const f32x4*)((second ? p.peer_v : p.peer_u) + (size_t)e * 1024) + lane;
#pragma unroll
    for (int j = 0; j < 4; ++j) r.v[j] = __builtin_nontemporal_load(src + 64 * j);
}
__device__ __forceinline__ void tab_row_finish(const Params& p, int row, int lane, const TabRow& r) {
    asm volatile("" : "+v"(lane));
    const bool second = row >= NEXP; const int e = second ? row - NEXP : row;
    float am = 0.f;
#pragma unroll
    for (int j = 0; j < 4; ++j) am = fmaxf(fmaxf(am, fmaxf(fabsf(r.v[j][0]), fabsf(r.v[j][1]))), fmaxf(fabsf(r.v[j][2]), fabsf(r.v[j][3])));
#pragma unroll
    for (int o = 1; o < 64; o <<= 1) am = fmaxf(am, __shfl_xor(am, o));
    const float inv = am > 0.f ? 127.f / am : 0.f;
    unsigned char* tb_ = p.ws + (second ? WS_VH : WS_UH) + (size_t)e * 128 + 4 * (lane & 31);
#pragma unroll
    for (int j = 0; j < 4; ++j) { const int q0 = (int)rintf(r.v[j][0] * inv), q1 = (int)rintf(r.v[j][1] * inv), q2 = (int)rintf(r.v[j][2] * inv), q3 = (int)rintf(r.v[j][3] * inv);
        *(unsigned*)(tb_ + (size_t)(2 * j + (lane >> 5)) * NEXP * 128) = ((unsigned)q0 & 255u) | (((unsigned)q1 & 255u) << 8) | (((unsigned)q2 & 255u) << 16) | ((unsigned)q3 << 24); }
    if (lane == 0) ((float*)(p.ws + WS_SU))[row] = am * (1.f / 127.f);
}


constexpr int VROW = 160;
constexpr int RPB_OFF = 98304;
constexpr int NUNIT_NA = 2048, NUNIT_DIL = 6144;


template <int NCH> __device__ __forceinline__ void softmax_pack(f32x4 (&S)[NCH][2], bf16x8 (&pa)[NCH], float& mx_out, float& l_out) {
    float mx = -1e30f, mx2 = -1e30f;
#pragma unroll
    for (int ch = 0; ch < NCH; ++ch)
#pragma unroll
        for (int xy = 0; xy < 2; ++xy) { mx = fmaxf(mx, fmaxf(S[ch][xy][0], S[ch][xy][1])); mx2 = fmaxf(mx2, fmaxf(S[ch][xy][2], S[ch][xy][3])); }
    mx = fmaxf(mx, mx2);
    mx = fmaxf(mx, __shfl_xor(mx, 16)); mx = fmaxf(mx, __shfl_xor(mx, 32));
    float l = 0.f;
#pragma unroll
    for (int ch = 0; ch < NCH; ++ch) {
#pragma unroll
        for (int xy = 0; xy < 2; ++xy)
#pragma unroll
            for (int r = 0; r < 4; ++r) { const float e = __builtin_amdgcn_exp2f(S[ch][xy][r] - mx); S[ch][xy][r] = e; l += e; }
        u32x4 w; w.x = pkbf(S[ch][0][0], S[ch][0][1]); w.y = pkbf(S[ch][0][2], S[ch][0][3]); w.z = pkbf(S[ch][1][0], S[ch][1][1]); w.w = pkbf(S[ch][1][2], S[ch][1][3]);
        pa[ch] = __builtin_bit_cast(bf16x8, w);
    }
    l += __shfl_xor(l, 16); l += __shfl_xor(l, 32);
    mx_out = mx; l_out = l;
}
template <int NCH, int CSB> __device__ __forceinline__ void pv_accum(const LAS unsigned char* vb, const bf16x8 (&pa)[NCH], f32x4 (&o)[4]) {
#pragma unroll
    for (int ch = 0; ch < NCH; ++ch)
#pragma unroll
        for (int nt = 0; nt < 4; ++nt) {
            const v4i16_t t0 = __builtin_amdgcn_ds_read_tr16_b64_v4i16((LAS v4i16_t*)(vb + ch * CSB + nt * 32));
            const v4i16_t t1 = __builtin_amdgcn_ds_read_tr16_b64_v4i16((LAS v4i16_t*)(vb + ch * CSB + 16 * VROW + nt * 32));
            const bf16x8 vf = {t0[0], t0[1], t0[2], t0[3], t1[0], t1[1], t1[2], t1[3]};
            o[nt] = __builtin_amdgcn_mfma_f32_16x16x32_bf16(vf, pa[ch], o[nt], 0, 0, 0);
        }
}

__device__ __forceinline__ void o_store16(__amdgpu_buffer_rsrc_t rs, size_t elem_off  , const f32x4 (&o)[4], float inv, int g) {
    const bool odd = (g & 1) != 0;
#pragma unroll
    for (int pr = 0; pr < 2; ++pr) {
        const unsigned x0 = pkbf(o[2 * pr][0] * inv, o[2 * pr][1] * inv), x1 = pkbf(o[2 * pr][2] * inv, o[2 * pr][3] * inv);
        const unsigned y0 = pkbf(o[2 * pr + 1][0] * inv, o[2 * pr + 1][1] * inv), y1 = pkbf(o[2 * pr + 1][2] * inv, o[2 * pr + 1][3] * inv);
        auto r0 = __builtin_amdgcn_permlane16_swap(x0, y0, false, false), r1 = __builtin_amdgcn_permlane16_swap(x1, y1, false, false);
        const u32x4 w = {r0[0], r1[0], r0[1], r1[1]};
        const int d0 = 16 * (2 * pr + (odd ? 1 : 0)) + 4 * (g & ~1);
        pg8::wt_store16(rs, (elem_off + d0) * 2, w);
    }
}

__device__ __forceinline__ void lds_barrier() { asm volatile("s_waitcnt lgkmcnt(0)\n\ts_barrier" ::: "memory"); }
struct NaGeo { int b, h, rp, rr, cg, r0, cw; };
__device__ __forceinline__ NaGeo na_geo(int u, int wave) {
    NaGeo z; z.b = u >> 7; z.h = (u >> 4) & 7; z.rp = u & 15; z.rr = 2 * z.rp + (wave >> 2); z.cg = wave & 3;
    z.r0 = min(max(z.rr - 4, 0), 24); z.cw = min(max(16 * z.cg - 8, 0), 32); return z;
}
__device__ __forceinline__ void na_qload(const bf16_t* QKV, const NaGeo& z, int lane, bf16x8& qf0, bf16x8& qf1) {
    const bf16_t* qp = QKV + (((size_t)z.b * 48 + z.h) * SEQ + z.rr * 64 + 16 * z.cg + (lane & 15)) * 64 + 8 * (lane >> 4);
    qf0 = *(const bf16x8*)qp; qf1 = *(const bf16x8*)(qp + 32);
}
__device__ __forceinline__ void na_kload(const bf16_t* QKV, const NaGeo& z, int hf, int lane, bf16x8 (&kf)[4][2][2]) {
#pragma unroll
    for (int c4 = 0; c4 < 4; ++c4)
#pragma unroll
        for (int xy = 0; xy < 2; ++xy) {
            const bf16_t* kp = QKV + (((size_t)z.b * 48 + 8 + z.h) * SEQ + (z.r0 + 4 * hf + c4) * 64 + z.cw + 16 * xy + (lane & 15)) * 64 + 8 * (lane >> 4);
            kf[c4][xy][0] = *(const bf16x8*)kp; kf[c4][xy][1] = *(const bf16x8*)(kp + 32);
        }
}
__device__ __forceinline__ void s_mfma4(const bf16x8 (&kf)[4][2][2], const bf16x8 qf0, const bf16x8 qf1, f32x4 (&S)[8][2], int base) {
#pragma unroll
    for (int c4 = 0; c4 < 4; ++c4)
#pragma unroll
        for (int xy = 0; xy < 2; ++xy) S[base + c4][xy] = __builtin_amdgcn_mfma_f32_16x16x32_bf16(kf[c4][xy][0], qf0, (f32x4){0.f, 0.f, 0.f, 0.f}, 0, 0, 0);
#pragma unroll
    for (int c4 = 0; c4 < 4; ++c4)
#pragma unroll
        for (int xy = 0; xy < 2; ++xy) S[base + c4][xy] = __builtin_amdgcn_mfma_f32_16x16x32_bf16(kf[c4][xy][1], qf1, S[base + c4][xy], 0, 0, 0);
}
__device__ __forceinline__ void na_unit(const Params& p, LAS unsigned char* lds, int u, int un, int tid, int lane, int wave, bf16x8 (&kfA)[4][2][2], bf16x8 (&kfB)[4][2][2], bf16x8& qf0, bf16x8& qf1) {
    const bf16_t* QKV = (const bf16_t*)(p.ws + WS_QKV);
    const LAS float* rpb = (const LAS float*)(lds + RPB_OFF) + 64;
    const NaGeo z = na_geo(u, wave);
    const int b = z.b, h = z.h, rp = z.rp, rr = z.rr, cg = z.cg, r0 = z.r0, cw = z.cw;
    const int q = lane & 15, g = lane >> 4, c = 16 * cg + q, c0 = min(max(c - 8, 0), 48);
    const int vbase = min(max(2 * rp - 4, 0), 24);
    const size_t tb = (size_t)b * SEQ;
    f32x4 S[8][2];
    s_mfma4(kfA, qf0, qf1, S, 0);
    s_mfma4(kfB, qf0, qf1, S, 4);
    __builtin_amdgcn_sched_barrier(0);
    u32x4 vreg[9];
    const int vr = tid >> 3, vpiece = tid & 7;
#pragma unroll
    for (int ps = 0; ps < 9; ++ps) { const int kr = min(vbase + ps, 31);
        vreg[ps] = *(const u32x4*)(QKV + (((size_t)b * 48 + 16 + h) * SEQ + kr * 64 + vr) * 64 + vpiece * 8); }
    const int thr = c0 - cw;
    const int bbase = h * 465 + (r0 - rr + 7) * 31 + (cw + 4 * g - c + 15);
    bool ux[4]; int bi[4];
#pragma unroll
    for (int r = 0; r < 4; ++r) { ux[r] = (4 * g + r) >= thr; bi[r] = bbase + r + (ux[r] ? 0 : 16); }
    f32x4 Sm[8];
#pragma unroll
    for (int ch = 0; ch < 8; ++ch)
#pragma unroll
        for (int r = 0; r < 4; ++r) Sm[ch][r] = (ux[r] ? S[ch][0][r] : S[ch][1][r]) + rpb[bi[r] + ch * 31];
    bf16x8 pa[8]; float mx, l;
    {
        float m0 = -1e30f, m1 = -1e30f;
#pragma unroll
        for (int ch = 0; ch < 8; ++ch) { m0 = fmaxf(m0, fmaxf(Sm[ch][0], Sm[ch][1])); m1 = fmaxf(m1, fmaxf(Sm[ch][2], Sm[ch][3])); }
        mx = fmaxf(m0, m1);
        mx = fmaxf(mx, __shfl_xor(mx, 16)); mx = fmaxf(mx, __shfl_xor(mx, 32));
        l = 0.f;
#pragma unroll
        for (int ch = 0; ch < 8; ++ch) {
            float ex[4], ey[4];
#pragma unroll
            for (int r = 0; r < 4; ++r) { const float e = __builtin_amdgcn_exp2f(Sm[ch][r] - mx); l += e; ex[r] = ux[r] ? e : 0.f; ey[r] = ux[r] ? 0.f : e; }
            u32x4 w; w.x = pkbf(ex[0], ex[1]); w.y = pkbf(ex[2], ex[3]); w.z = pkbf(ey[0], ey[1]); w.w = pkbf(ey[2], ey[3]);
            pa[ch] = __builtin_bit_cast(bf16x8, w);
        }
        l += __shfl_xor(l, 16); l += __shfl_xor(l, 32);
    }
    __builtin_amdgcn_sched_barrier(0);
    { const NaGeo zn = na_geo(un, wave); na_qload(QKV, zn, lane, qf0, qf1); na_kload(QKV, zn, 0, lane, kfA); na_kload(QKV, zn, 1, lane, kfB); }
    __builtin_amdgcn_sched_barrier(0);
    lds_barrier();
#pragma unroll
    for (int ps = 0; ps < 9; ++ps) *(LAS u32x4*)(lds + (ps * 64 + vr) * VROW + vpiece * 16) = vreg[ps];
    lds_barrier();
    f32x4 o[4];
#pragma unroll
    for (int nt = 0; nt < 4; ++nt) o[nt] = (f32x4){0.f, 0.f, 0.f, 0.f};
    const int i16 = lane & 15, qq = i16 >> 2, pp = i16 & 3;
    const LAS unsigned char* vb = lds + ((r0 - vbase) * 64 + cw + 4 * g + qq) * VROW + pp * 8;
    pv_accum<8, 64 * VROW>(vb, pa, o);
    const float inv = 1.f / l;
    o_store16(pg8::wt_rsrc(p.ws + WS_ONA), (tb + rr * 64 + c) * 512 + h * 64, o, inv, g);
}

struct DilGeo { int b, h, cfg, Dl, L, rho, m0; };
__device__ __forceinline__ DilGeo dil_geo(int v) {
    DilGeo z; z.b = v / 384; int rem = v - z.b * 384; z.h = rem / 48; rem -= z.h * 48; z.cfg = rem >> 4; const int sub = rem & 15;
    z.Dl = z.cfg * 2; z.L = SEQ >> z.Dl; const int nbl = 4 - z.Dl; z.rho = sub >> nbl; z.m0 = (sub & ((1 << nbl) - 1)) * 128; return z;
}
constexpr int DIL_KOFF = 0, DIL_VOFF = 272 * VROW;
struct DilRegs { u32x4 k[4], v[4]; bf16x8 qf0, qf1; };
__device__ __forceinline__ void dil_prefetch(const bf16_t* QKV, const DilGeo& z, int tid, int lane, int wave, DilRegs& R) {
    const int vr = tid >> 3, vpiece = tid & 7;
#pragma unroll
    for (int ps = 0; ps < 4; ++ps) { const int j = ps * 64 + vr; const int mm = min(max(z.m0 - 64 + j, 0), z.L - 1);
        const size_t tok = ((size_t)mm << z.Dl) + z.rho;
        R.k[ps] = *(const u32x4*)(QKV + (((size_t)z.b * 48 + 32 + z.h) * SEQ + tok) * 64 + vpiece * 8);
        R.v[ps] = *(const u32x4*)(QKV + (((size_t)z.b * 48 + 40 + z.h) * SEQ + tok) * 64 + vpiece * 8); }
    const int mq = z.m0 + 16 * wave + (lane & 15);
    const bf16_t* qp = QKV + (((size_t)z.b * 48 + 24 + z.h) * SEQ + ((size_t)mq << z.Dl) + z.rho) * 64 + 8 * (lane >> 4);
    R.qf0 = *(const bf16x8*)qp; R.qf1 = *(const bf16x8*)(qp + 32);
}
__device__ __forceinline__ void dil_unit(const Params& p, LAS unsigned char* lds, int v, int vn, int tid, int lane, int wave, DilRegs& R) {
    const bf16_t* QKV = (const bf16_t*)(p.ws + WS_QKV);
    const DilGeo z = dil_geo(v);
    const int h = z.h, cfg = z.cfg, Dl = z.Dl, L = z.L, rho = z.rho, m0 = z.m0;
    const int q = lane & 15, g = lane >> 4;
    const size_t tb = (size_t)z.b * SEQ;
    const int mq = m0 + 16 * wave + q;
    const int vr = tid >> 3, vpiece = tid & 7;
    lds_barrier();
#pragma unroll
    for (int ps = 0; ps < 4; ++ps) { const int j = ps * 64 + vr;
        *(LAS u32x4*)(lds + DIL_KOFF + j * VROW + vpiece * 16) = R.k[ps]; *(LAS u32x4*)(lds + DIL_VOFF + j * VROW + vpiece * 16) = R.v[ps]; }
    const bf16x8 qf0 = R.qf0, qf1 = R.qf1;
    lds_barrier();
    { const DilGeo zn = dil_geo(vn); dil_prefetch(QKV, zn, tid, lane, wave, R); }
    TabRow trw; const bool tconv = v < 2 * NEXP / 8;
    tab_row_load(p, tconv ? 8 * v + wave : 0, lane, trw);
    __builtin_amdgcn_sched_barrier(0);
    f32x4 S[5][2];
    {
        const LAS unsigned char* kb = lds + DIL_KOFF + (16 * wave + q) * VROW + 16 * g;
#pragma unroll
        for (int ch = 0; ch < 5; ++ch)
#pragma unroll
            for (int xy = 0; xy < 2; ++xy) S[ch][xy] = __builtin_amdgcn_mfma_f32_16x16x32_bf16(*(const LAS bf16x8*)(kb + (32 * ch + 16 * xy) * VROW), qf0, (f32x4){0.f, 0.f, 0.f, 0.f}, 0, 0, 0);
#pragma unroll
        for (int ch = 0; ch < 5; ++ch)
#pragma unroll
            for (int xy = 0; xy < 2; ++xy) S[ch][xy] = __builtin_amdgcn_mfma_f32_16x16x32_bf16(*(const LAS bf16x8*)(kb + (32 * ch + 16 * xy) * VROW + 64), qf1, S[ch][xy], 0, 0, 0);
    }
    const float slope2 = __builtin_amdgcn_exp2f(-(float)(h + 1)) * (float)(1 << Dl) * LOG2E;
#pragma unroll
    for (int ch = 0; ch < 5; ++ch)
#pragma unroll
        for (int xy = 0; xy < 2; ++xy)
#pragma unroll
            for (int r = 0; r < 4; ++r) { const int delta = 32 * ch + 16 * xy + 4 * g + r - 64 - q, ad = delta < 0 ? -delta : delta, mm = mq + delta;
                const bool valid = (ad <= 64) && (mm >= 0) && (mm < L);
                S[ch][xy][r] = valid ? S[ch][xy][r] - slope2 * (float)ad : -1e30f; }
    bf16x8 pa[5]; float mx, l;
    softmax_pack<5>(S, pa, mx, l);
    f32x4 o[4];
#pragma unroll
    for (int nt = 0; nt < 4; ++nt) o[nt] = (f32x4){0.f, 0.f, 0.f, 0.f};
    const int i16 = lane & 15, qq = i16 >> 2, pp = i16 & 3;
    const LAS unsigned char* vb = lds + DIL_VOFF + (16 * wave + 4 * g + qq) * VROW + pp * 8;
    pv_accum<5, 32 * VROW>(vb, pa, o);
    const float inv = 1.f / l;
    int g7 = g; asm volatile("" : "+v"(g7));
    const size_t tq = tb + ((size_t)(m0 + 16 * wave + (lane & 15)) << Dl) + rho;
    o_store16(pg8::wt_rsrc(p.ws + WS_OD), (size_t)cfg * TOK * 512 + tq * 512 + h * 64, o, inv, g7);
    if (g7 == 0) ((float*)(p.ws + WS_LSE))[((size_t)cfg * TOK + tq) * 8 + h] = mx + __builtin_amdgcn_logf(l);
    if (tconv) tab_row_finish(p, 8 * v + wave, lane, trw);
}

__device__ __forceinline__ void attn_phase(const Params& p, LAS unsigned char* lds, int tid, int lane, int wave, int vcu, int G) {
    const bf16_t* QKV = (const bf16_t*)(p.ws + WS_QKV);
    LAS float* rp = (LAS float*)(lds + RPB_OFF);
    for (int i = tid; i < 64 + 8 * 465 + 64; i += 512) { const int k = i - 64; rp[i] = (k >= 0 && k < 8 * 465) ? p.na_rpb[k] * LOG2E : 0.f; }
    __syncthreads();
    {
        bf16x8 kfA[4][2][2], kfB[4][2][2], qf0, qf1;
        int u = vcu;
        if (u < NUNIT_NA) { const NaGeo z = na_geo(u, wave); na_qload(QKV, z, lane, qf0, qf1); na_kload(QKV, z, 0, lane, kfA); na_kload(QKV, z, 1, lane, kfB); }
        for (; u < NUNIT_NA; u += G) na_unit(p, lds, u, (u + G < NUNIT_NA) ? u + G : u, tid, lane, wave, kfA, kfB, qf0, qf1);
    }
    {
        DilRegs R0, R1;
        int v = vcu;
        lds_barrier();
        if (tid < 16 * 8) { const int j = 256 + (tid >> 3); *(LAS u32x4*)(lds + DIL_KOFF + j * VROW + (tid & 7) * 16) = (u32x4){0u, 0u, 0u, 0u}; *(LAS u32x4*)(lds + DIL_VOFF + j * VROW + (tid & 7) * 16) = (u32x4){0u, 0u, 0u, 0u}; }
        if (v < NUNIT_DIL) { const DilGeo z = dil_geo(v); dil_prefetch(QKV, z, tid, lane, wave, R0); }
        if (v + G < NUNIT_DIL) { const DilGeo z = dil_geo(v + G); dil_prefetch(QKV, z, tid, lane, wave, R1); }
        for (; v < NUNIT_DIL; v += 2 * G) {
            dil_unit(p, lds, v, (v + 2 * G < NUNIT_DIL) ? v + 2 * G : v, tid, lane, wave, R0);
            if (v + G < NUNIT_DIL) dil_unit(p, lds, v + G, (v + 3 * G < NUNIT_DIL) ? v + 3 * G : v + G, tid, lane, wave, R1);
        }
    }
}

__device__ __forceinline__ void unpack8(const u32x4 w, float (&f)[8]) { f[0] = bf_lo(w.x); f[1] = bf_hi(w.x); f[2] = bf_lo(w.y); f[3] = bf_hi(w.y); f[4] = bf_lo(w.z); f[5] = bf_hi(w.z); f[6] = bf_lo(w.w); f[7] = bf_hi(w.w); }
__device__ __forceinline__ void merge_norm(const Params& p, int gw, int NGW, int lane) {
    const bf16_t* ONA = (const bf16_t*)(p.ws + WS_ONA); const bf16_t* OD = (const bf16_t*)(p.ws + WS_OD); const float* LSE = (const float*)(p.ws + WS_LSE);
    bf16_t* Hn = (bf16_t*)(p.ws + WS_H);
    const __amdgpu_buffer_rsrc_t hrs = pg8::wt_rsrc(Hn);
    for (int t = gw; t < TOK; t += NGW) {
        float na[8], d0[8], d1[8], d2[8];
        unpack8(__builtin_nontemporal_load((const u32x4*)(ONA + (size_t)t * 512 + 8 * lane)), na);
        unpack8(__builtin_nontemporal_load((const u32x4*)(OD + (size_t)t * 512 + 8 * lane)), d0);
        unpack8(__builtin_nontemporal_load((const u32x4*)(OD + ((size_t)TOK + t) * 512 + 8 * lane)), d1);
        unpack8(__builtin_nontemporal_load((const u32x4*)(OD + ((size_t)2 * TOK + t) * 512 + 8 * lane)), d2);
        const int hh = lane >> 3;
        const float l0 = LSE[(size_t)t * 8 + hh], l1 = LSE[((size_t)TOK + t) * 8 + hh], l2 = LSE[((size_t)2 * TOK + t) * 8 + hh];
        const float m = fmaxf(l0, fmaxf(l1, l2));
        const float e0 = __builtin_amdgcn_exp2f(l0 - m), e1 = __builtin_amdgcn_exp2f(l1 - m), e2 = __builtin_amdgcn_exp2f(l2 - m), ie = 1.f / (e0 + e1 + e2);
        const float al0 = e0 * ie, al1 = e1 * ie, al2 = e2 * ie;
        float ssa = 0.f, ssb = 0.f, dl[8];
#pragma unroll
        for (int k = 0; k < 8; ++k) { dl[k] = al0 * d0[k] + al1 * d1[k] + al2 * d2[k]; ssa += na[k] * na[k]; ssb += dl[k] * dl[k]; }
        const float rsa = rsqrtf(wave_sum(ssa) * (1.f / 512.f) + EPS), rsb = rsqrtf(wave_sum(ssb) * (1.f / 512.f) + EPS);
        u32x4 wa, wb;
        wa.x = pkbf(na[0] * rsa, na[1] * rsa); wa.y = pkbf(na[2] * rsa, na[3] * rsa); wa.z = pkbf(na[4] * rsa, na[5] * rsa); wa.w = pkbf(na[6] * rsa, na[7] * rsa);
        wb.x = pkbf(dl[0] * rsb, dl[1] * rsb); wb.y = pkbf(dl[2] * rsb, dl[3] * rsb); wb.z = pkbf(dl[4] * rsb, dl[5] * rsb); wb.w = pkbf(dl[6] * rsb, dl[7] * rsb);
        pg8::wt_store16(hrs, ((size_t)t * DM + 8 * lane) * 2, wa);
        pg8::wt_store16(hrs, ((size_t)t * DM + 512 + 8 * lane) * 2, wb);
    }
}

__device__ __forceinline__ void ce(float& a, float& b) { const float hi = fmaxf(a, b), lo = fminf(a, b); a = hi; b = lo; }
template <int N> __device__ __forceinline__ void bitonic_sort_desc(float (&v)[N]) {
#pragma unroll
    for (int k = 2; k <= N; k <<= 1)
#pragma unroll
        for (int j = k >> 1; j > 0; j >>= 1)
#pragma unroll
            for (int i = 0; i < N; ++i) { const int l = i ^ j; if (l > i) { if ((i & k) == 0) ce(v[i], v[l]); else ce(v[l], v[i]); } }
}
__device__ __forceinline__ void sort16_desc(float (&v)[16]) {
    ce(v[0], v[1]); ce(v[2], v[3]); ce(v[0], v[2]); ce(v[1], v[3]); ce(v[1], v[2]); ce(v[4], v[5]); ce(v[6], v[7]); ce(v[4], v[6]); ce(v[5], v[7]); ce(v[5], v[6]); ce(v[0], v[4]); ce(v[2], v[6]); ce(v[2], v[4]); ce(v[1], v[5]); ce(v[3], v[7]); ce(v[3], v[5]); ce(v[1], v[2]); ce(v[3], v[4]); ce(v[5], v[6]); ce(v[8], v[9]); ce(v[10], v[11]); ce(v[8], v[10]); ce(v[9], v[11]); ce(v[9], v[10]); ce(v[12], v[13]); ce(v[14], v[15]); ce(v[12], v[14]); ce(v[13], v[15]); ce(v[13], v[14]); ce(v[8], v[12]); ce(v[10], v[14]); ce(v[10], v[12]); ce(v[9], v[13]); ce(v[11], v[15]); ce(v[11], v[13]); ce(v[9], v[10]); ce(v[11], v[12]); ce(v[13], v[14]); ce(v[0], v[8]); ce(v[4], v[12]); ce(v[4], v[8]); ce(v[2], v[10]); ce(v[6], v[14]); ce(v[6], v[10]); ce(v[2], v[4]); ce(v[6], v[8]); ce(v[10], v[12]); ce(v[1], v[9]); ce(v[5], v[13]); ce(v[5], v[9]); ce(v[3], v[11]); ce(v[7], v[15]); ce(v[7], v[11]); ce(v[3], v[5]); ce(v[7], v[9]); ce(v[11], v[13]); ce(v[1], v[2]); ce(v[3], v[4]); ce(v[5], v[6]); ce(v[7], v[8]); ce(v[9], v[10]); ce(v[11], v[12]); ce(v[13], v[14]);
}
template <int N> __device__ __forceinline__ void bitonic_merge_desc(float (&v)[N]) {
#pragma unroll
    for (int j = N >> 1; j > 0; j >>= 1)
#pragma unroll
        for (int i = 0; i < N; ++i) if ((i & j) == 0) ce(v[i], v[i | j]);
}
__device__ __forceinline__ float h2f_lo(unsigned u) { return (float)__builtin_bit_cast(_Float16, (unsigned short)(u & 0xffffu)); }
__device__ __forceinline__ float h2f_hi(unsigned u) { return (float)__builtin_bit_cast(_Float16, (unsigned short)(u >> 16)); }
__device__ __forceinline__ void top16_of_128(const LAS unsigned char* row, float (&run)[16]) {
#pragma unroll
    for (int gi = 0; gi < 8; ++gi) {
        float grp[16];
#pragma unroll
        for (int q4 = 0; q4 < 2; ++q4) { const u32x4 v = *(const LAS u32x4*)(row + gi * 32 + q4 * 16);
#pragma unroll
            for (int e = 0; e < 4; ++e) {
                grp[8 * q4 + 2 * e] = __uint_as_float(__float_as_uint(h2f_lo(v[e])) | (unsigned)(gi * 16 + 8 * q4 + 2 * e));
                grp[8 * q4 + 2 * e + 1] = __uint_as_float(__float_as_uint(h2f_hi(v[e])) | (unsigned)(gi * 16 + 8 * q4 + 2 * e + 1)); } }
        sort16_desc(grp);
        if (gi == 0) {
#pragma unroll
            for (int i = 0; i < 16; ++i) run[i] = grp[i];
        } else {
#pragma unroll
            for (int i = 0; i < 16; ++i) run[i] = fmaxf(run[i], grp[15 - i]);
            bitonic_merge_desc<16>(run);
        }
    }
}
#define CAND(i, j) __uint_as_float((__float_as_uint(v1[i] + v2[j]) & ~0xFFu) | (unsigned)((i) * 16 + (j)))
constexpr int TK_ROW = 272;
__device__ __forceinline__ void tk_stage(const _Float16* SC, LAS unsigned char* wb, int t0, int col0, int lane) {
    u32x4 v[16];
#pragma unroll
    for (int i = 0; i < 16; ++i) { const int pi = i * 64 + lane, row = pi >> 4, ch = pi & 15; v[i] = __builtin_nontemporal_load((const u32x4*)(SC + (size_t)(t0 + row) * NPQ + col0 + ch * 8)); }
#pragma unroll
    for (int i = 0; i < 16; ++i) { const int pi = i * 64 + lane, row = pi >> 4, ch = pi & 15; *(LAS u32x4*)(wb + row * TK_ROW + ch * 16) = v[i]; }
}
__device__ __forceinline__ void topk_phase(const Params& p, LAS unsigned char* lds, int gw, int NGW, int lane, int wave) {
    const _Float16* SC = (const _Float16*)(p.ws + WS_SC);
    unsigned* IDS = (unsigned*)(p.ws + WS_IDS); float* GATES = (float*)(p.ws + WS_GATES);
    LAS unsigned char* wb = lds + wave * (64 * TK_ROW);
    LAS unsigned char* my = wb + lane * TK_ROW;
    const float NEG = -3.0e38f;
    for (int wi = gw; wi < (TOK / 64) * 8; wi += NGW) {
        const int t0 = (wi >> 3) * 64, hh = wi & 7, it = (t0 + lane) * 8 + hh;
        float v1[16], v2[16];
        tk_stage(SC, wb, t0, hh * 256, lane);
        top16_of_128(my, v1);
        tk_stage(SC, wb, t0, hh * 256 + 128, lane);
        top16_of_128(my, v2);
        {
            u32x4 w1, w2;
#define PK4(v, o) ((__float_as_uint(v[o]) & 0x7Fu) | ((__float_as_uint(v[o + 1]) & 0x7Fu) << 8) | ((__float_as_uint(v[o + 2]) & 0x7Fu) << 16) | ((__float_as_uint(v[o + 3]) & 0x7Fu) << 24))
            w1.x = PK4(v1, 0); w1.y = PK4(v1, 4); w1.z = PK4(v1, 8); w1.w = PK4(v1, 12);
            w2.x = PK4(v2, 0); w2.y = PK4(v2, 4); w2.z = PK4(v2, 8); w2.w = PK4(v2, 12);
#undef PK4
            *(LAS u32x4*)my = w1; *(LAS u32x4*)(my + 16) = w2;
        }
        float best[16], grp[16];
        best[0] = CAND(0, 0); best[1] = CAND(0, 1); best[2] = CAND(0, 2); best[3] = CAND(0, 3); best[4] = CAND(0, 4); best[5] = CAND(0, 5); best[6] = CAND(0, 6); best[7] = CAND(0, 7);
        best[8] = CAND(0, 8); best[9] = CAND(0, 9); best[10] = CAND(0, 10); best[11] = CAND(0, 11); best[12] = CAND(0, 12); best[13] = CAND(0, 13); best[14] = CAND(0, 14); best[15] = CAND(0, 15);
        sort16_desc(best);
        grp[0] = CAND(1, 0); grp[1] = CAND(1, 1); grp[2] = CAND(1, 2); grp[3] = CAND(1, 3); grp[4] = CAND(1, 4); grp[5] = CAND(1, 5); grp[6] = CAND(1, 6); grp[7] = CAND(1, 7);
        grp[8] = CAND(2, 0); grp[9] = CAND(2, 1); grp[10] = CAND(2, 2); grp[11] = CAND(2, 3); grp[12] = CAND(2, 4); grp[13] = CAND(3, 0); grp[14] = CAND(3, 1); grp[15] = CAND(3, 2);
        sort16_desc(grp);
#pragma unroll
        for (int i = 0; i < 16; ++i) best[i] = fmaxf(best[i], grp[15 - i]);
        bitonic_merge_desc<16>(best);
        grp[0] = CAND(3, 3); grp[1] = CAND(4, 0); grp[2] = CAND(4, 1); grp[3] = CAND(4, 2); grp[4] = CAND(5, 0); grp[5] = CAND(5, 1); grp[6] = CAND(6, 0); grp[7] = CAND(6, 1);
        grp[8] = CAND(7, 0); grp[9] = CAND(7, 1); grp[10] = CAND(8, 0); grp[11] = CAND(9, 0); grp[12] = CAND(10, 0); grp[13] = CAND(11, 0); grp[14] = CAND(12, 0); grp[15] = CAND(13, 0);
        sort16_desc(grp);
#pragma unroll
        for (int i = 0; i < 16; ++i) best[i] = fmaxf(best[i], grp[15 - i]);
        bitonic_merge_desc<16>(best);
        grp[0] = CAND(14, 0); grp[1] = CAND(15, 0);
#pragma unroll
        for (int i = 2; i < 16; ++i) grp[i] = NEG;
        sort16_desc(grp);
#pragma unroll
        for (int i = 0; i < 16; ++i) best[i] = fmaxf(best[i], grp[15 - i]);
        bitonic_merge_desc<16>(best);
        float e[16], sum = 0.f;
#pragma unroll
        for (int k = 0; k < 16; ++k) { e[k] = __expf(best[k] - best[0]); sum += e[k]; }
        const float isum = 1.f / sum;
        int idv[16];
        asm volatile("s_waitcnt lgkmcnt(0)" ::: "memory");
#pragma unroll
        for (int k = 0; k < 16; ++k) { const unsigned code = __float_as_uint(best[k]) & 0xFFu; const unsigned i1 = my[code >> 4], i2 = my[16 + (code & 15u)]; idv[k] = (int)(i1 * 128u + i2); }
        const int tt = it >> 3;
        unsigned* ip = IDS + (size_t)tt * 64 + hh; float* gp = GATES + (size_t)tt * 128 + 2 * hh;
#pragma unroll
        for (int j = 0; j < 8; ++j) {
            ip[8 * j] = (unsigned)idv[j] | ((unsigned)idv[j + 8] << 16);
            *(f32x2_t*)(gp + 16 * j) = (f32x2_t){e[j] * isum, e[j + 8] * isum};
        }
    }
}
#undef CAND

struct Topo { int xi, nx, rank, nloc; };
constexpr int CW_XCNT = 8192;
__device__ __forceinline__ float wave_max(float v) {
#pragma unroll
    for (int o = 1; o < 64; o <<= 1) v = fmaxf(v, __shfl_xor(v, o));
    return v;
}
__device__ __forceinline__ unsigned pack4(int a, int b, int c, int d) { return ((unsigned)a & 255u) | (((unsigned)b & 255u) << 8) | (((unsigned)c & 255u) << 16) | ((unsigned)d << 24); }
template <int CTRL> __device__ __forceinline__ int dppi(int v) { return __builtin_amdgcn_update_dpp(0, v, CTRL, 0xF, 0xF, false); }

#define PE_LOAD_IDS(ids, tok) do { const u32x4* ip_ = (const u32x4*)(IDST + (size_t)(tok) * 64 + 8 * j); ids[0] = ip_[0]; ids[1] = ip_[1]; } while (0)
#define PE_LOAD_SEGS(seg, ids, tab) do { _Pragma("unroll") for (int i_ = 0; i_ < 16; ++i_) seg[i_] = *(const u32x4*)((tab) + (size_t)((i_ & 1) ? (ids[i_ >> 3][(i_ >> 1) & 3] >> 16) : (ids[i_ >> 3][(i_ >> 1) & 3] & 0xffffu)) * 128); } while (0)

__device__ __forceinline__ void pe_u_compute(const u32x4 (&seg)[16], const u32x4 h8, unsigned* dst, bool live, int lane) {
    int a[16];
#pragma unroll
    for (int i = 0; i < 16; ++i) { int s_ = 0;
#pragma unroll
        for (int w = 0; w < 4; ++w) s_ = __builtin_amdgcn_sdot4((int)seg[i][w], (int)h8[w], s_, false);
        a[i] = s_; }
    const bool q2 = (lane & 4) != 0, q1 = (lane & 2) != 0, q0 = (lane & 1) != 0;
    int c[8], d[4], e[2];
#pragma unroll
    for (int i = 0; i < 8; ++i) { const int keep = q2 ? a[i + 8] : a[i], send = q2 ? a[i] : a[i + 8]; c[i] = keep + dppi<0x141>(send); }
#pragma unroll
    for (int i = 0; i < 4; ++i) { const int keep = q1 ? c[i + 4] : c[i], send = q1 ? c[i] : c[i + 4]; d[i] = keep + dppi<0x4E>(send); }
#pragma unroll
    for (int i = 0; i < 2; ++i) { const int keep = q0 ? d[i + 2] : d[i], send = q0 ? d[i] : d[i + 2]; e[i] = keep + dppi<0xB1>(send); }
    if (live) *dst = pkh((float)e[0] * (1.f / 64.f), (float)e[1] * (1.f / 64.f));
}
__device__ __forceinline__ void peer_u_phase(const Params& p, const Topo& tp, int lane, int wave) {
    const unsigned* IDST = (const unsigned*)(p.ws + WS_IDS); const unsigned char* H8 = p.ws + WS_H8; unsigned* PART = (unsigned*)(p.ws + WS_PART);
    const int j = lane >> 3, q = lane & 7;
    const int wv = tp.rank * 8 + wave, nwv = tp.nloc * 8;
    for (int s = tp.xi; s < 8; s += tp.nx) {
        const unsigned char* tab = p.ws + WS_UH + (size_t)s * NEXP * 128 + 16 * q;
        const unsigned char* hb = H8 + 128 * s + 16 * q;
        unsigned* pb = PART + (size_t)s * TOK * 64 + j * 8 + q;
        u32x4 idsA[2], idsB[2], segA[16], segB[16], h8A, h8B;
        int t = wv;
#define TC(x) ((x) < TOK ? (x) : TOK - 1)
        PE_LOAD_IDS(idsA, TC(t));
        PE_LOAD_IDS(idsB, TC(t + nwv));
        PE_LOAD_SEGS(segA, idsA, tab); h8A = *(const u32x4*)(hb + (size_t)TC(t) * 1024);
        for (; t < TOK; t += 8 * nwv) {
            PE_LOAD_IDS(idsA, TC(t + (2 + 0) * nwv));
            __builtin_amdgcn_sched_barrier(0);
            PE_LOAD_SEGS(segB, idsB, tab); h8B = *(const u32x4*)(hb + (size_t)TC(t + (1 + 0) * nwv) * 1024);
            __builtin_amdgcn_sched_barrier(0);
            pe_u_compute(segA, h8A, pb + (size_t)TC(t + (0) * nwv) * 64, t + (0) * nwv < TOK, lane);
            PE_LOAD_IDS(idsB, TC(t + (3 + 0) * nwv));
            __builtin_amdgcn_sched_barrier(0);
            PE_LOAD_SEGS(segA, idsA, tab); h8A = *(const u32x4*)(hb + (size_t)TC(t + (2 + 0) * nwv) * 1024);
            __builtin_amdgcn_sched_barrier(0);
            pe_u_compute(segB, h8B, pb + (size_t)TC(t + (1 + 0) * nwv) * 64, t + (1 + 0) * nwv < TOK, lane);
            PE_LOAD_IDS(idsA, TC(t + (2 + 2) * nwv));
            __builtin_amdgcn_sched_barrier(0);
            PE_LOAD_SEGS(segB, idsB, tab); h8B = *(const u32x4*)(hb + (size_t)TC(t + (1 + 2) * nwv) * 1024);
            __builtin_amdgcn_sched_barrier(0);
            pe_u_compute(segA, h8A, pb + (size_t)TC(t + (2) * nwv) * 64, t + (2) * nwv < TOK, lane);
            PE_LOAD_IDS(idsB, TC(t + (3 + 2) * nwv));
            __builtin_amdgcn_sched_barrier(0);
            PE_LOAD_SEGS(segA, idsA, tab); h8A = *(const u32x4*)(hb + (size_t)TC(t + (2 + 2) * nwv) * 1024);
            __builtin_amdgcn_sched_barrier(0);
            pe_u_compute(segB, h8B, pb + (size_t)TC(t + (1 + 2) * nwv) * 64, t + (1 + 2) * nwv < TOK, lane);
            PE_LOAD_IDS(idsA, TC(t + (2 + 4) * nwv));
            __builtin_amdgcn_sched_barrier(0);
            PE_LOAD_SEGS(segB, idsB, tab); h8B = *(const u32x4*)(hb + (size_t)TC(t + (1 + 4) * nwv) * 1024);
            __builtin_amdgcn_sched_barrier(0);
            pe_u_compute(segA, h8A, pb + (size_t)TC(t + (4) * nwv) * 64, t + (4) * nwv < TOK, lane);
            PE_LOAD_IDS(idsB, TC(t + (3 + 4) * nwv));
            __builtin_amdgcn_sched_barrier(0);
            PE_LOAD_SEGS(segA, idsA, tab); h8A = *(const u32x4*)(hb + (size_t)TC(t + (2 + 4) * nwv) * 1024);
            __builtin_amdgcn_sched_barrier(0);
            pe_u_compute(segB, h8B, pb + (size_t)TC(t + (1 + 4) * nwv) * 64, t + (1 + 4) * nwv < TOK, lane);
            PE_LOAD_IDS(idsA, TC(t + (2 + 6) * nwv));
            __builtin_amdgcn_sched_barrier(0);
            PE_LOAD_SEGS(segB, idsB, tab); h8B = *(const u32x4*)(hb + (size_t)TC(t + (1 + 6) * nwv) * 1024);
            __builtin_amdgcn_sched_barrier(0);
            pe_u_compute(segA, h8A, pb + (size_t)TC(t + (6) * nwv) * 64, t + (6) * nwv < TOK, lane);
            PE_LOAD_IDS(idsB, TC(t + (3 + 6) * nwv));
            __builtin_amdgcn_sched_barrier(0);
            PE_LOAD_SEGS(segA, idsA, tab); h8A = *(const u32x4*)(hb + (size_t)TC(t + (2 + 6) * nwv) * 1024);
            __builtin_amdgcn_sched_barrier(0);
            pe_u_compute(segB, h8B, pb + (size_t)TC(t + (1 + 6) * nwv) * 64, t + (1 + 6) * nwv < TOK, lane);
        }
    }
}
__device__ __forceinline__ void peer_w_phase(const Params& p, int gw, int NGW, int lane) {
    const unsigned* IDST = (const unsigned*)(p.ws + WS_IDS); const float* GT = (const float*)(p.ws + WS_GATES); const unsigned* PART = (const unsigned*)(p.ws + WS_PART);
    const float* SU = (const float*)(p.ws + WS_SU); const float* SV = (const float*)(p.ws + WS_SV); const float* SH = (const float*)(p.ws + WS_SH);
    unsigned short* W8 = (unsigned short*)(p.ws + WS_W8); float* SW = (float*)(p.ws + WS_SW);
    for (int t = gw; t < TOK; t += NGW) {
        const size_t ix = (size_t)t * 128 + 2 * lane;
        float a0 = 0.f, a1 = 0.f;
#pragma unroll
        for (int s = 0; s < 8; ++s) { const unsigned v = __builtin_nontemporal_load(PART + (size_t)s * TOK * 64 + (ix >> 1)); a0 += h2f_lo(v); a1 += h2f_hi(v); }
        const unsigned idp = IDST[ix >> 1]; const u32x2 id = {idp & 0xffffu, idp >> 16}; const f32x2_t g = *(const f32x2_t*)(GT + ix);
        const float sh = SH[t];
        const float x0 = a0 * 64.f * SU[id.x] * sh, x1 = a1 * 64.f * SU[id.y] * sh;
        const float w0 = g.x * 0.5f * x0 * (1.f + erff(x0 * 0.70710678118654752f)) * SV[id.x];
        const float w1 = g.y * 0.5f * x1 * (1.f + erff(x1 * 0.70710678118654752f)) * SV[id.y];
        const float wm = wave_max(fmaxf(fabsf(w0), fabsf(w1)));
        const float inv = wm > 0.f ? 127.f / wm : 0.f;
        W8[ix >> 1] = (unsigned short)(((unsigned)((int)rintf(w0 * inv)) & 255u) | (((unsigned)((int)rintf(w1 * inv)) & 255u) << 8));
        if (lane == 0) SW[t] = wm * (1.f / 127.f);
    }
}
__device__ __forceinline__ void pe_v_compute(const u32x4 (&seg)[16], const u32x4 w8, float sw, bf16_t* dst, bool live, int lane) {
    int o[16];
#pragma unroll
    for (int i = 0; i < 16; ++i) o[i] = 0;
#pragma unroll
    for (int qd = 0; qd < 4; ++qd)
#pragma unroll
        for (int w = 0; w < 4; ++w) {
            const unsigned ra = seg[4 * qd][w], rb = seg[4 * qd + 1][w], rc = seg[4 * qd + 2][w], rd = seg[4 * qd + 3][w];
            const unsigned abl = __builtin_amdgcn_perm(rb, ra, 0x05010400u), abh = __builtin_amdgcn_perm(rb, ra, 0x07030602u);
            const unsigned cdl = __builtin_amdgcn_perm(rd, rc, 0x05010400u), cdh = __builtin_amdgcn_perm(rd, rc, 0x07030602u);
            o[4 * w + 0] = __builtin_amdgcn_sdot4((int)__builtin_amdgcn_perm(cdl, abl, 0x05040100u), (int)w8[qd], o[4 * w + 0], false);
            o[4 * w + 1] = __builtin_amdgcn_sdot4((int)__builtin_amdgcn_perm(cdl, abl, 0x07060302u), (int)w8[qd], o[4 * w + 1], false);
            o[4 * w + 2] = __builtin_amdgcn_sdot4((int)__builtin_amdgcn_perm(cdh, abh, 0x05040100u), (int)w8[qd], o[4 * w + 2], false);
            o[4 * w + 3] = __builtin_amdgcn_sdot4((int)__builtin_amdgcn_perm(cdh, abh, 0x07060302u), (int)w8[qd], o[4 * w + 3], false);
        }
    int b[8], c[4], d[2];
#pragma unroll
    for (int m = 0; m < 8; ++m) { auto r = __builtin_amdgcn_permlane32_swap((unsigned)o[m], (unsigned)o[m + 8], false, false); b[m] = (int)r[0] + (int)r[1]; }
#pragma unroll
    for (int m = 0; m < 4; ++m) { auto r = __builtin_amdgcn_permlane16_swap((unsigned)b[m], (unsigned)b[m + 4], false, false); c[m] = (int)r[0] + (int)r[1]; }
    const bool b3 = (lane & 8) != 0;
#pragma unroll
    for (int m = 0; m < 2; ++m) { const int keep = b3 ? c[m + 2] : c[m], send = b3 ? c[m] : c[m + 2]; d[m] = keep + dppi<0x128>(send); }
    if (live) *(unsigned*)dst = pkbf((float)d[0] * sw, (float)d[1] * sw);
}
__device__ __forceinline__ void peer_v_phase(const Params& p, const Topo& tp, int lane, int wave) {
    const unsigned* IDST = (const unsigned*)(p.ws + WS_IDS); const unsigned char* W8 = p.ws + WS_W8; const float* SW = (const float*)(p.ws + WS_SW); bf16_t* PEER = (bf16_t*)(p.ws + WS_PEER);
    const int j = lane >> 3, q = lane & 7;
    const int wv = tp.rank * 8 + wave, nwv = tp.nloc * 8;
    for (int s = tp.xi; s < 8; s += tp.nx) {
        const unsigned char* tab = p.ws + WS_VH + (size_t)s * NEXP * 128 + 16 * q;
        const unsigned char* wb = W8 + 16 * j;
        bf16_t* ob = PEER + 128 * s + 16 * q + 2 * j;
        u32x4 idsA[2], idsB[2], segA[16], segB[16], w8A, w8B; float swA, swB;
        int t = wv;
        PE_LOAD_IDS(idsA, TC(t));
        PE_LOAD_IDS(idsB, TC(t + nwv));
        PE_LOAD_SEGS(segA, idsA, tab); w8A = *(const u32x4*)(wb + (size_t)TC(t) * 128); swA = SW[TC(t)];
        for (; t < TOK; t += 8 * nwv) {
            PE_LOAD_IDS(idsA, TC(t + (2 + 0) * nwv));
            __builtin_amdgcn_sched_barrier(0);
            PE_LOAD_SEGS(segB, idsB, tab); w8B = *(const u32x4*)(wb + (size_t)TC(t + (1 + 0) * nwv) * 128); swB = SW[TC(t + (1 + 0) * nwv)];
            __builtin_amdgcn_sched_barrier(0);
            pe_v_compute(segA, w8A, swA, ob + (size_t)TC(t + (0) * nwv) * DM, t + (0) * nwv < TOK, lane);
            PE_LOAD_IDS(idsB, TC(t + (3 + 0) * nwv));
            __builtin_amdgcn_sched_barrier(0);
            PE_LOAD_SEGS(segA, idsA, tab); w8A = *(const u32x4*)(wb + (size_t)TC(t + (2 + 0) * nwv) * 128); swA = SW[TC(t + (2 + 0) * nwv)];
            __builtin_amdgcn_sched_barrier(0);
            pe_v_compute(segB, w8B, swB, ob + (size_t)TC(t + (1 + 0) * nwv) * DM, t + (1 + 0) * nwv < TOK, lane);
            PE_LOAD_IDS(idsA, TC(t + (2 + 2) * nwv));
            __builtin_amdgcn_sched_barrier(0);
            PE_LOAD_SEGS(segB, idsB, tab); w8B = *(const u32x4*)(wb + (size_t)TC(t + (1 + 2) * nwv) * 128); swB = SW[TC(t + (1 + 2) * nwv)];
            __builtin_amdgcn_sched_barrier(0);
            pe_v_compute(segA, w8A, swA, ob + (size_t)TC(t + (2) * nwv) * DM, t + (2) * nwv < TOK, lane);
            PE_LOAD_IDS(idsB, TC(t + (3 + 2) * nwv));
            __builtin_amdgcn_sched_barrier(0);
            PE_LOAD_SEGS(segA, idsA, tab); w8A = *(const u32x4*)(wb + (size_t)TC(t + (2 + 2) * nwv) * 128); swA = SW[TC(t + (2 + 2) * nwv)];
            __builtin_amdgcn_sched_barrier(0);
            pe_v_compute(segB, w8B, swB, ob + (size_t)TC(t + (1 + 2) * nwv) * DM, t + (1 + 2) * nwv < TOK, lane);
            PE_LOAD_IDS(idsA, TC(t + (2 + 4) * nwv));
            __builtin_amdgcn_sched_barrier(0);
            PE_LOAD_SEGS(segB, idsB, tab); w8B = *(const u32x4*)(wb + (size_t)TC(t + (1 + 4) * nwv) * 128); swB = SW[TC(t + (1 + 4) * nwv)];
            __builtin_amdgcn_sched_barrier(0);
            pe_v_compute(segA, w8A, swA, ob + (size_t)TC(t + (4) * nwv) * DM, t + (4) * nwv < TOK, lane);
            PE_LOAD_IDS(idsB, TC(t + (3 + 4) * nwv));
            __builtin_amdgcn_sched_barrier(0);
            PE_LOAD_SEGS(segA, idsA, tab); w8A = *(const u32x4*)(wb + (size_t)TC(t + (2 + 4) * nwv) * 128); swA = SW[TC(t + (2 + 4) * nwv)];
            __builtin_amdgcn_sched_barrier(0);
            pe_v_compute(segB, w8B, swB, ob + (size_t)TC(t + (1 + 4) * nwv) * DM, t + (1 + 4) * nwv < TOK, lane);
            PE_LOAD_IDS(idsA, TC(t + (2 + 6) * nwv));
            __builtin_amdgcn_sched_barrier(0);
            PE_LOAD_SEGS(segB, idsB, tab); w8B = *(const u32x4*)(wb + (size_t)TC(t + (1 + 6) * nwv) * 128); swB = SW[TC(t + (1 + 6) * nwv)];
            __builtin_amdgcn_sched_barrier(0);
            pe_v_compute(segA, w8A, swA, ob + (size_t)TC(t + (6) * nwv) * DM, t + (6) * nwv < TOK, lane);
            PE_LOAD_IDS(idsB, TC(t + (3 + 6) * nwv));
            __builtin_amdgcn_sched_barrier(0);
            PE_LOAD_SEGS(segA, idsA, tab); w8A = *(const u32x4*)(wb + (size_t)TC(t + (2 + 6) * nwv) * 128); swA = SW[TC(t + (2 + 6) * nwv)];
            __builtin_amdgcn_sched_barrier(0);
            pe_v_compute(segB, w8B, swB, ob + (size_t)TC(t + (1 + 6) * nwv) * DM, t + (1 + 6) * nwv < TOK, lane);
        }
    }
}
#undef TC
#undef PE_LOAD_IDS
#undef PE_LOAD_SEGS
__device__ __forceinline__ void final_phase(const Params& p, float* dstbase, int gw, int NGW, int lane) {
    const float* mod = (const float*)(p.ws + WS_MOD); const bf16_t* PEER = (const bf16_t*)(p.ws + WS_PEER);
    f32x4 fg[4];
#pragma unroll
    for (int j = 0; j < 4; ++j) fg[j] = *(const f32x4*)(p.final_g + 4 * lane + 256 * j);
    const __amdgpu_buffer_rsrc_t ors = pg8::wt_rsrc(dstbase);
    for (int t = gw; t < TOK; t += NGW) {
        const float* mb = mod + (size_t)(t >> 11) * 6144 + 5120;
        const f32x4* xr = (const f32x4*)(p.x + (size_t)t * DM) + lane; const u32x2* pr = (const u32x2*)(PEER + (size_t)t * DM) + lane; const u32x2* zr = (const u32x2*)((const bf16_t*)(p.ws + WS_Z) + (size_t)t * DM) + lane;
        f32x4* xw = (f32x4*)(dstbase + (size_t)t * DM) + lane;
        f32x4 x2[4]; float ss = 0.f;
#pragma unroll
        for (int j = 0; j < 4; ++j) { const f32x4 g2 = *(const f32x4*)(mb + 4 * lane + 256 * j); const u32x2 pv = __builtin_nontemporal_load(pr + 64 * j), zv = __builtin_nontemporal_load(zr + 64 * j); x2[j] = __builtin_nontemporal_load(xr + 64 * j) + (f32x4){bf_lo(zv.x), bf_hi(zv.x), bf_lo(zv.y), bf_hi(zv.y)} + g2 * (f32x4){bf_lo(pv.x), bf_hi(pv.x), bf_lo(pv.y), bf_hi(pv.y)};
            ss += (x2[j][0] * x2[j][0] + x2[j][1] * x2[j][1]) + (x2[j][2] * x2[j][2] + x2[j][3] * x2[j][3]); }
        const float rs = rsqrtf(wave_sum(ss) * (1.f / DM) + EPS);
#pragma unroll
        for (int j = 0; j < 4; ++j) pg8::wt_store16(ors, ((size_t)t * DM + 4 * lane + 256 * j) * 4, __builtin_bit_cast(u32x4, x2[j] * rs * fg[j]));
    }
}

#ifndef MK_PROF_PHASE
#define MK_PROF_PHASE -1
#endif
#ifndef MK_PROF_MULT
#define MK_PROF_MULT 4
#endif
__global__ void __launch_bounds__(512, 2) mk_fwd(Params p) {
    extern __shared__ __attribute__((aligned(16))) unsigned char lds_raw[];
    LAS unsigned char* lds = (LAS unsigned char*)lds_raw;
    const int tid = threadIdx.x, lane = tid & 63, wave = __builtin_amdgcn_readfirstlane(tid >> 6);
    const int G = gridDim.x, bx = blockIdx.x;
    const int vcu = (G % 8 == 0) ? (bx % 8) * (G / 8) + bx / 8 : bx;
    const int gw = vcu * 8 + wave, NGW = G * 8;
    const float* mod = (const float*)(p.ws + WS_MOD);
    bf16_t* Hb = (bf16_t*)(p.ws + WS_H);
#if MK_COOP
    volatile LAS unsigned* bst = (volatile LAS unsigned*)(lds + LDS_BYTES - 16);
    if (tid < 4) bst[tid] = 0u;
    __syncthreads();
    const XcdBarrier xb = xcd_barrier_post((unsigned*)(p.ws + WS_CTL) + 1024, bst);
    if (tid == 0) bst[2] = __hip_atomic_fetch_add((unsigned*)(p.ws + WS_CTL) + CW_XCNT + 64 * xb.x, 1u, __ATOMIC_RELAXED, __HIP_MEMORY_SCOPE_AGENT);
#define PHASE_END(k) do { if ((k) + 1 < p.ph_hi) xcd_barrier(xb); } while (0)
#else
#define PHASE_END(k) do { } while (0)
#endif
#define IN(k) (p.ph_lo <= (k) && (k) < p.ph_hi)
#if MK_PROF_PHASE >= 0
    unsigned long long pt_prev_ = __builtin_amdgcn_s_memrealtime(), pdt_ = 0ull;
#define PMARK(k) do { const unsigned long long n_ = __builtin_amdgcn_s_memrealtime(); if ((k) == MK_PROF_PHASE) pdt_ = n_ - pt_prev_; pt_prev_ = n_; } while (0)
#else
#define PMARK(k) do { } while (0)
#endif
    if (IN(0)) { p0_mod(p, lds, tid, lane, wave); PHASE_END(0); PMARK(0); }
    if (IN(1)) { p0_weights(p, lds, tid, lane, wave); norm_rows<false>(p.x, nullptr, p.norm1_g, mod, 0, 1024, Hb, nullptr, nullptr, gw, NGW, lane); PHASE_END(1); PMARK(1); }
    if (IN(2)) {
        pg8::Gemm g{Hb, (const bf16_t*)(p.ws + WS_WIN), TOK, NQKV, DM}; pg8::StaticOrder S; S.init(TOK, NQKV, G, bx);
        pg8::EpiQKV E{(bf16_t*)(p.ws + WS_QKV), NQKV, QSCALE};
        pg8::gemm_phase<pg8::EpiQKV, pg8::StaticOrder, true, true>(lds, g, S, E);
        PHASE_END(2); PMARK(2);
    }
    if (IN(3)) { attn_phase(p, lds, tid, lane, wave, vcu, G); PHASE_END(3); PMARK(3); }
    if (IN(4)) { merge_norm(p, gw, NGW, lane); PHASE_END(4); PMARK(4); }
    if (IN(5)) {
        pg8::Gemm g{Hb, (const bf16_t*)(p.ws + WS_WOUT), TOK, DM, DM}; pg8::StaticOrder S; S.init(TOK, DM, G, bx);
        pg8::EpiZ E{(bf16_t*)(p.ws + WS_Z), mod};
        pg8::gemm_phase<pg8::EpiZ, pg8::StaticOrder, true, true>(lds, g, S, E);
        PHASE_END(5); PMARK(5);
    }
    if (IN(6)) { norm_rows<true>(p.x, (const bf16_t*)(p.ws + WS_Z), p.norm2_g, mod, 3072, 4096, Hb, p.ws + WS_H8, (float*)(p.ws + WS_SH), gw, NGW, lane); PHASE_END(6); PMARK(6); }
    if (IN(7)) {
        pg8::Gemm g{Hb, (const bf16_t*)(p.ws + WS_WSC), TOK, NPQ, DM}; pg8::StaticOrder S; S.init(TOK, NPQ, G, bx);
        pg8::EpiSC E{(_Float16*)(p.ws + WS_SC), NPQ};
        pg8::gemm_phase<pg8::EpiSC, pg8::StaticOrder, true, true>(lds, g, S, E);
        PHASE_END(7); PMARK(7);
    }
    if (IN(8)) { topk_phase(p, lds, gw, NGW, lane, wave); PHASE_END(8); PMARK(8); }
    Topo tp; tp.xi = 0; tp.nx = 1; tp.rank = bx; tp.nloc = G;
#if MK_COOP
    if (IN(9) || IN(11)) {
        const unsigned* xc = (const unsigned*)(p.ws + WS_CTL) + CW_XCNT; int nx = 0, xi = 0, nloc = 1;
        for (int jx = 0; jx < 16; ++jx) { const unsigned cnt = __hip_atomic_load(xc + 64 * jx, __ATOMIC_RELAXED, __HIP_MEMORY_SCOPE_AGENT); if (cnt) { if (jx < (int)xb.x) ++xi; if (jx == (int)xb.x) nloc = (int)cnt; ++nx; } }
        tp.xi = xi; tp.nx = nx > 0 ? nx : 1; tp.rank = (int)bst[2]; tp.nloc = nloc;
    }
#endif
    if (IN(9)) { peer_u_phase(p, tp, lane, wave); PHASE_END(9); PMARK(9); }
    if (IN(10)) { peer_w_phase(p, gw, NGW, lane); PHASE_END(10); PMARK(10); }
    if (IN(11)) { peer_v_phase(p, tp, lane, wave); PHASE_END(11); PMARK(11); }
    if (IN(12)) { final_phase(p, p.out, gw, NGW, lane); }
#if MK_PROF_PHASE >= 0
    if (blockIdx.x == 0 && threadIdx.x < 64) { const unsigned long long t0_ = __builtin_amdgcn_s_memrealtime(), d_ = pdt_ * MK_PROF_MULT; while (__builtin_amdgcn_s_memrealtime() - t0_ < d_) __builtin_amdgcn_s_sleep(8); }
#endif
#undef IN
#undef PHASE_END
}

extern "C" void kernel_launch(void* const* d_in, const int* in_sizes, int n_in, void* d_out, int out_size, void* d_ws, size_t ws_size, hipStream_t stream) {
    static int grid = 0;
    if (grid == 0) {
        if (n_in != 16 || in_sizes[0] != TOK * DM || out_size != TOK * DM || ws_size < WS_END) {
            fprintf(stderr, "kernel_launch: unexpected shapes (n_in %d, in0 %d, out %d, ws %zu)\n", n_in, n_in > 0 ? in_sizes[0] : -1, out_size, ws_size); grid = -1; return; }
        int dev = 0, cus = 0, per_cu = 0;
        if (hipGetDevice(&dev) != hipSuccess || hipDeviceGetAttribute(&cus, hipDeviceAttributeMultiprocessorCount, dev) != hipSuccess) { grid = -1; return; }
        if (hipFuncSetAttribute((const void*)mk_fwd, hipFuncAttributeMaxDynamicSharedMemorySize, LDS_BYTES) != hipSuccess) { fprintf(stderr, "kernel_launch: hipFuncSetAttribute failed\n"); grid = -1; return; }
        if (hipOccupancyMaxActiveBlocksPerMultiprocessor(&per_cu, (const void*)mk_fwd, 512, LDS_BYTES) != hipSuccess || per_cu < 1) { fprintf(stderr, "kernel_launch: occupancy query says %d blocks per CU\n", per_cu); per_cu = 1; }
        (void)hipGetLastError();
        grid = cus;
        if (grid > 2048) { fprintf(stderr, "kernel_launch: %d CUs: the attention phase's table-conversion schedule assumes at most 2048 workgroups\n", grid); grid = -1; return; }
    }
    if (grid < 0) return;
    Params p{};
    p.x = (const float*)d_in[0]; p.c = (const float*)d_in[1]; p.ada_w = (const float*)d_in[2]; p.ada_b = (const float*)d_in[3]; p.norm1_g = (const float*)d_in[4];
    p.w_in = (const float*)d_in[5]; p.na_rpb = (const float*)d_in[6]; p.ong_na = (const float*)d_in[7]; p.ong_dil = (const float*)d_in[8]; p.w_out = (const float*)d_in[9];
    p.norm2_g = (const float*)d_in[10]; p.peer_wq = (const float*)d_in[11]; p.peer_sk = (const float*)d_in[12]; p.peer_u = (const float*)d_in[13]; p.peer_v = (const float*)d_in[14];
    p.final_g = (const float*)d_in[15]; p.out = (float*)d_out; p.ws = (unsigned char*)d_ws;
#if MK_COOP
    if (hipMemsetAsync((char*)d_ws + WS_CTL, 0, 65536, stream) != hipSuccess) { fprintf(stderr, "kernel_launch: memset of the barrier words failed\n"); return; }
    p.ph_lo = 0; p.ph_hi = NPHASE;
    void* args[] = {&p};
    const hipError_t e = hipLaunchCooperativeKernel((const void*)mk_fwd, dim3(grid), dim3(512), args, LDS_BYTES, stream);
    if (e != hipSuccess) fprintf(stderr, "kernel_launch: cooperative launch failed: %s (grid %d)\n", hipGetErrorString(e), grid);
#else
    for (int k = 0; k < NPHASE; ++k) { p.ph_lo = k; p.ph_hi = k + 1; hipLaunchKernelGGL(mk_fwd, dim3(grid), dim3(512), LDS_BYTES, stream, p); }
#endif
}
```

```cpp
#include <hip/hip_runtime.h>
#include <cstdio>
#include <cstdint>

#ifndef MK_COOP
#define MK_COOP 1
#endif

constexpr int DM = 1024, BATCH = 16, SEQ = 2048, TOK = BATCH * SEQ;
constexpr int NQKV = 3072, NPQ = 2048, NEXP = 16384;
constexpr float EPS = 1e-6f;
constexpr float LOG2E = 1.4426950408889634f;
constexpr float QSCALE = 0.125f * LOG2E;

constexpr size_t MiB = 1u << 20;
constexpr size_t WS_CTL = 0;
constexpr size_t WS_MOD = 1 * MiB;
constexpr size_t WS_WIN = 2 * MiB;
constexpr size_t WS_WOUT = 8 * MiB;
constexpr size_t WS_WSC = 10 * MiB;
constexpr size_t WS_SU = 14 * MiB;
constexpr size_t WS_SV = 14 * MiB + 65536;
constexpr size_t WS_UH = 16 * MiB;
constexpr size_t WS_VH = 48 * MiB;
constexpr size_t WS_H = 80 * MiB;
constexpr size_t WS_QKV = 144 * MiB;
constexpr size_t WS_ONA = 336 * MiB;
constexpr size_t WS_OD = 368 * MiB;
constexpr size_t WS_LSE = 464 * MiB;
constexpr size_t WS_IDS = 468 * MiB;
constexpr size_t WS_GATES = 484 * MiB;
constexpr size_t WS_SC = 144 * MiB;
constexpr size_t WS_PART = 144 * MiB;
constexpr size_t WS_PEER = 272 * MiB;
constexpr size_t WS_Z = 336 * MiB;
constexpr size_t WS_H8 = 400 * MiB;
constexpr size_t WS_W8 = 432 * MiB;
constexpr size_t WS_SH = 436 * MiB;
constexpr size_t WS_SW = 437 * MiB;
constexpr size_t WS_END = 500 * MiB;

constexpr int LDS_BYTES = 147456;

#define LAS __attribute__((address_space(3)))
typedef unsigned short bf16_t;
typedef short bf16x8 __attribute__((ext_vector_type(8)));
typedef float f32x4 __attribute__((ext_vector_type(4)));
typedef unsigned u32x4 __attribute__((ext_vector_type(4)));
typedef unsigned u32x2 __attribute__((ext_vector_type(2)));
typedef float f32x2_t __attribute__((ext_vector_type(2)));
typedef __bf16 bf16x2_t __attribute__((ext_vector_type(2)));
typedef _Float16 h2_t __attribute__((ext_vector_type(2)));
typedef short v4i16_t __attribute__((ext_vector_type(4)));

__device__ __forceinline__ unsigned pkbf(float lo, float hi) { f32x2_t v = {lo, hi}; bf16x2_t b = __builtin_convertvector(v, bf16x2_t); return __builtin_bit_cast(unsigned, b); }
__device__ __forceinline__ unsigned pkh(float lo, float hi) { h2_t h = {(_Float16)lo, (_Float16)hi}; return __builtin_bit_cast(unsigned, h); }
__device__ __forceinline__ float bf_lo(unsigned u) { return __uint_as_float(u << 16); }
__device__ __forceinline__ float bf_hi(unsigned u) { return __uint_as_float(u & 0xffff0000u); }
__device__ __forceinline__ float wave_sum(float v) {
#pragma unroll
    for (int o = 1; o < 64; o <<= 1) v += __shfl_xor(v, o);
    return v;
}

#define XB_TMO      128
#define XB_XCNT(j)  (256  + 64 * (j))
#define XB_XSUB(j)  (1280 + 64 * (j))
#define XB_XGEN(j)  (2304 + 64 * (j))
#define XB_TOP      3328
#define XB_TOPGEN   3392
#define XCD_BAR_WORDS 3456
#define XB_SPIN_CAP (1u << 18)

__device__ __forceinline__ unsigned xb_ld(unsigned* p)              { return __hip_atomic_load(p, __ATOMIC_RELAXED, __HIP_MEMORY_SCOPE_AGENT); }
__device__ __forceinline__ unsigned xb_add(unsigned* p, unsigned v) { return __hip_atomic_fetch_add(p, v, __ATOMIC_RELAXED, __HIP_MEMORY_SCOPE_AGENT); }
__device__ __forceinline__ unsigned xb_xcc_id() { return (unsigned)__builtin_amdgcn_s_getreg((3 << 11) | 20) & 0xFu; }
#define XB_SPIN(cond, bar) do { unsigned _sp = 0; while (cond) { __builtin_amdgcn_s_sleep(1); \
    if ((++_sp & 255u) == 0u) { if (xb_ld(&(bar)[XB_TMO])) break; if (_sp > XB_SPIN_CAP) { atomicAdd(&(bar)[XB_TMO], 1u); break; } } } } while (0)

struct XcdBarrier {
    unsigned* bar; unsigned x;
    volatile LAS unsigned* st;
};

__device__ __forceinline__ XcdBarrier xcd_barrier_post(unsigned* bar, volatile LAS unsigned* st) {
    XcdBarrier b; b.bar = bar; b.x = xb_xcc_id(); b.st = st;
    if (threadIdx.x == 0) (void)xb_add(&bar[XB_XCNT(b.x)], 1u);
    return b;
}
__device__ __forceinline__ void xcd_barrier_complete(unsigned* bar, unsigned x, unsigned& nloc, unsigned& nx) {
    const unsigned G = gridDim.x * gridDim.y * gridDim.z;
    unsigned sum, cnt, mine, sp = 0u;
    for (;;) {
        sum = 0u; cnt = 0u; mine = 0u;
#pragma unroll
        for (unsigned j = 0; j < 16; ++j) { const unsigned c = xb_ld(&bar[XB_XCNT(j)]); sum += c; cnt += (c > 0u) ? 1u : 0u; mine = (j == x) ? c : mine; }
        if (sum == G) break;
        __builtin_amdgcn_s_sleep(1);
        if ((++sp & 255u) == 0u) { if (xb_ld(&bar[XB_TMO])) break; if (sp > XB_SPIN_CAP) { atomicAdd(&bar[XB_TMO], 1u); break; } }
    }
    nloc = mine > 0u ? mine : 1u; nx = cnt > 0u ? cnt : 1u;
}

__device__ __forceinline__ void xcd_barrier(const XcdBarrier& b) {
    asm volatile("s_waitcnt vmcnt(0)" ::: "memory");
    __syncthreads();
    if (threadIdx.x == 0) {
        unsigned* bar = b.bar;
        __builtin_amdgcn_s_waitcnt(0);
        unsigned nloc = b.st[0], nx = b.st[1];
        if (nloc == 0u) { xcd_barrier_complete(bar, b.x, nloc, nx); b.st[0] = nloc; b.st[1] = nx; }
        const unsigned old = xb_add(&bar[XB_XSUB(b.x)], 1u);
        const unsigned gen = old / nloc;
        if (old + 1u == (gen + 1u) * nloc) {
            __builtin_amdgcn_fence(__ATOMIC_RELEASE, "agent");
            asm volatile("s_waitcnt vmcnt(0)" ::: "memory");
            const unsigned og = xb_add(&bar[XB_TOP], 1u);
            const unsigned tg = og / nx;
            if (og + 1u == (tg + 1u) * nx) xb_add(&bar[XB_TOPGEN], 1u);
            else XB_SPIN(xb_ld(&bar[XB_TOPGEN]) == tg, bar);
            __builtin_amdgcn_fence(__ATOMIC_ACQUIRE, "agent");
            xb_add(&bar[XB_XGEN(b.x)], 1u);
            asm volatile("s_waitcnt vmcnt(0)" ::: "memory");
        } else {
            XB_SPIN(xb_ld(&bar[XB_XGEN(b.x)]) == gen, bar);
            __builtin_amdgcn_fence(__ATOMIC_ACQUIRE, "agent");
            asm volatile("s_waitcnt vmcnt(0)" ::: "memory");
        }
    }
    __syncthreads();
}

namespace pg8 {
#define PG8_LAS __attribute__((address_space(3)))
typedef unsigned short bf16_t;
typedef short bf16x8 __attribute__((ext_vector_type(8)));
typedef float f32x4 __attribute__((ext_vector_type(4)));
typedef unsigned u32x4 __attribute__((ext_vector_type(4)));
constexpr int BM = 256, BK = 64, HALF = 128, HTB = HALF * BK * 2  , STAGE_BYTES = 8 * HTB, NXCD = 8, WGM = 8;

__host__ __device__ __forceinline__ int lds_byte(int r, int c) { const int st = (r >> 4) * 2 + (c >> 5), rr = r & 15, cc = c & 31, ob = rr * 64 + cc * 2; return st * 1024 + (ob ^ (((ob >> 9) & 1) << 5)); }
__host__ __device__ __forceinline__ void stage_rc(int b, int& R, int& C) { const int st = b / 1024, sb = b % 1024, swz = sb ^ (((sb >> 9) & 1) << 5); R = (st >> 1) * 16 + swz / 64; C = (st & 1) * 32 + (swz % 64) / 2; }
__host__ __device__ __forceinline__ int perm32(int rho) { const int n = rho >> 4, i = rho & 15; return 8 * (i >> 2) + 4 * n + (i & 3); }

struct Unit { int pm, pn; };
struct Gemm { const bf16_t* A; const bf16_t* Bt; int M, N, K; };

struct StaticOrder {
    int nM, nN, nwg, G, c;
    __host__ __device__ void init(int M, int N, int G_, int c_) { nM = M / BM; nN = N / BM; nwg = nM * nN; G = G_; c = c_; }
    __host__ __device__ bool next(int i, Unit& u) const {
        const long L = (long)i * G + c; if (L >= nwg) return false;
        int wgid = (int)L; { const int q = nwg / NXCD, r = nwg % NXCD, xcd = wgid % NXCD, off = wgid / NXCD; wgid = (xcd < r ? xcd * (q + 1) : r * (q + 1) + (xcd - r) * q) + off; }
        const int nig = WGM * nN, gid = wgid / nig, fm = gid * WGM, gsz = (nM - fm) < WGM ? (nM - fm) : WGM;
        u.pm = fm + ((wgid % nig) % gsz); u.pn = (wgid % nig) / gsz; return true;
    }
    __device__ __forceinline__ void a_ready(const Unit&) const {}
    __device__ __forceinline__ void done(const Unit&) const {}
};


__device__ __forceinline__ unsigned cvt_pk_bf16(float lo, float hi) { unsigned r; asm volatile("v_cvt_pk_bf16_f32 %0, %1, %2" : "=v"(r) : "v"(lo), "v"(hi)); return r; }

__device__ __forceinline__ __amdgpu_buffer_rsrc_t wt_rsrc(void* base) { return __builtin_amdgcn_make_buffer_rsrc(base, 0, 0x7fffffff, 0x00020000); }
__device__ __forceinline__ void wt_store16(__amdgpu_buffer_rsrc_t r, size_t byte_off, u32x4 v) { __builtin_amdgcn_raw_buffer_store_b128(v, r, (unsigned)byte_off, 0, 16); }
struct EpiQKV {
    static constexpr bool PERM = true, AFTER_DRAIN = false;
    bf16_t* O; int ldc; float qscale;
    __device__ __forceinline__ void operator()(const f32x4 (&acc)[2][2][4][2], const Unit& u, int wr, int wc, int fr, int fq) const {
        const int bb = u.pm >> 3, s0 = (u.pm & 7) * BM + wr * 64 + fr, slot0 = 4 * u.pn + (wc >> 1), d0 = (wc & 1) * 32 + 8 * fq;
        const float sc = (u.pn < 2 || u.pn == 6 || u.pn == 7) ? qscale : 1.f;
        const __amdgpu_buffer_rsrc_t rs_ = wt_rsrc(O);
#pragma unroll
        for (int bj = 0; bj < 2; ++bj) { const size_t hp = ((((size_t)bb * 48 + slot0 + 2 * bj) * 2048 + s0) * 64 + d0) * 2;
#pragma unroll
            for (int ai = 0; ai < 2; ++ai)
#pragma unroll
                for (int m = 0; m < 4; ++m) { const f32x4 v0 = acc[ai][bj][m][0] * sc, v1 = acc[ai][bj][m][1] * sc;
                    u32x4 w; w.x = cvt_pk_bf16(v0[0], v0[1]); w.y = cvt_pk_bf16(v0[2], v0[3]); w.z = cvt_pk_bf16(v1[0], v1[1]); w.w = cvt_pk_bf16(v1[2], v1[3]);
                    wt_store16(rs_, hp + (size_t)(ai * HALF + m * 16) * 128, w); } }
    }
};
struct EpiZ {
    static constexpr bool PERM = true, AFTER_DRAIN = false;
    bf16_t* Z; const float* mod;
    __device__ __forceinline__ void operator()(const f32x4 (&acc)[2][2][4][2], const Unit& u, int wr, int wc, int fr, int fq) const {
        const int row0 = u.pm * BM + wr * 64 + fr, col0 = u.pn * BM + wc * 32 + 8 * fq;
        const float* g1 = mod + (size_t)(u.pm >> 3) * 6144 + 2048 + col0;
        const __amdgpu_buffer_rsrc_t rs_ = wt_rsrc(Z);
        f32x4 gv[2][2];
#pragma unroll
        for (int bj = 0; bj < 2; ++bj)
#pragma unroll
            for (int n = 0; n < 2; ++n) gv[bj][n] = *(const f32x4*)(g1 + bj * HALF + 4 * n);
#pragma unroll
        for (int ai = 0; ai < 2; ++ai)
#pragma unroll
            for (int m = 0; m < 4; ++m) { const size_t off = (size_t)(row0 + ai * HALF + m * 16) * 1024 + col0;
#pragma unroll
                for (int bj = 0; bj < 2; ++bj) { const f32x4 v0 = acc[ai][bj][m][0] * gv[bj][0], v1 = acc[ai][bj][m][1] * gv[bj][1];
                    u32x4 w; w.x = cvt_pk_bf16(v0[0], v0[1]); w.y = cvt_pk_bf16(v0[2], v0[3]); w.z = cvt_pk_bf16(v1[0], v1[1]); w.w = cvt_pk_bf16(v1[2], v1[3]);
                    wt_store16(rs_, (off + bj * HALF) * 2, w); } }
    }
};
struct EpiSC {
    static constexpr bool PERM = true, AFTER_DRAIN = false;
    _Float16* O; int ldc;
    __device__ __forceinline__ void operator()(const f32x4 (&acc)[2][2][4][2], const Unit& u, int wr, int wc, int fr, int fq) const {
        const int row0 = u.pm * BM + wr * 64 + fr, col0 = u.pn * BM + wc * 32 + 8 * fq;
        const __amdgpu_buffer_rsrc_t rs_ = wt_rsrc(O);
#pragma unroll
        for (int ai = 0; ai < 2; ++ai)
#pragma unroll
            for (int m = 0; m < 4; ++m) { const size_t rowp = ((size_t)(row0 + ai * HALF + m * 16) * ldc + col0) * 2;
#pragma unroll
                for (int bj = 0; bj < 2; ++bj) { const f32x4 v0 = acc[ai][bj][m][0], v1 = acc[ai][bj][m][1];
                    u32x4 w; w.x = pkh(v0[0], v0[1]); w.y = pkh(v0[2], v0[3]); w.z = pkh(v1[0], v1[1]); w.w = pkh(v1[2], v1[3]);
                    wt_store16(rs_, rowp + bj * HALF * 2, w); } }
    }
};

template <class Epi, class Sched, bool ALIGN_EPI = false, bool SP2 = false>
__device__ __forceinline__ void gemm_phase(PG8_LAS unsigned char* lds, const Gemm g, const Sched& S, const Epi& E) {
    const int tid = threadIdx.x, wid = __builtin_amdgcn_readfirstlane(tid >> 6), lane = tid & 63, wr = wid >> 2, wc = wid & 3, fr = lane & 15, fq = lane >> 4;
    const int K = g.K, nt = K / BK;
    unsigned voffA[2], voffB[2];
#pragma unroll
    for (int i = 0; i < 2; ++i) { int R, C; stage_rc(tid * 16 + i * 8192, R, C); const int Rb = Epi::PERM ? ((R & ~31) + perm32(R & 31)) : R;
        voffA[i] = (unsigned)(R * K + C) * 2u; voffB[i] = (unsigned)(Rb * K + C) * 2u; }
    const size_t kstep = (size_t)(BK * 2);
    const size_t hstep = (size_t)HALF * K * 2;
    const size_t tstep = 2 * hstep;
    const unsigned ldsw = (unsigned)wid * 1024u;
    const int aoff = lds_byte(wr * 64 + fr, fq * 8), boff = lds_byte(wc * 32 + fr, fq * 8);
#define PG8_SA(b, h) (((b) * 2 + (h)) * HTB)
#define PG8_SB(b, h) ((4 + (b) * 2 + (h)) * HTB)
#define PG8_STAGE(bufoff, gbase, voff) do { _Pragma("unroll") for (int _i = 0; _i < 2; ++_i) \
        __builtin_amdgcn_global_load_lds((const unsigned*)((const char*)(gbase) + (voff)[_i]), (PG8_LAS unsigned*)(lds + (bufoff) + ldsw + _i * 8192), 16, 0, 0); } while (0)
#define PG8_LDA(dst, b, h) do { _Pragma("unroll") for (int m = 0; m < 4; ++m) _Pragma("unroll") for (int k = 0; k < 2; ++k) dst[m][k] = *(const PG8_LAS bf16x8*)(lds + PG8_SA(b, h) + aoff + m * 2048 + k * 1024); } while (0)
#define PG8_LDB(dst, b, h) do { _Pragma("unroll") for (int n = 0; n < 2; ++n) _Pragma("unroll") for (int k = 0; k < 2; ++k) dst[n][k] = *(const PG8_LAS bf16x8*)(lds + PG8_SB(b, h) + boff + n * 2048 + k * 1024); } while (0)
#define PG8_MMA(ai, bj, At, Bt) do { __builtin_amdgcn_s_setprio(1); _Pragma("unroll") for (int m = 0; m < 4; ++m) _Pragma("unroll") for (int n = 0; n < 2; ++n) _Pragma("unroll") for (int k = 0; k < 2; ++k) \
        acc[ai][bj][m][n] = __builtin_amdgcn_mfma_f32_16x16x32_bf16(Bt[n][k], At[m][k], acc[ai][bj][m][n], 0, 0, 0); __builtin_amdgcn_s_setprio(0); } while (0)
#define PG8_WAIT_V(n) asm volatile("s_waitcnt vmcnt(" #n ")" ::: "memory")
#define PG8_WAIT_L(n) asm volatile("s_waitcnt lgkmcnt(" #n ")" ::: "memory")
#define PG8_BAR __builtin_amdgcn_s_barrier()
#define PG8_SCHED __builtin_amdgcn_sched_barrier(0)
    Unit cur, nxt; int ui = 0;
    if (!S.next(0, cur)) return;
    f32x4 acc[2][2][4][2];
#pragma unroll
    for (int a = 0; a < 2; ++a)
#pragma unroll
        for (int b = 0; b < 2; ++b)
#pragma unroll
            for (int m = 0; m < 4; ++m)
#pragma unroll
                for (int n = 0; n < 2; ++n) acc[a][b][m][n] = (f32x4){0.f, 0.f, 0.f, 0.f};
    bf16x8 At[4][2], B0[2][2], B1[2][2];
    const char* cA = (const char*)g.A + (size_t)cur.pm * tstep; const char* cB = (const char*)g.Bt + (size_t)cur.pn * tstep;
    S.a_ready(cur);
    if constexpr (SP2) {
        PG8_STAGE(PG8_SB(0, 0), cB, voffB); PG8_STAGE(PG8_SB(0, 1), cB + hstep, voffB); PG8_STAGE(PG8_SA(0, 0), cA, voffA); PG8_STAGE(PG8_SA(0, 1), cA + hstep, voffA);
        if (wr == 1) PG8_BAR;
        PG8_WAIT_V(2); PG8_BAR;
        PG8_STAGE(PG8_SB(1, 0), cB + kstep, voffB); PG8_STAGE(PG8_SA(1, 0), cA + kstep, voffA); PG8_STAGE(PG8_SB(1, 1), cB + hstep + kstep, voffB);
        PG8_WAIT_V(6); PG8_BAR;
    } else {
        PG8_STAGE(PG8_SB(0, 0), cB, voffB); PG8_STAGE(PG8_SA(0, 0), cA, voffA); PG8_STAGE(PG8_SB(0, 1), cB + hstep, voffB); PG8_STAGE(PG8_SA(0, 1), cA + hstep, voffA);
        if (wr == 1) PG8_BAR;
        PG8_WAIT_V(4); PG8_BAR;
        PG8_STAGE(PG8_SB(1, 0), cB + kstep, voffB); PG8_STAGE(PG8_SA(1, 0), cA + kstep, voffA); PG8_STAGE(PG8_SB(1, 1), cB + hstep + kstep, voffB);
        PG8_WAIT_V(6); PG8_BAR;
    }
    for (;;) {
        const bool has_next = S.next(ui + 1, nxt);
        const char* nA = has_next ? (const char*)g.A + (size_t)nxt.pm * tstep : cA; const char* nB = has_next ? (const char*)g.Bt + (size_t)nxt.pn * tstep : cB;
        for (int t = 0; t < nt; t += 2) {
            const bool last = (t == nt - 2);
            const char* a1 = cA + (size_t)(t + 1) * kstep;
            const char* a2 = last ? nA : cA + (size_t)(t + 2) * kstep; const char* b2 = last ? nB : cB + (size_t)(t + 2) * kstep;
            const char* a3 = a2 + kstep; const char* b3 = b2 + kstep;
            if (last && has_next) S.a_ready(nxt);
            if constexpr (SP2) {
            PG8_LDB(B0, 0, 0); PG8_LDB(B1, 0, 1); PG8_SCHED; PG8_LDA(At, 0, 0); PG8_STAGE(PG8_SA(1, 1), a1 + hstep, voffA);
            PG8_WAIT_V(8); PG8_WAIT_L(0); PG8_BAR; PG8_MMA(0, 0, At, B0); PG8_MMA(0, 1, At, B1); PG8_BAR; PG8_SCHED;
            PG8_LDA(At, 0, 1); PG8_STAGE(PG8_SB(0, 0), b2, voffB); PG8_STAGE(PG8_SB(0, 1), b2 + hstep, voffB); PG8_STAGE(PG8_SA(0, 0), a2, voffA);
            PG8_WAIT_V(8); PG8_WAIT_L(0); PG8_BAR; PG8_MMA(1, 0, At, B0); PG8_MMA(1, 1, At, B1); PG8_BAR; PG8_SCHED;
            PG8_LDB(B0, 1, 0); PG8_LDB(B1, 1, 1); PG8_SCHED; PG8_LDA(At, 1, 0); PG8_STAGE(PG8_SA(0, 1), a2 + hstep, voffA);
            PG8_WAIT_V(8); PG8_WAIT_L(0); PG8_BAR; PG8_MMA(0, 0, At, B0); PG8_MMA(0, 1, At, B1); PG8_BAR; PG8_SCHED;
            PG8_LDA(At, 1, 1); PG8_STAGE(PG8_SB(1, 0), b3, voffB); PG8_STAGE(PG8_SB(1, 1), b3 + hstep, voffB); PG8_STAGE(PG8_SA(1, 0), a3, voffA);
            PG8_WAIT_V(8); PG8_WAIT_L(0); PG8_BAR; PG8_MMA(1, 0, At, B0); PG8_MMA(1, 1, At, B1); PG8_BAR; PG8_SCHED;
            } else {
            PG8_LDB(B0, 0, 0); PG8_SCHED; PG8_LDA(At, 0, 0); PG8_STAGE(PG8_SA(1, 1), a1 + hstep, voffA);
            PG8_WAIT_L(8); PG8_BAR; PG8_WAIT_L(0); PG8_MMA(0, 0, At, B0); PG8_BAR; PG8_SCHED;
            PG8_LDB(B1, 0, 1); PG8_STAGE(PG8_SB(0, 0), b2, voffB);
            PG8_BAR; PG8_WAIT_L(0); PG8_MMA(0, 1, At, B1); PG8_BAR;
            PG8_LDA(At, 0, 1); PG8_STAGE(PG8_SA(0, 0), a2, voffA);
            PG8_BAR; PG8_WAIT_L(0); PG8_MMA(1, 0, At, B0); PG8_BAR; PG8_SCHED;
            PG8_STAGE(PG8_SB(0, 1), b2 + hstep, voffB);
            PG8_WAIT_V(6); PG8_BAR; PG8_MMA(1, 1, At, B1); PG8_BAR;
            PG8_LDB(B0, 1, 0); PG8_SCHED; PG8_LDA(At, 1, 0); PG8_STAGE(PG8_SA(0, 1), a2 + hstep, voffA);
            PG8_WAIT_L(8); PG8_BAR; PG8_WAIT_L(0); PG8_MMA(0, 0, At, B0); PG8_BAR; PG8_SCHED;
            PG8_LDB(B1, 1, 1); PG8_STAGE(PG8_SB(1, 0), b3, voffB);
            PG8_BAR; PG8_WAIT_L(0); PG8_MMA(0, 1, At, B1); PG8_BAR;
            PG8_LDA(At, 1, 1); PG8_STAGE(PG8_SA(1, 0), a3, voffA);
            PG8_BAR; PG8_WAIT_L(0); PG8_MMA(1, 0, At, B0); PG8_BAR; PG8_SCHED;
            PG8_STAGE(PG8_SB(1, 1), b3 + hstep, voffB);
            PG8_WAIT_V(6); PG8_BAR; PG8_MMA(1, 1, At, B1); PG8_BAR;
            }
        }
        if constexpr (ALIGN_EPI) { if (wr == 0) PG8_BAR; }
        if constexpr (!Epi::AFTER_DRAIN) { E(acc, cur, wr, wc, fr, fq); S.done(cur); }
        if (!has_next) break;
#pragma unroll
        for (int a = 0; a < 2; ++a)
#pragma unroll
            for (int b = 0; b < 2; ++b)
#pragma unroll
                for (int m = 0; m < 4; ++m)
#pragma unroll
                    for (int n = 0; n < 2; ++n) acc[a][b][m][n] = (f32x4){0.f, 0.f, 0.f, 0.f};
        cur = nxt; cA = nA; cB = nB; ++ui;
        if constexpr (ALIGN_EPI) { if (wr == 1) PG8_BAR; }
    }
    PG8_WAIT_V(0);
    if constexpr (!ALIGN_EPI) { if (wr == 0) PG8_BAR; }
    PG8_BAR;
    if constexpr (Epi::AFTER_DRAIN) { E.fused(acc, cur, wr, wc, fr, fq, lds, wid, lane); S.done(cur); }
#undef PG8_SA
#undef PG8_SB
#undef PG8_STAGE
#undef PG8_LDA
#undef PG8_LDB
#undef PG8_MMA
#undef PG8_WAIT_V
#undef PG8_WAIT_L
#undef PG8_BAR
#undef PG8_SCHED
}
}

struct Params {
    const float *x, *c, *ada_w, *ada_b, *norm1_g, *w_in, *na_rpb, *ong_na, *ong_dil, *w_out, *norm2_g, *peer_wq, *peer_sk, *peer_u, *peer_v, *final_g;
    float* out; unsigned char* ws; int ph_lo, ph_hi;
};
constexpr int NPHASE = 13;

__device__ __forceinline__ void p0_mod(const Params& p, LAS unsigned char* lds, int tid, int lane, int wave) {
    LAS float* s = (LAS float*)lds;
    LAS float* red = (LAS float*)(lds + 65536);
    for (int idx = tid; idx < 16 * 1024; idx += 512) { const int b = idx >> 10, k = idx & 1023; const float cv = p.c[idx]; s[k * 16 + b] = cv / (1.f + __expf(-cv)); }
    __syncthreads();
    float* mod = (float*)(p.ws + WS_MOD);
    for (int it = blockIdx.x; it < 256; it += gridDim.x) {
        const int j0 = it * 24, c = lane & 31, kq = lane >> 5; const bool act = c < 24;
        float acc[16];
#pragma unroll
        for (int b = 0; b < 16; ++b) acc[b] = 0.f;
        const float* wp = p.ada_w + (size_t)(wave * 128 + kq) * 6144 + j0 + (act ? c : 0);
#pragma unroll 4
        for (int i = 0; i < 64; ++i) {
            const int k = wave * 128 + 2 * i + kq;
            const float wv = act ? __builtin_nontemporal_load(wp + (size_t)i * 2 * 6144) : 0.f;
            const LAS f32x4* sp = (const LAS f32x4*)(s + k * 16);
            const f32x4 s0 = sp[0], s1 = sp[1], s2 = sp[2], s3 = sp[3];
#pragma unroll
            for (int e = 0; e < 4; ++e) { acc[e] += s0[e] * wv; acc[4 + e] += s1[e] * wv; acc[8 + e] += s2[e] * wv; acc[12 + e] += s3[e] * wv; }
        }
#pragma unroll
        for (int b = 0; b < 16; ++b) red[((wave * 2 + kq) * 16 + b) * 32 + c] = acc[b];
        __syncthreads();
        if (tid < 384) { const int b = tid / 24, cc = tid - b * 24; float sum = p.ada_b[j0 + cc];
#pragma unroll
            for (int pp = 0; pp < 16; ++pp) sum += red[(pp * 16 + b) * 32 + cc];
            mod[(size_t)b * 6144 + j0 + cc] = sum; }
        __syncthreads();
    }
}
__device__ __forceinline__ void p0_wsc(const Params& p, LAS unsigned char* lds, int tid) {
    LAS float* wq_s = (LAS float*)lds;
    LAS float* sk_s = (LAS float*)(lds + 32768);
    bf16_t* WscT = (bf16_t*)(p.ws + WS_WSC);
    for (int it = blockIdx.x; it < 256; it += gridDim.x) {
        const int hp = it >> 4, kc = it & 15, pp = hp & 1, k0 = kc * 64;
        for (int i = tid; i < 2048; i += 512) { const int r = i >> 5, c4 = i & 31; *(LAS f32x4*)(wq_s + r * 128 + c4 * 4) = *(const f32x4*)(p.peer_wq + (size_t)(k0 + r) * 2048 + hp * 128 + c4 * 4); }
        for (int i = tid; i < 4096; i += 512) { const int r = i >> 5, c4 = i & 31; *(LAS f32x4*)(sk_s + r * 132 + c4 * 4) = *(const f32x4*)(p.peer_sk + (size_t)pp * 16384 + r * 128 + c4 * 4); }
        __syncthreads();
        const int n = tid & 127, kg = tid >> 7;
        float acc[16];
#pragma unroll
        for (int i = 0; i < 16; ++i) acc[i] = 0.f;
        for (int d = 0; d < 128; d += 4) {
            const f32x4 sv = *(const LAS f32x4*)(sk_s + n * 132 + d);
#pragma unroll
            for (int i = 0; i < 16; ++i) { const f32x4 wv = *(const LAS f32x4*)(wq_s + (kg * 16 + i) * 128 + d); acc[i] += (wv[0] * sv[0] + wv[1] * sv[1]) + (wv[2] * sv[2] + wv[3] * sv[3]); }
        }
        bf16_t* op = WscT + (size_t)(hp * 128 + n) * 1024 + k0 + kg * 16;
        u32x4 w0, w1;
        w0.x = pkbf(acc[0], acc[1]); w0.y = pkbf(acc[2], acc[3]); w0.z = pkbf(acc[4], acc[5]); w0.w = pkbf(acc[6], acc[7]);
        w1.x = pkbf(acc[8], acc[9]); w1.y = pkbf(acc[10], acc[11]); w1.z = pkbf(acc[12], acc[13]); w1.w = pkbf(acc[14], acc[15]);
        *(u32x4*)op = w0; *(u32x4*)(op + 8) = w1;
        __syncthreads();
    }
}
__device__ __forceinline__ void p0_transpose_item(const float* W, int K, int N, bf16_t* WT, const float* ks0, const float* ks1, LAS float* scr, int item, int lane) {
    const int nblk = N / 32, kb = item / nblk, nb = item % nblk, k0 = 64 * kb, n0 = 32 * nb;
#pragma unroll 8
    for (int i = 0; i < 32; ++i) { const int kk = 2 * i + (lane >> 5), kabs = k0 + kk;
        const float sc = ks0 ? (kabs < 512 ? ks0[kabs] : ks1[kabs - 512]) : 1.f;
        scr[kk * 33 + (lane & 31)] = W[(size_t)kabs * N + n0 + (lane & 31)] * sc; }
    asm volatile("s_waitcnt lgkmcnt(0)" ::: "memory");
    const int c = lane & 7;
#pragma unroll
    for (int j = 0; j < 4; ++j) { const int n = (lane >> 3) + 8 * j; const LAS float* s = scr + (8 * c) * 33 + n;
        u32x4 o; o.x = pkbf(s[0 * 33], s[1 * 33]); o.y = pkbf(s[2 * 33], s[3 * 33]); o.z = pkbf(s[4 * 33], s[5 * 33]); o.w = pkbf(s[6 * 33], s[7 * 33]);
        *(u32x4*)(WT + (size_t)(n0 + n) * K + k0 + 8 * c) = o; }
    asm volatile("s_waitcnt lgkmcnt(0)" ::: "memory");
}
__device__ __forceinline__ void p0_weights(const Params& p, LAS unsigned char* lds, int tid, int lane, int wave) {
    p0_wsc(p, lds, tid);
    const int G = gridDim.x, gw = blockIdx.x * 8 + wave, NGW = G * 8;
    LAS float* scr = (LAS float*)(lds + wave * 16384);
    constexpr int I_IN = (DM / 64) * (NQKV / 32), I_OUT = (DM / 64) * (DM / 32);
    for (int it = gw; it < I_IN + I_OUT; it += NGW) {
        if (it < I_IN) p0_transpose_item(p.w_in, DM, NQKV, (bf16_t*)(p.ws + WS_WIN), nullptr, nullptr, scr, it, lane);
        else p0_transpose_item(p.w_out, DM, DM, (bf16_t*)(p.ws + WS_WOUT), p.ong_na, p.ong_dil, scr, it - I_IN, lane);
    }
}

template <bool Q8>
__device__ __forceinline__ void norm_rows(const float* src, const bf16_t* zadd, const float* gain, const float* mod, int sh_off, int sc_off, bf16_t* dst, unsigned char* dst8, float* scale8, int gw, int NGW, int lane) {
    for (int it = gw; it < TOK / 16; it += NGW) {
        const int t0 = it * 16, b = t0 >> 11; const float* mb = mod + (size_t)b * 6144;
        f32x4 Gv[4], Sv[4];
#pragma unroll
        for (int j = 0; j < 4; ++j) { const int k = 4 * lane + 256 * j; const f32x4 g = *(const f32x4*)(gain + k), sc = *(const f32x4*)(mb + sc_off + k); Gv[j] = g * (1.f + sc); Sv[j] = *(const f32x4*)(mb + sh_off + k); }
        f32x4 n1[4], n2[4], n3[4];
#pragma unroll
        for (int j = 0; j < 4; ++j) { n1[j] = __builtin_nontemporal_load((const f32x4*)(src + (size_t)t0 * DM) + lane + 64 * j); n2[j] = __builtin_nontemporal_load((const f32x4*)(src + (size_t)(t0 + 1) * DM) + lane + 64 * j); n3[j] = __builtin_nontemporal_load((const f32x4*)(src + (size_t)(t0 + 2) * DM) + lane + 64 * j); }
        u32x2 z1[4], z2[4], z3[4];
        if (Q8) {
#pragma unroll
            for (int j = 0; j < 4; ++j) { z1[j] = __builtin_nontemporal_load((const u32x2*)(zadd + (size_t)t0 * DM) + lane + 64 * j); z2[j] = __builtin_nontemporal_load((const u32x2*)(zadd + (size_t)(t0 + 1) * DM) + lane + 64 * j); z3[j] = __builtin_nontemporal_load((const u32x2*)(zadd + (size_t)(t0 + 2) * DM) + lane + 64 * j); }
        }
#pragma unroll 4
        for (int r = 0; r < 16; ++r) {
            f32x4 v[4]; float ss = 0.f;
            const f32x4* xn = (const f32x4*)(src + (size_t)(t0 + (r + 3 < 16 ? r + 3 : 15)) * DM) + lane;
#pragma unroll
            for (int j = 0; j < 4; ++j) { v[j] = n1[j]; n1[j] = n2[j]; n2[j] = n3[j]; n3[j] = __builtin_nontemporal_load(xn + 64 * j);
                if (Q8) { const u32x2 zz = z1[j]; v[j] = v[j] + (f32x4){bf_lo(zz.x), bf_hi(zz.x), bf_lo(zz.y), bf_hi(zz.y)}; z1[j] = z2[j]; z2[j] = z3[j]; z3[j] = __builtin_nontemporal_load((const u32x2*)(zadd + (size_t)(t0 + (r + 3 < 16 ? r + 3 : 15)) * DM) + lane + 64 * j); }
                ss += (v[j][0] * v[j][0] + v[j][1] * v[j][1]) + (v[j][2] * v[j][2] + v[j][3] * v[j][3]); }
            const float rs = rsqrtf(wave_sum(ss) * (1.f / DM) + EPS);
            u32x2* o8 = (u32x2*)(dst + (size_t)(t0 + r) * DM) + lane;
            float am = 0.f;
#pragma unroll
            for (int j = 0; j < 4; ++j) { const f32x4 h = v[j] * rs * Gv[j] + Sv[j]; v[j] = h; u32x2 w; w.x = pkbf(h[0], h[1]); w.y = pkbf(h[2], h[3]); o8[64 * j] = w;
                if (Q8) am = fmaxf(fmaxf(am, fmaxf(fabsf(h[0]), fabsf(h[1]))), fmaxf(fabsf(h[2]), fabsf(h[3]))); }
            if (Q8) {
#pragma unroll
                for (int o = 1; o < 64; o <<= 1) am = fmaxf(am, __shfl_xor(am, o));
                const float inv = am > 0.f ? 127.f / am : 0.f;
                unsigned* q8 = (unsigned*)(dst8 + (size_t)(t0 + r) * DM) + lane;
#pragma unroll
                for (int j = 0; j < 4; ++j) { const int q0 = (int)rintf(v[j][0] * inv), q1 = (int)rintf(v[j][1] * inv), q2 = (int)rintf(v[j][2] * inv), q3 = (int)rintf(v[j][3] * inv);
                    q8[64 * j] = ((unsigned)q0 & 255u) | (((unsigned)q1 & 255u) << 8) | (((unsigned)q2 & 255u) << 16) | ((unsigned)q3 << 24); }
                if (lane == 0) scale8[t0 + r] = am * (1.f / 127.f);
            }
        }
    }
}

struct TabRow { f32x4 v[4]; };
__device__ __forceinline__ void tab_row_load(const Params& p, int row, int lane, TabRow& r) {
    const bool second = row >= NEXP; const int e = second ? row - NEXP : row;
    const f32x4* src = (const f32x4*)((second ? p.peer_v : p.peer_u) + (size_t)e * 1024) + lane;
#pragma unroll
    for (int j = 0; j < 4; ++j) r.v[j] = __builtin_nontemporal_load(src + 64 * j);
}
__device__ __forceinline__ void tab_row_finish(const Params& p, int row, int lane, const TabRow& r) {
    asm volatile("" : "+v"(lane));
    const bool second = row >= NEXP; const int e = second ? row - NEXP : row;
    float am = 0.f;
#pragma unroll
    for (int j = 0; j < 4; ++j) am = fmaxf(fmaxf(am, fmaxf(fabsf(r.v[j][0]), fabsf(r.v[j][1]))), fmaxf(fabsf(r.v[j][2]), fabsf(r.v[j][3])));
#pragma unroll
    for (int o = 1; o < 64; o <<= 1) am = fmaxf(am, __shfl_xor(am, o));
    const float inv = am > 0.f ? 127.f / am : 0.f;
    unsigned char* tb_ = p.ws + (second ? WS_VH : WS_UH) + (size_t)e * 128 + 4 * (lane & 31);
#pragma unroll
    for (int j = 0; j < 4; ++j) { const int q0 = (int)rintf(r.v[j][0] * inv), q1 = (int)rintf(r.v[j][1] * inv), q2 = (int)rintf(r.v[j][2] * inv), q3 = (int)rintf(r.v[j][3] * inv);
        *(unsigned*)(tb_ + (size_t)(2 * j + (lane >> 5)) * NEXP * 128) = ((unsigned)q0 & 255u) | (((unsigned)q1 & 255u) << 8) | (((unsigned)q2 & 255u) << 16) | ((unsigned)q3 << 24); }
    if (lane == 0) ((float*)(p.ws + WS_SU))[row] = am * (1.f / 127.f);
}


constexpr int VROW = 160;
constexpr int RPB_OFF = 98304;
constexpr int NUNIT_NA = 2048, NUNIT_DIL = 6144;


template <int NCH> __device__ __forceinline__ void softmax_pack(f32x4 (&S)[NCH][2], bf16x8 (&pa)[NCH], float& mx_out, float& l_out) {
    float mx = -1e30f, mx2 = -1e30f;
#pragma unroll
    for (int ch = 0; ch < NCH; ++ch)
#pragma unroll
        for (int xy = 0; xy < 2; ++xy) { mx = fmaxf(mx, fmaxf(S[ch][xy][0], S[ch][xy][1])); mx2 = fmaxf(mx2, fmaxf(S[ch][xy][2], S[ch][xy][3])); }
    mx = fmaxf(mx, mx2);
    mx = fmaxf(mx, __shfl_xor(mx, 16)); mx = fmaxf(mx, __shfl_xor(mx, 32));
    float l = 0.f;
#pragma unroll
    for (int ch = 0; ch < NCH; ++ch) {
#pragma unroll
        for (int xy = 0; xy < 2; ++xy)
#pragma unroll
            for (int r = 0; r < 4; ++r) { const float e = __builtin_amdgcn_exp2f(S[ch][xy][r] - mx); S[ch][xy][r] = e; l += e; }
        u32x4 w; w.x = pkbf(S[ch][0][0], S[ch][0][1]); w.y = pkbf(S[ch][0][2], S[ch][0][3]); w.z = pkbf(S[ch][1][0], S[ch][1][1]); w.w = pkbf(S[ch][1][2], S[ch][1][3]);
        pa[ch] = __builtin_bit_cast(bf16x8, w);
    }
    l += __shfl_xor(l, 16); l += __shfl_xor(l, 32);
    mx_out = mx; l_out = l;
}
template <int NCH, int CSB> __device__ __forceinline__ void pv_accum(const LAS unsigned char* vb, const bf16x8 (&pa)[NCH], f32x4 (&o)[4]) {
#pragma unroll
    for (int ch = 0; ch < NCH; ++ch)
#pragma unroll
        for (int nt = 0; nt < 4; ++nt) {
            const v4i16_t t0 = __builtin_amdgcn_ds_read_tr16_b64_v4i16((LAS v4i16_t*)(vb + ch * CSB + nt * 32));
            const v4i16_t t1 = __builtin_amdgcn_ds_read_tr16_b64_v4i16((LAS v4i16_t*)(vb + ch * CSB + 16 * VROW + nt * 32));
            const bf16x8 vf = {t0[0], t0[1], t0[2], t0[3], t1[0], t1[1], t1[2], t1[3]};
            o[nt] = __builtin_amdgcn_mfma_f32_16x16x32_bf16(vf, pa[ch], o[nt], 0, 0, 0);
        }
}

__device__ __forceinline__ void o_store16(__amdgpu_buffer_rsrc_t rs, size_t elem_off  , const f32x4 (&o)[4], float inv, int g) {
    const bool odd = (g & 1) != 0;
#pragma unroll
    for (int pr = 0; pr < 2; ++pr) {
        const unsigned x0 = pkbf(o[2 * pr][0] * inv, o[2 * pr][1] * inv), x1 = pkbf(o[2 * pr][2] * inv, o[2 * pr][3] * inv);
        const unsigned y0 = pkbf(o[2 * pr + 1][0] * inv, o[2 * pr + 1][1] * inv), y1 = pkbf(o[2 * pr + 1][2] * inv, o[2 * pr + 1][3] * inv);
        auto r0 = __builtin_amdgcn_permlane16_swap(x0, y0, false, false), r1 = __builtin_amdgcn_permlane16_swap(x1, y1, false, false);
        const u32x4 w = {r0[0], r1[0], r0[1], r1[1]};
        const int d0 = 16 * (2 * pr + (odd ? 1 : 0)) + 4 * (g & ~1);
        pg8::wt_store16(rs, (elem_off + d0) * 2, w);
    }
}

__device__ __forceinline__ void lds_barrier() { asm volatile("s_waitcnt lgkmcnt(0)\n\ts_barrier" ::: "memory"); }
struct NaGeo { int b, h, rp, rr, cg, r0, cw; };
__device__ __forceinline__ NaGeo na_geo(int u, int wave) {
    NaGeo z; z.b = u >> 7; z.h = (u >> 4) & 7; z.rp = u & 15; z.rr = 2 * z.rp + (wave >> 2); z.cg = wave & 3;
    z.r0 = min(max(z.rr - 4, 0), 24); z.cw = min(max(16 * z.cg - 8, 0), 32); return z;
}
__device__ __forceinline__ void na_qload(const bf16_t* QKV, const NaGeo& z, int lane, bf16x8& qf0, bf16x8& qf1) {
    const bf16_t* qp = QKV + (((size_t)z.b * 48 + z.h) * SEQ + z.rr * 64 + 16 * z.cg + (lane & 15)) * 64 + 8 * (lane >> 4);
    qf0 = *(const bf16x8*)qp; qf1 = *(const bf16x8*)(qp + 32);
}
__device__ __forceinline__ void na_kload(const bf16_t* QKV, const NaGeo& z, int hf, int lane, bf16x8 (&kf)[4][2][2]) {
#pragma unroll
    for (int c4 = 0; c4 < 4; ++c4)
#pragma unroll
        for (int xy = 0; xy < 2; ++xy) {
            const bf16_t* kp = QKV + (((size_t)z.b * 48 + 8 + z.h) * SEQ + (z.r0 + 4 * hf + c4) * 64 + z.cw + 16 * xy + (lane & 15)) * 64 + 8 * (lane >> 4);
            kf[c4][xy][0] = *(const bf16x8*)kp; kf[c4][xy][1] = *(const bf16x8*)(kp + 32);
        }
}
__device__ __forceinline__ void s_mfma4(const bf16x8 (&kf)[4][2][2], const bf16x8 qf0, const bf16x8 qf1, f32x4 (&S)[8][2], int base) {
#pragma unroll
    for (int c4 = 0; c4 < 4; ++c4)
#pragma unroll
        for (int xy = 0; xy < 2; ++xy) S[base + c4][xy] = __builtin_amdgcn_mfma_f32_16x16x32_bf16(kf[c4][xy][0], qf0, (f32x4){0.f, 0.f, 0.f, 0.f}, 0, 0, 0);
#pragma unroll
    for (int c4 = 0; c4 < 4; ++c4)
#pragma unroll
        for (int xy = 0; xy < 2; ++xy) S[base + c4][xy] = __builtin_amdgcn_mfma_f32_16x16x32_bf16(kf[c4][xy][1], qf1, S[base + c4][xy], 0, 0, 0);
}
__device__ __forceinline__ void na_unit(const Params& p, LAS unsigned char* lds, int u, int un, int tid, int lane, int wave, bf16x8 (&kfA)[4][2][2], bf16x8 (&kfB)[4][2][2], bf16x8& qf0, bf16x8& qf1) {
    const bf16_t* QKV = (const bf16_t*)(p.ws + WS_QKV);
    const LAS float* rpb = (const LAS float*)(lds + RPB_OFF) + 64;
    const NaGeo z = na_geo(u, wave);
    const int b = z.b, h = z.h, rp = z.rp, rr = z.rr, cg = z.cg, r0 = z.r0, cw = z.cw;
    const int q = lane & 15, g = lane >> 4, c = 16 * cg + q, c0 = min(max(c - 8, 0), 48);
    const int vbase = min(max(2 * rp - 4, 0), 24);
    const size_t tb = (size_t)b * SEQ;
    f32x4 S[8][2];
    s_mfma4(kfA, qf0, qf1, S, 0);
    s_mfma4(kfB, qf0, qf1, S, 4);
    __builtin_amdgcn_sched_barrier(0);
    u32x4 vreg[9];
    const int vr = tid >> 3, vpiece = tid & 7;
#pragma unroll
    for (int ps = 0; ps < 9; ++ps) { const int kr = min(vbase + ps, 31);
        vreg[ps] = *(const u32x4*)(QKV + (((size_t)b * 48 + 16 + h) * SEQ + kr * 64 + vr) * 64 + vpiece * 8); }
    const int thr = c0 - cw;
    const int bbase = h * 465 + (r0 - rr + 7) * 31 + (cw + 4 * g - c + 15);
    bool ux[4]; int bi[4];
#pragma unroll
    for (int r = 0; r < 4; ++r) { ux[r] = (4 * g + r) >= thr; bi[r] = bbase + r + (ux[r] ? 0 : 16); }
    f32x4 Sm[8];
#pragma unroll
    for (int ch = 0; ch < 8; ++ch)
#pragma unroll
        for (int r = 0; r < 4; ++r) Sm[ch][r] = (ux[r] ? S[ch][0][r] : S[ch][1][r]) + rpb[bi[r] + ch * 31];
    bf16x8 pa[8]; float mx, l;
    {
        float m0 = -1e30f, m1 = -1e30f;
#pragma unroll
        for (int ch = 0; ch < 8; ++ch) { m0 = fmaxf(m0, fmaxf(Sm[ch][0], Sm[ch][1])); m1 = fmaxf(m1, fmaxf(Sm[ch][2], Sm[ch][3])); }
        mx = fmaxf(m0, m1);
        mx = fmaxf(mx, __shfl_xor(mx, 16)); mx = fmaxf(mx, __shfl_xor(mx, 32));
        l = 0.f;
#pragma unroll
        for (int ch = 0; ch < 8; ++ch) {
            float ex[4], ey[4];
#pragma unroll
            for (int r = 0; r < 4; ++r) { const float e = __builtin_amdgcn_exp2f(Sm[ch][r] - mx); l += e; ex[r] = ux[r] ? e : 0.f; ey[r] = ux[r] ? 0.f : e; }
            u32x4 w; w.x = pkbf(ex[0], ex[1]); w.y = pkbf(ex[2], ex[3]); w.z = pkbf(ey[0], ey[1]); w.w = pkbf(ey[2], ey[3]);
            pa[ch] = __builtin_bit_cast(bf16x8, w);
        }
        l += __shfl_xor(l, 16); l += __shfl_xor(l, 32);
    }
    __builtin_amdgcn_sched_barrier(0);
    { const NaGeo zn = na_geo(un, wave); na_qload(QKV, zn, lane, qf0, qf1); na_kload(QKV, zn, 0, lane, kfA); na_kload(QKV, zn, 1, lane, kfB); }
    __builtin_amdgcn_sched_barrier(0);
    lds_barrier();
#pragma unroll
    for (int ps = 0; ps < 9; ++ps) *(LAS u32x4*)(lds + (ps * 64 + vr) * VROW + vpiece * 16) = vreg[ps];
    lds_barrier();
    f32x4 o[4];
#pragma unroll
    for (int nt = 0; nt < 4; ++nt) o[nt] = (f32x4){0.f, 0.f, 0.f, 0.f};
    const int i16 = lane & 15, qq = i16 >> 2, pp = i16 & 3;
    const LAS unsigned char* vb = lds + ((r0 - vbase) * 64 + cw + 4 * g + qq) * VROW + pp * 8;
    pv_accum<8, 64 * VROW>(vb, pa, o);
    const float inv = 1.f / l;
    o_store16(pg8::wt_rsrc(p.ws + WS_ONA), (tb + rr * 64 + c) * 512 + h * 64, o, inv, g);
}

struct DilGeo { int b, h, cfg, Dl, L, rho, m0; };
__device__ __forceinline__ DilGeo dil_geo(int v) {
    DilGeo z; z.b = v / 384; int rem = v - z.b * 384; z.h = rem / 48; rem -= z.h * 48; z.cfg = rem >> 4; const int sub = rem & 15;
    z.Dl = z.cfg * 2; z.L = SEQ >> z.Dl; const int nbl = 4 - z.Dl; z.rho = sub >> nbl; z.m0 = (sub & ((1 << nbl) - 1)) * 128; return z;
}
constexpr int DIL_KOFF = 0, DIL_VOFF = 272 * VROW;
struct DilRegs { u32x4 k[4], v[4]; bf16x8 qf0, qf1; };
__device__ __forceinline__ void dil_prefetch(const bf16_t* QKV, const DilGeo& z, int tid, int lane, int wave, DilRegs& R) {
    const int vr = tid >> 3, vpiece = tid & 7;
#pragma unroll
    for (int ps = 0; ps < 4; ++ps) { const int j = ps * 64 + vr; const int mm = min(max(z.m0 - 64 + j, 0), z.L - 1);
        const size_t tok = ((size_t)mm << z.Dl) + z.rho;
        R.k[ps] = *(const u32x4*)(QKV + (((size_t)z.b * 48 + 32 + z.h) * SEQ + tok) * 64 + vpiece * 8);
        R.v[ps] = *(const u32x4*)(QKV + (((size_t)z.b * 48 + 40 + z.h) * SEQ + tok) * 64 + vpiece * 8); }
    const int mq = z.m0 + 16 * wave + (lane & 15);
    const bf16_t* qp = QKV + (((size_t)z.b * 48 + 24 + z.h) * SEQ + ((size_t)mq << z.Dl) + z.rho) * 64 + 8 * (lane >> 4);
    R.qf0 = *(const bf16x8*)qp; R.qf1 = *(const bf16x8*)(qp + 32);
}
__device__ __forceinline__ void dil_unit(const Params& p, LAS unsigned char* lds, int v, int vn, int tid, int lane, int wave, DilRegs& R) {
    const bf16_t* QKV = (const bf16_t*)(p.ws + WS_QKV);
    const DilGeo z = dil_geo(v);
    const int h = z.h, cfg = z.cfg, Dl = z.Dl, L = z.L, rho = z.rho, m0 = z.m0;
    const int q = lane & 15, g = lane >> 4;
    const size_t tb = (size_t)z.b * SEQ;
    const int mq = m0 + 16 * wave + q;
    const int vr = tid >> 3, vpiece = tid & 7;
    lds_barrier();
#pragma unroll
    for (int ps = 0; ps < 4; ++ps) { const int j = ps * 64 + vr;
        *(LAS u32x4*)(lds + DIL_KOFF + j * VROW + vpiece * 16) = R.k[ps]; *(LAS u32x4*)(lds + DIL_VOFF + j * VROW + vpiece * 16) = R.v[ps]; }
    const bf16x8 qf0 = R.qf0, qf1 = R.qf1;
    lds_barrier();
    { const DilGeo zn = dil_geo(vn); dil_prefetch(QKV, zn, tid, lane, wave, R); }
    TabRow trw; const bool tconv = v < 2 * NEXP / 8;
    tab_row_load(p, tconv ? 8 * v + wave : 0, lane, trw);
    __builtin_amdgcn_sched_barrier(0);
    f32x4 S[5][2];
    {
        const LAS unsigned char* kb = lds + DIL_KOFF + (16 * wave + q) * VROW + 16 * g;
#pragma unroll
        for (int ch = 0; ch < 5; ++ch)
#pragma unroll
            for (int xy = 0; xy < 2; ++xy) S[ch][xy] = __builtin_amdgcn_mfma_f32_16x16x32_bf16(*(const LAS bf16x8*)(kb + (32 * ch + 16 * xy) * VROW), qf0, (f32x4){0.f, 0.f, 0.f, 0.f}, 0, 0, 0);
#pragma unroll
        for (int ch = 0; ch < 5; ++ch)
#pragma unroll
            for (int xy = 0; xy < 2; ++xy) S[ch][xy] = __builtin_amdgcn_mfma_f32_16x16x32_bf16(*(const LAS bf16x8*)(kb + (32 * ch + 16 * xy) * VROW + 64), qf1, S[ch][xy], 0, 0, 0);
    }
    const float slope2 = __builtin_amdgcn_exp2f(-(float)(h + 1)) * (float)(1 << Dl) * LOG2E;
#pragma unroll
    for (int ch = 0; ch < 5; ++ch)
#pragma unroll
        for (int xy = 0; xy < 2; ++xy)
#pragma unroll
            for (int r = 0; r < 4; ++r) { const int delta = 32 * ch + 16 * xy + 4 * g + r - 64 - q, ad = delta < 0 ? -delta : delta, mm = mq + delta;
                const bool valid = (ad <= 64) && (mm >= 0) && (mm < L);
                S[ch][xy][r] = valid ? S[ch][xy][r] - slope2 * (float)ad : -1e30f; }
    bf16x8 pa[5]; float mx, l;
    softmax_pack<5>(S, pa, mx, l);
    f32x4 o[4];
#pragma unroll
    for (int nt = 0; nt < 4; ++nt) o[nt] = (f32x4){0.f, 0.f, 0.f, 0.f};
    const int i16 = lane & 15, qq = i16 >> 2, pp = i16 & 3;
    const LAS unsigned char* vb = lds + DIL_VOFF + (16 * wave + 4 * g + qq) * VROW + pp * 8;
    pv_accum<5, 32 * VROW>(vb, pa, o);
    const float inv = 1.f / l;
    int g7 = g; asm volatile("" : "+v"(g7));
    const size_t tq = tb + ((size_t)(m0 + 16 * wave + (lane & 15)) << Dl) + rho;
    o_store16(pg8::wt_rsrc(p.ws + WS_OD), (size_t)cfg * TOK * 512 + tq * 512 + h * 64, o, inv, g7);
    if (g7 == 0) ((float*)(p.ws + WS_LSE))[((size_t)cfg * TOK + tq) * 8 + h] = mx + __builtin_amdgcn_logf(l);
    if (tconv) tab_row_finish(p, 8 * v + wave, lane, trw);
}

__device__ __forceinline__ void attn_phase(const Params& p, LAS unsigned char* lds, int tid, int lane, int wave, int vcu, int G) {
    const bf16_t* QKV = (const bf16_t*)(p.ws + WS_QKV);
    LAS float* rp = (LAS float*)(lds + RPB_OFF);
    for (int i = tid; i < 64 + 8 * 465 + 64; i += 512) { const int k = i - 64; rp[i] = (k >= 0 && k < 8 * 465) ? p.na_rpb[k] * LOG2E : 0.f; }
    __syncthreads();
    {
        bf16x8 kfA[4][2][2], kfB[4][2][2], qf0, qf1;
        int u = vcu;
        if (u < NUNIT_NA) { const NaGeo z = na_geo(u, wave); na_qload(QKV, z, lane, qf0, qf1); na_kload(QKV, z, 0, lane, kfA); na_kload(QKV, z, 1, lane, kfB); }
        for (; u < NUNIT_NA; u += G) na_unit(p, lds, u, (u + G < NUNIT_NA) ? u + G : u, tid, lane, wave, kfA, kfB, qf0, qf1);
    }
    {
        DilRegs R0, R1;
        int v = vcu;
        lds_barrier();
        if (tid < 16 * 8) { const int j = 256 + (tid >> 3); *(LAS u32x4*)(lds + DIL_KOFF + j * VROW + (tid & 7) * 16) = (u32x4){0u, 0u, 0u, 0u}; *(LAS u32x4*)(lds + DIL_VOFF + j * VROW + (tid & 7) * 16) = (u32x4){0u, 0u, 0u, 0u}; }
        if (v < NUNIT_DIL) { const DilGeo z = dil_geo(v); dil_prefetch(QKV, z, tid, lane, wave, R0); }
        if (v + G < NUNIT_DIL) { const DilGeo z = dil_geo(v + G); dil_prefetch(QKV, z, tid, lane, wave, R1); }
        for (; v < NUNIT_DIL; v += 2 * G) {
            dil_unit(p, lds, v, (v + 2 * G < NUNIT_DIL) ? v + 2 * G : v, tid, lane, wave, R0);
            if (v + G < NUNIT_DIL) dil_unit(p, lds, v + G, (v + 3 * G < NUNIT_DIL) ? v + 3 * G : v + G, tid, lane, wave, R1);
        }
    }
}

__device__ __forceinline__ void unpack8(const u32x4 w, float (&f)[8]) { f[0] = bf_lo(w.x); f[1] = bf_hi(w.x); f[2] = bf_lo(w.y); f[3] = bf_hi(w.y); f[4] = bf_lo(w.z); f[5] = bf_hi(w.z); f[6] = bf_lo(w.w); f[7] = bf_hi(w.w); }
__device__ __forceinline__ void merge_norm(const Params& p, int gw, int NGW, int lane) {
    const bf16_t* ONA = (const bf16_t*)(p.ws + WS_ONA); const bf16_t* OD = (const bf16_t*)(p.ws + WS_OD); const float* LSE = (const float*)(p.ws + WS_LSE);
    bf16_t* Hn = (bf16_t*)(p.ws + WS_H);
    const __amdgpu_buffer_rsrc_t hrs = pg8::wt_rsrc(Hn);
    for (int t = gw; t < TOK; t += NGW) {
        float na[8], d0[8], d1[8], d2[8];
        unpack8(__builtin_nontemporal_load((const u32x4*)(ONA + (size_t)t * 512 + 8 * lane)), na);
        unpack8(__builtin_nontemporal_load((const u32x4*)(OD + (size_t)t * 512 + 8 * lane)), d0);
        unpack8(__builtin_nontemporal_load((const u32x4*)(OD + ((size_t)TOK + t) * 512 + 8 * lane)), d1);
        unpack8(__builtin_nontemporal_load((const u32x4*)(OD + ((size_t)2 * TOK + t) * 512 + 8 * lane)), d2);
        const int hh = lane >> 3;
        const float l0 = LSE[(size_t)t * 8 + hh], l1 = LSE[((size_t)TOK + t) * 8 + hh], l2 = LSE[((size_t)2 * TOK + t) * 8 + hh];
        const float m = fmaxf(l0, fmaxf(l1, l2));
        const float e0 = __builtin_amdgcn_exp2f(l0 - m), e1 = __builtin_amdgcn_exp2f(l1 - m), e2 = __builtin_amdgcn_exp2f(l2 - m), ie = 1.f / (e0 + e1 + e2);
        const float al0 = e0 * ie, al1 = e1 * ie, al2 = e2 * ie;
        float ssa = 0.f, ssb = 0.f, dl[8];
#pragma unroll
        for (int k = 0; k < 8; ++k) { dl[k] = al0 * d0[k] + al1 * d1[k] + al2 * d2[k]; ssa += na[k] * na[k]; ssb += dl[k] * dl[k]; }
        const float rsa = rsqrtf(wave_sum(ssa) * (1.f / 512.f) + EPS), rsb = rsqrtf(wave_sum(ssb) * (1.f / 512.f) + EPS);
        u32x4 wa, wb;
        wa.x = pkbf(na[0] * rsa, na[1] * rsa); wa.y = pkbf(na[2] * rsa, na[3] * rsa); wa.z = pkbf(na[4] * rsa, na[5] * rsa); wa.w = pkbf(na[6] * rsa, na[7] * rsa);
        wb.x = pkbf(dl[0] * rsb, dl[1] * rsb); wb.y = pkbf(dl[2] * rsb, dl[3] * rsb); wb.z = pkbf(dl[4] * rsb, dl[5] * rsb); wb.w = pkbf(dl[6] * rsb, dl[7] * rsb);
        pg8::wt_store16(hrs, ((size_t)t * DM + 8 * lane) * 2, wa);
        pg8::wt_store16(hrs, ((size_t)t * DM + 512 + 8 * lane) * 2, wb);
    }
}

__device__ __forceinline__ void ce(float& a, float& b) { const float hi = fmaxf(a, b), lo = fminf(a, b); a = hi; b = lo; }
template <int N> __device__ __forceinline__ void bitonic_sort_desc(float (&v)[N]) {
#pragma unroll
    for (int k = 2; k <= N; k <<= 1)
#pragma unroll
        for (int j = k >> 1; j > 0; j >>= 1)
#pragma unroll
            for (int i = 0; i < N; ++i) { const int l = i ^ j; if (l > i) { if ((i & k) == 0) ce(v[i], v[l]); else ce(v[l], v[i]); } }
}
__device__ __forceinline__ void sort16_desc(float (&v)[16]) {
    ce(v[0], v[1]); ce(v[2], v[3]); ce(v[0], v[2]); ce(v[1], v[3]); ce(v[1], v[2]); ce(v[4], v[5]); ce(v[6], v[7]); ce(v[4], v[6]); ce(v[5], v[7]); ce(v[5], v[6]); ce(v[0], v[4]); ce(v[2], v[6]); ce(v[2], v[4]); ce(v[1], v[5]); ce(v[3], v[7]); ce(v[3], v[5]); ce(v[1], v[2]); ce(v[3], v[4]); ce(v[5], v[6]); ce(v[8], v[9]); ce(v[10], v[11]); ce(v[8], v[10]); ce(v[9], v[11]); ce(v[9], v[10]); ce(v[12], v[13]); ce(v[14], v[15]); ce(v[12], v[14]); ce(v[13], v[15]); ce(v[13], v[14]); ce(v[8], v[12]); ce(v[10], v[14]); ce(v[10], v[12]); ce(v[9], v[13]); ce(v[11], v[15]); ce(v[11], v[13]); ce(v[9], v[10]); ce(v[11], v[12]); ce(v[13], v[14]); ce(v[0], v[8]); ce(v[4], v[12]); ce(v[4], v[8]); ce(v[2], v[10]); ce(v[6], v[14]); ce(v[6], v[10]); ce(v[2], v[4]); ce(v[6], v[8]); ce(v[10], v[12]); ce(v[1], v[9]); ce(v[5], v[13]); ce(v[5], v[9]); ce(v[3], v[11]); ce(v[7], v[15]); ce(v[7], v[11]); ce(v[3], v[5]); ce(v[7], v[9]); ce(v[11], v[13]); ce(v[1], v[2]); ce(v[3], v[4]); ce(v[5], v[6]); ce(v[7], v[8]); ce(v[9], v[10]); ce(v[11], v[12]); ce(v[13], v[14]);
}
template <int N> __device__ __forceinline__ void bitonic_merge_desc(float (&v)[N]) {
#pragma unroll
    for (int j = N >> 1; j > 0; j >>= 1)
#pragma unroll
        for (int i = 0; i < N; ++i) if ((i & j) == 0) ce(v[i], v[i | j]);
}
__device__ __forceinline__ float h2f_lo(unsigned u) { return (float)__builtin_bit_cast(_Float16, (unsigned short)(u & 0xffffu)); }
__device__ __forceinline__ float h2f_hi(unsigned u) { return (float)__builtin_bit_cast(_Float16, (unsigned short)(u >> 16)); }
__device__ __forceinline__ void top16_of_128(const LAS unsigned char* row, float (&run)[16]) {
#pragma unroll
    for (int gi = 0; gi < 8; ++gi) {
        float grp[16];
#pragma unroll
        for (int q4 = 0; q4 < 2; ++q4) { const u32x4 v = *(const LAS u32x4*)(row + gi * 32 + q4 * 16);
#pragma unroll
            for (int e = 0; e < 4; ++e) {
                grp[8 * q4 + 2 * e] = __uint_as_float(__float_as_uint(h2f_lo(v[e])) | (unsigned)(gi * 16 + 8 * q4 + 2 * e));
                grp[8 * q4 + 2 * e + 1] = __uint_as_float(__float_as_uint(h2f_hi(v[e])) | (unsigned)(gi * 16 + 8 * q4 + 2 * e + 1)); } }
        sort16_desc(grp);
        if (gi == 0) {
#pragma unroll
            for (int i = 0; i < 16; ++i) run[i] = grp[i];
        } else {
#pragma unroll
            for (int i = 0; i < 16; ++i) run[i] = fmaxf(run[i], grp[15 - i]);
            bitonic_merge_desc<16>(run);
        }
    }
}
#define CAND(i, j) __uint_as_float((__float_as_uint(v1[i] + v2[j]) & ~0xFFu) | (unsigned)((i) * 16 + (j)))
constexpr int TK_ROW = 272;
__device__ __forceinline__ void tk_stage(const _Float16* SC, LAS unsigned char* wb, int t0, int col0, int lane) {
    u32x4 v[16];
#pragma unroll
    for (int i = 0; i < 16; ++i) { const int pi = i * 64 + lane, row = pi >> 4, ch = pi & 15; v[i] = __builtin_nontemporal_load((const u32x4*)(SC + (size_t)(t0 + row) * NPQ + col0 + ch * 8)); }
#pragma unroll
    for (int i = 0; i < 16; ++i) { const int pi = i * 64 + lane, row = pi >> 4, ch = pi & 15; *(LAS u32x4*)(wb + row * TK_ROW + ch * 16) = v[i]; }
}
__device__ __forceinline__ void topk_phase(const Params& p, LAS unsigned char* lds, int gw, int NGW, int lane, int wave) {
    const _Float16* SC = (const _Float16*)(p.ws + WS_SC);
    unsigned* IDS = (unsigned*)(p.ws + WS_IDS); float* GATES = (float*)(p.ws + WS_GATES);
    LAS unsigned char* wb = lds + wave * (64 * TK_ROW);
    LAS unsigned char* my = wb + lane * TK_ROW;
    const float NEG = -3.0e38f;
    for (int wi = gw; wi < (TOK / 64) * 8; wi += NGW) {
        const int t0 = (wi >> 3) * 64, hh = wi & 7, it = (t0 + lane) * 8 + hh;
        float v1[16], v2[16];
        tk_stage(SC, wb, t0, hh * 256, lane);
        top16_of_128(my, v1);
        tk_stage(SC, wb, t0, hh * 256 + 128, lane);
        top16_of_128(my, v2);
        {
            u32x4 w1, w2;
#define PK4(v, o) ((__float_as_uint(v[o]) & 0x7Fu) | ((__float_as_uint(v[o + 1]) & 0x7Fu) << 8) | ((__float_as_uint(v[o + 2]) & 0x7Fu) << 16) | ((__float_as_uint(v[o + 3]) & 0x7Fu) << 24))
            w1.x = PK4(v1, 0); w1.y = PK4(v1, 4); w1.z = PK4(v1, 8); w1.w = PK4(v1, 12);
            w2.x = PK4(v2, 0); w2.y = PK4(v2, 4); w2.z = PK4(v2, 8); w2.w = PK4(v2, 12);
#undef PK4
            *(LAS u32x4*)my = w1; *(LAS u32x4*)(my + 16) = w2;
        }
        float best[16], grp[16];
        best[0] = CAND(0, 0); best[1] = CAND(0, 1); best[2] = CAND(0, 2); best[3] = CAND(0, 3); best[4] = CAND(0, 4); best[5] = CAND(0, 5); best[6] = CAND(0, 6); best[7] = CAND(0, 7);
        best[8] = CAND(0, 8); best[9] = CAND(0, 9); best[10] = CAND(0, 10); best[11] = CAND(0, 11); best[12] = CAND(0, 12); best[13] = CAND(0, 13); best[14] = CAND(0, 14); best[15] = CAND(0, 15);
        sort16_desc(best);
        grp[0] = CAND(1, 0); grp[1] = CAND(1, 1); grp[2] = CAND(1, 2); grp[3] = CAND(1, 3); grp[4] = CAND(1, 4); grp[5] = CAND(1, 5); grp[6] = CAND(1, 6); grp[7] = CAND(1, 7);
        grp[8] = CAND(2, 0); grp[9] = CAND(2, 1); grp[10] = CAND(2, 2); grp[11] = CAND(2, 3); grp[12] = CAND(2, 4); grp[13] = CAND(3, 0); grp[14] = CAND(3, 1); grp[15] = CAND(3, 2);
        sort16_desc(grp);
#pragma unroll
        for (int i = 0; i < 16; ++i) best[i] = fmaxf(best[i], grp[15 - i]);
        bitonic_merge_desc<16>(best);
        grp[0] = CAND(3, 3); grp[1] = CAND(4, 0); grp[2] = CAND(4, 1); grp[3] = CAND(4, 2); grp[4] = CAND(5, 0); grp[5] = CAND(5, 1); grp[6] = CAND(6, 0); grp[7] = CAND(6, 1);
        grp[8] = CAND(7, 0); grp[9] = CAND(7, 1); grp[10] = CAND(8, 0); grp[11] = CAND(9, 0); grp[12] = CAND(10, 0); grp[13] = CAND(11, 0); grp[14] = CAND(12, 0); grp[15] = CAND(13, 0);
        sort16_desc(grp);
#pragma unroll
        for (int i = 0; i < 16; ++i) best[i] = fmaxf(best[i], grp[15 - i]);
        bitonic_merge_desc<16>(best);
        grp[0] = CAND(14, 0); grp[1] = CAND(15, 0);
#pragma unroll
        for (int i = 2; i < 16; ++i) grp[i] = NEG;
        sort16_desc(grp);
#pragma unroll
        for (int i = 0; i < 16; ++i) best[i] = fmaxf(best[i], grp[15 - i]);
        bitonic_merge_desc<16>(best);
        float e[16], sum = 0.f;
#pragma unroll
        for (int k = 0; k < 16; ++k) { e[k] = __expf(best[k] - best[0]); sum += e[k]; }
        const float isum = 1.f / sum;
        int idv[16];
        asm volatile("s_waitcnt lgkmcnt(0)" ::: "memory");
#pragma unroll
        for (int k = 0; k < 16; ++k) { const unsigned code = __float_as_uint(best[k]) & 0xFFu; const unsigned i1 = my[code >> 4], i2 = my[16 + (code & 15u)]; idv[k] = (int)(i1 * 128u + i2); }
        const int tt = it >> 3;
        unsigned* ip = IDS + (size_t)tt * 64 + hh; float* gp = GATES + (size_t)tt * 128 + 2 * hh;
#pragma unroll
        for (int j = 0; j < 8; ++j) {
            ip[8 * j] = (unsigned)idv[j] | ((unsigned)idv[j + 8] << 16);
            *(f32x2_t*)(gp + 16 * j) = (f32x2_t){e[j] * isum, e[j + 8] * isum};
        }
    }
}
#undef CAND

struct Topo { int xi, nx, rank, nloc; };
constexpr int CW_XCNT = 8192;
__device__ __forceinline__ float wave_max(float v) {
#pragma unroll
    for (int o = 1; o < 64; o <<= 1) v = fmaxf(v, __shfl_xor(v, o));
    return v;
}
__device__ __forceinline__ unsigned pack4(int a, int b, int c, int d) { return ((unsigned)a & 255u) | (((unsigned)b & 255u) << 8) | (((unsigned)c & 255u) << 16) | ((unsigned)d << 24); }
template <int CTRL> __device__ __forceinline__ int dppi(int v) { return __builtin_amdgcn_update_dpp(0, v, CTRL, 0xF, 0xF, false); }

#define PE_LOAD_IDS(ids, tok) do { const u32x4* ip_ = (const u32x4*)(IDST + (size_t)(tok) * 64 + 8 * j); ids[0] = ip_[0]; ids[1] = ip_[1]; } while (0)
#define PE_WARM(pf, ptr) asm volatile("s_load_dword %0, %1, 0x0" : "+s"(pf) : "s"(ptr))
#define PE_WARM_DRAIN(pf) asm volatile("s_waitcnt lgkmcnt(0)" : "+s"(pf))
#define PE_LOAD_SEGS(seg, ids, tab) do { _Pragma("unroll") for (int i_ = 0; i_ < 16; ++i_) seg[i_] = *(const u32x4*)((tab) + (size_t)((i_ & 1) ? (ids[i_ >> 3][(i_ >> 1) & 3] >> 16) : (ids[i_ >> 3][(i_ >> 1) & 3] & 0xffffu)) * 128); } while (0)

__device__ __forceinline__ void pe_u_compute(const u32x4 (&seg)[16], const u32x4 h8, unsigned* dst, bool live, int lane) {
    int a[16];
#pragma unroll
    for (int i = 0; i < 16; ++i) { int s_ = 0;
#pragma unroll
        for (int w = 0; w < 4; ++w) s_ = __builtin_amdgcn_sdot4((int)seg[i][w], (int)h8[w], s_, false);
        a[i] = s_; }
    const bool q2 = (lane & 4) != 0, q1 = (lane & 2) != 0, q0 = (lane & 1) != 0;
    int c[8], d[4], e[2];
#pragma unroll
    for (int i = 0; i < 8; ++i) { const int keep = q2 ? a[i + 8] : a[i], send = q2 ? a[i] : a[i + 8]; c[i] = keep + dppi<0x141>(send); }
#pragma unroll
    for (int i = 0; i < 4; ++i) { const int keep = q1 ? c[i + 4] : c[i], send = q1 ? c[i] : c[i + 4]; d[i] = keep + dppi<0x4E>(send); }
#pragma unroll
    for (int i = 0; i < 2; ++i) { const int keep = q0 ? d[i + 2] : d[i], send = q0 ? d[i] : d[i + 2]; e[i] = keep + dppi<0xB1>(send); }
    if (live) *dst = pkh((float)e[0] * (1.f / 64.f), (float)e[1] * (1.f / 64.f));
}
__device__ __forceinline__ void peer_u_phase(const Params& p, const Topo& tp, int lane, int wave) {
    const unsigned* IDST = (const unsigned*)(p.ws + WS_IDS); const unsigned char* H8 = p.ws + WS_H8; unsigned* PART = (unsigned*)(p.ws + WS_PART);
    const int j = lane >> 3, q = lane & 7;
    const int wv = __builtin_amdgcn_readfirstlane(tp.rank * 8 + wave), nwv = __builtin_amdgcn_readfirstlane(tp.nloc * 8);
    for (int s = tp.xi; s < 8; s += tp.nx) {
        const unsigned char* tab = p.ws + WS_UH + (size_t)s * NEXP * 128 + 16 * q;
        const unsigned char* hb = H8 + 128 * s + 16 * q;
        unsigned* pb = PART + (size_t)s * TOK * 64 + j * 8 + q;
        u32x4 idsA[2], idsB[2], segA[16], segB[16], h8A, h8B;
        int t = wv;
        unsigned pf = 0u;
#define PE_WARM_TOK(tok) do { const unsigned* wi_ = IDST + (size_t)(tok) * 64; PE_WARM(pf, wi_); PE_WARM(pf, wi_ + 32); const unsigned char* wh_ = H8 + 128 * s + (size_t)(tok) * 1024; PE_WARM(pf, wh_); } while (0)
#define TC(x) ((x) < TOK ? (x) : TOK - 1)
        PE_LOAD_IDS(idsA, TC(t));
        PE_LOAD_IDS(idsB, TC(t + nwv));
        PE_LOAD_SEGS(segA, idsA, tab); h8A = *(const u32x4*)(hb + (size_t)TC(t) * 1024);
        for (; t < TOK; t += 8 * nwv) {
            PE_LOAD_IDS(idsA, TC(t + (2 + 0) * nwv));
            PE_WARM_TOK(TC(t + (3 + (2 + 0)) * nwv));
            __builtin_amdgcn_sched_barrier(0);
            PE_LOAD_SEGS(segB, idsB, tab); h8B = *(const u32x4*)(hb + (size_t)TC(t + (1 + 0) * nwv) * 1024);
            __builtin_amdgcn_sched_barrier(0);
            pe_u_compute(segA, h8A, pb + (size_t)TC(t + (0) * nwv) * 64, t + (0) * nwv < TOK, lane);
            PE_LOAD_IDS(idsB, TC(t + (3 + 0) * nwv));
            PE_WARM_TOK(TC(t + (3 + (3 + 0)) * nwv));
            __builtin_amdgcn_sched_barrier(0);
            PE_LOAD_SEGS(segA, idsA, tab); h8A = *(const u32x4*)(hb + (size_t)TC(t + (2 + 0) * nwv) * 1024);
            __builtin_amdgcn_sched_barrier(0);
            pe_u_compute(segB, h8B, pb + (size_t)TC(t + (1 + 0) * nwv) * 64, t + (1 + 0) * nwv < TOK, lane);
            PE_LOAD_IDS(idsA, TC(t + (2 + 2) * nwv));
            PE_WARM_TOK(TC(t + (3 + (2 + 2)) * nwv));
            __builtin_amdgcn_sched_barrier(0);
            PE_LOAD_SEGS(segB, idsB, tab); h8B = *(const u32x4*)(hb + (size_t)TC(t + (1 + 2) * nwv) * 1024);
            __builtin_amdgcn_sched_barrier(0);
            pe_u_compute(segA, h8A, pb + (size_t)TC(t + (2) * nwv) * 64, t + (2) * nwv < TOK, lane);
            PE_LOAD_IDS(idsB, TC(t + (3 + 2) * nwv));
            PE_WARM_TOK(TC(t + (3 + (3 + 2)) * nwv));
            __builtin_amdgcn_sched_barrier(0);
            PE_LOAD_SEGS(segA, idsA, tab); h8A = *(const u32x4*)(hb + (size_t)TC(t + (2 + 2) * nwv) * 1024);
            __builtin_amdgcn_sched_barrier(0);
            pe_u_compute(segB, h8B, pb + (size_t)TC(t + (1 + 2) * nwv) * 64, t + (1 + 2) * nwv < TOK, lane);
            PE_LOAD_IDS(idsA, TC(t + (2 + 4) * nwv));
            PE_WARM_TOK(TC(t + (3 + (2 + 4)) * nwv));
            __builtin_amdgcn_sched_barrier(0);
            PE_LOAD_SEGS(segB, idsB, tab); h8B = *(const u32x4*)(hb + (size_t)TC(t + (1 + 4) * nwv) * 1024);
            __builtin_amdgcn_sched_barrier(0);
            pe_u_compute(segA, h8A, pb + (size_t)TC(t + (4) * nwv) * 64, t + (4) * nwv < TOK, lane);
            PE_LOAD_IDS(idsB, TC(t + (3 + 4) * nwv));
            PE_WARM_TOK(TC(t + (3 + (3 + 4)) * nwv));
            __builtin_amdgcn_sched_barrier(0);
            PE_LOAD_SEGS(segA, idsA, tab); h8A = *(const u32x4*)(hb + (size_t)TC(t + (2 + 4) * nwv) * 1024);
            __builtin_amdgcn_sched_barrier(0);
            pe_u_compute(segB, h8B, pb + (size_t)TC(t + (1 + 4) * nwv) * 64, t + (1 + 4) * nwv < TOK, lane);
            PE_LOAD_IDS(idsA, TC(t + (2 + 6) * nwv));
            PE_WARM_TOK(TC(t + (3 + (2 + 6)) * nwv));
            __builtin_amdgcn_sched_barrier(0);
            PE_LOAD_SEGS(segB, idsB, tab); h8B = *(const u32x4*)(hb + (size_t)TC(t + (1 + 6) * nwv) * 1024);
            __builtin_amdgcn_sched_barrier(0);
            pe_u_compute(segA, h8A, pb + (size_t)TC(t + (6) * nwv) * 64, t + (6) * nwv < TOK, lane);
            PE_LOAD_IDS(idsB, TC(t + (3 + 6) * nwv));
            PE_WARM_TOK(TC(t + (3 + (3 + 6)) * nwv));
            __builtin_amdgcn_sched_barrier(0);
            PE_LOAD_SEGS(segA, idsA, tab); h8A = *(const u32x4*)(hb + (size_t)TC(t + (2 + 6) * nwv) * 1024);
            __builtin_amdgcn_sched_barrier(0);
            pe_u_compute(segB, h8B, pb + (size_t)TC(t + (1 + 6) * nwv) * 64, t + (1 + 6) * nwv < TOK, lane);
        }
        PE_WARM_DRAIN(pf);
#undef PE_WARM_TOK
    }
}
__device__ __forceinline__ void peer_w_phase(const Params& p, int gw, int NGW, int lane) {
    const unsigned* IDST = (const unsigned*)(p.ws + WS_IDS); const float* GT = (const float*)(p.ws + WS_GATES); const unsigned* PART = (const unsigned*)(p.ws + WS_PART);
    const float* SU = (const float*)(p.ws + WS_SU); const float* SV = (const float*)(p.ws + WS_SV); const float* SH = (const float*)(p.ws + WS_SH);
    unsigned short* W8 = (unsigned short*)(p.ws + WS_W8); float* SW = (float*)(p.ws + WS_SW);
    for (int t = gw; t < TOK; t += NGW) {
        const size_t ix = (size_t)t * 128 + 2 * lane;
        float a0 = 0.f, a1 = 0.f;
#pragma unroll
        for (int s = 0; s < 8; ++s) { const unsigned v = __builtin_nontemporal_load(PART + (size_t)s * TOK * 64 + (ix >> 1)); a0 += h2f_lo(v); a1 += h2f_hi(v); }
        const unsigned idp = IDST[ix >> 1]; const u32x2 id = {idp & 0xffffu, idp >> 16}; const f32x2_t g = *(const f32x2_t*)(GT + ix);
        const float sh = SH[t];
        const float x0 = a0 * 64.f * SU[id.x] * sh, x1 = a1 * 64.f * SU[id.y] * sh;
        const float w0 = g.x * 0.5f * x0 * (1.f + erff(x0 * 0.70710678118654752f)) * SV[id.x];
        const float w1 = g.y * 0.5f * x1 * (1.f + erff(x1 * 0.70710678118654752f)) * SV[id.y];
        const float wm = wave_max(fmaxf(fabsf(w0), fabsf(w1)));
        const float inv = wm > 0.f ? 127.f / wm : 0.f;
        W8[ix >> 1] = (unsigned short)(((unsigned)((int)rintf(w0 * inv)) & 255u) | (((unsigned)((int)rintf(w1 * inv)) & 255u) << 8));
        if (lane == 0) SW[t] = wm * (1.f / 127.f);
    }
}
__device__ __forceinline__ void pe_v_compute(const u32x4 (&seg)[16], const u32x4 w8, float sw, bf16_t* dst, bool live, int lane) {
    int o[16];
#pragma unroll
    for (int i = 0; i < 16; ++i) o[i] = 0;
#pragma unroll
    for (int qd = 0; qd < 4; ++qd)
#pragma unroll
        for (int w = 0; w < 4; ++w) {
            const unsigned ra = seg[4 * qd][w], rb = seg[4 * qd + 1][w], rc = seg[4 * qd + 2][w], rd = seg[4 * qd + 3][w];
            const unsigned abl = __builtin_amdgcn_perm(rb, ra, 0x05010400u), abh = __builtin_amdgcn_perm(rb, ra, 0x07030602u);
            const unsigned cdl = __builtin_amdgcn_perm(rd, rc, 0x05010400u), cdh = __builtin_amdgcn_perm(rd, rc, 0x07030602u);
            o[4 * w + 0] = __builtin_amdgcn_sdot4((int)__builtin_amdgcn_perm(cdl, abl, 0x05040100u), (int)w8[qd], o[4 * w + 0], false);
            o[4 * w + 1] = __builtin_amdgcn_sdot4((int)__builtin_amdgcn_perm(cdl, abl, 0x07060302u), (int)w8[qd], o[4 * w + 1], false);
            o[4 * w + 2] = __builtin_amdgcn_sdot4((int)__builtin_amdgcn_perm(cdh, abh, 0x05040100u), (int)w8[qd], o[4 * w + 2], false);
            o[4 * w + 3] = __builtin_amdgcn_sdot4((int)__builtin_amdgcn_perm(cdh, abh, 0x07060302u), (int)w8[qd], o[4 * w + 3], false);
        }
    int b[8], c[4], d[2];
#pragma unroll
    for (int m = 0; m < 8; ++m) { auto r = __builtin_amdgcn_permlane32_swap((unsigned)o[m], (unsigned)o[m + 8], false, false); b[m] = (int)r[0] + (int)r[1]; }
#pragma unroll
    for (int m = 0; m < 4; ++m) { auto r = __builtin_amdgcn_permlane16_swap((unsigned)b[m], (unsigned)b[m + 4], false, false); c[m] = (int)r[0] + (int)r[1]; }
    const bool b3 = (lane & 8) != 0;
#pragma unroll
    for (int m = 0; m < 2; ++m) { const int keep = b3 ? c[m + 2] : c[m], send = b3 ? c[m] : c[m + 2]; d[m] = keep + dppi<0x128>(send); }
    if (live) *(unsigned*)dst = pkbf((float)d[0] * sw, (float)d[1] * sw);
}
__device__ __forceinline__ void peer_v_phase(const Params& p, const Topo& tp, int lane, int wave) {
    const unsigned* IDST = (const unsigned*)(p.ws + WS_IDS); const unsigned char* W8 = p.ws + WS_W8; const float* SW = (const float*)(p.ws + WS_SW); bf16_t* PEER = (bf16_t*)(p.ws + WS_PEER);
    const int j = lane >> 3, q = lane & 7;
    const int wv = __builtin_amdgcn_readfirstlane(tp.rank * 8 + wave), nwv = __builtin_amdgcn_readfirstlane(tp.nloc * 8);
    for (int s = tp.xi; s < 8; s += tp.nx) {
        const unsigned char* tab = p.ws + WS_VH + (size_t)s * NEXP * 128 + 16 * q;
        const unsigned char* wb = W8 + 16 * j;
        bf16_t* ob = PEER + 128 * s + 16 * q + 2 * j;
        u32x4 idsA[2], idsB[2], segA[16], segB[16], w8A, w8B; float swA, swB;
        int t = wv;
        unsigned pf = 0u;
#define PE_WARM_TOK(tok) do { const unsigned* wi_ = IDST + (size_t)(tok) * 64; PE_WARM(pf, wi_); PE_WARM(pf, wi_ + 32); const unsigned char* ww_ = W8 + (size_t)(tok) * 128; PE_WARM(pf, ww_); } while (0)
        PE_LOAD_IDS(idsA, TC(t));
        PE_LOAD_IDS(idsB, TC(t + nwv));
        PE_LOAD_SEGS(segA, idsA, tab); w8A = *(const u32x4*)(wb + (size_t)TC(t) * 128); swA = SW[TC(t)];
        for (; t < TOK; t += 8 * nwv) {
            PE_LOAD_IDS(idsA, TC(t + (2 + 0) * nwv));
            PE_WARM_TOK(TC(t + (3 + (2 + 0)) * nwv));
            __builtin_amdgcn_sched_barrier(0);
            PE_LOAD_SEGS(segB, idsB, tab); w8B = *(const u32x4*)(wb + (size_t)TC(t + (1 + 0) * nwv) * 128); swB = SW[TC(t + (1 + 0) * nwv)];
            __builtin_amdgcn_sched_barrier(0);
            pe_v_compute(segA, w8A, swA, ob + (size_t)TC(t + (0) * nwv) * DM, t + (0) * nwv < TOK, lane);
            PE_LOAD_IDS(idsB, TC(t + (3 + 0) * nwv));
            PE_WARM_TOK(TC(t + (3 + (3 + 0)) * nwv));
            __builtin_amdgcn_sched_barrier(0);
            PE_LOAD_SEGS(segA, idsA, tab); w8A = *(const u32x4*)(wb + (size_t)TC(t + (2 + 0) * nwv) * 128); swA = SW[TC(t + (2 + 0) * nwv)];
            __builtin_amdgcn_sched_barrier(0);
            pe_v_compute(segB, w8B, swB, ob + (size_t)TC(t + (1 + 0) * nwv) * DM, t + (1 + 0) * nwv < TOK, lane);
            PE_LOAD_IDS(idsA, TC(t + (2 + 2) * nwv));
            PE_WARM_TOK(TC(t + (3 + (2 + 2)) * nwv));
            __builtin_amdgcn_sched_barrier(0);
            PE_LOAD_SEGS(segB, idsB, tab); w8B = *(const u32x4*)(wb + (size_t)TC(t + (1 + 2) * nwv) * 128); swB = SW[TC(t + (1 + 2) * nwv)];
            __builtin_amdgcn_sched_barrier(0);
            pe_v_compute(segA, w8A, swA, ob + (size_t)TC(t + (2) * nwv) * DM, t + (2) * nwv < TOK, lane);
            PE_LOAD_IDS(idsB, TC(t + (3 + 2) * nwv));
            PE_WARM_TOK(TC(t + (3 + (3 + 2)) * nwv));
            __builtin_amdgcn_sched_barrier(0);
            PE_LOAD_SEGS(segA, idsA, tab); w8A = *(const u32x4*)(wb + (size_t)TC(t + (2 + 2) * nwv) * 128); swA = SW[TC(t + (2 + 2) * nwv)];
            __builtin_amdgcn_sched_barrier(0);
            pe_v_compute(segB, w8B, swB, ob + (size_t)TC(t + (1 + 2) * nwv) * DM, t + (1 + 2) * nwv < TOK, lane);
            PE_LOAD_IDS(idsA, TC(t + (2 + 4) * nwv));
            PE_WARM_TOK(TC(t + (3 + (2 + 4)) * nwv));
            __builtin_amdgcn_sched_barrier(0);
            PE_LOAD_SEGS(segB, idsB, tab); w8B = *(const u32x4*)(wb + (size_t)TC(t + (1 + 4) * nwv) * 128); swB = SW[TC(t + (1 + 4) * nwv)];
            __builtin_amdgcn_sched_barrier(0);
            pe_v_compute(segA, w8A, swA, ob + (size_t)TC(t + (4) * nwv) * DM, t + (4) * nwv < TOK, lane);
            PE_LOAD_IDS(idsB, TC(t + (3 + 4) * nwv));
            PE_WARM_TOK(TC(t + (3 + (3 + 4)) * nwv));
            __builtin_amdgcn_sched_barrier(0);
            PE_LOAD_SEGS(segA, idsA, tab); w8A = *(const u32x4*)(wb + (size_t)TC(t + (2 + 4) * nwv) * 128); swA = SW[TC(t + (2 + 4) * nwv)];
            __builtin_amdgcn_sched_barrier(0);
            pe_v_compute(segB, w8B, swB, ob + (size_t)TC(t + (1 + 4) * nwv) * DM, t + (1 + 4) * nwv < TOK, lane);
            PE_LOAD_IDS(idsA, TC(t + (2 + 6) * nwv));
            PE_WARM_TOK(TC(t + (3 + (2 + 6)) * nwv));
            __builtin_amdgcn_sched_barrier(0);
            PE_LOAD_SEGS(segB, idsB, tab); w8B = *(const u32x4*)(wb + (size_t)TC(t + (1 + 6) * nwv) * 128); swB = SW[TC(t + (1 + 6) * nwv)];
            __builtin_amdgcn_sched_barrier(0);
            pe_v_compute(segA, w8A, swA, ob + (size_t)TC(t + (6) * nwv) * DM, t + (6) * nwv < TOK, lane);
            PE_LOAD_IDS(idsB, TC(t + (3 + 6) * nwv));
            PE_WARM_TOK(TC(t + (3 + (3 + 6)) * nwv));
            __builtin_amdgcn_sched_barrier(0);
            PE_LOAD_SEGS(segA, idsA, tab); w8A = *(const u32x4*)(wb + (size_t)TC(t + (2 + 6) * nwv) * 128); swA = SW[TC(t + (2 + 6) * nwv)];
            __builtin_amdgcn_sched_barrier(0);
            pe_v_compute(segB, w8B, swB, ob + (size_t)TC(t + (1 + 6) * nwv) * DM, t + (1 + 6) * nwv < TOK, lane);
        }
        PE_WARM_DRAIN(pf);
#undef PE_WARM_TOK
    }
}
#undef TC
#undef PE_LOAD_IDS
#undef PE_LOAD_SEGS
#undef PE_WARM
#undef PE_WARM_DRAIN
__device__ __forceinline__ void final_phase(const Params& p, float* dstbase, int gw, int NGW, int lane) {
    const float* mod = (const float*)(p.ws + WS_MOD); const bf16_t* PEER = (const bf16_t*)(p.ws + WS_PEER);
    f32x4 fg[4];
#pragma unroll
    for (int j = 0; j < 4; ++j) fg[j] = *(const f32x4*)(p.final_g + 4 * lane + 256 * j);
    const __amdgpu_buffer_rsrc_t ors = pg8::wt_rsrc(dstbase);
    for (int t = gw; t < TOK; t += NGW) {
        const float* mb = mod + (size_t)(t >> 11) * 6144 + 5120;
        const f32x4* xr = (const f32x4*)(p.x + (size_t)t * DM) + lane; const u32x2* pr = (const u32x2*)(PEER + (size_t)t * DM) + lane; const u32x2* zr = (const u32x2*)((const bf16_t*)(p.ws + WS_Z) + (size_t)t * DM) + lane;
        f32x4* xw = (f32x4*)(dstbase + (size_t)t * DM) + lane;
        f32x4 x2[4]; float ss = 0.f;
#pragma unroll
        for (int j = 0; j < 4; ++j) { const f32x4 g2 = *(const f32x4*)(mb + 4 * lane + 256 * j); const u32x2 pv = __builtin_nontemporal_load(pr + 64 * j), zv = __builtin_nontemporal_load(zr + 64 * j); x2[j] = __builtin_nontemporal_load(xr + 64 * j) + (f32x4){bf_lo(zv.x), bf_hi(zv.x), bf_lo(zv.y), bf_hi(zv.y)} + g2 * (f32x4){bf_lo(pv.x), bf_hi(pv.x), bf_lo(pv.y), bf_hi(pv.y)};
            ss += (x2[j][0] * x2[j][0] + x2[j][1] * x2[j][1]) + (x2[j][2] * x2[j][2] + x2[j][3] * x2[j][3]); }
        const float rs = rsqrtf(wave_sum(ss) * (1.f / DM) + EPS);
#pragma unroll
        for (int j = 0; j < 4; ++j) pg8::wt_store16(ors, ((size_t)t * DM + 4 * lane + 256 * j) * 4, __builtin_bit_cast(u32x4, x2[j] * rs * fg[j]));
    }
}

#ifndef MK_PROF_PHASE
#define MK_PROF_PHASE -1
#endif
#ifndef MK_PROF_MULT
#define MK_PROF_MULT 4
#endif
__global__ void __launch_bounds__(512, 2) mk_fwd(Params p) {
    extern __shared__ __attribute__((aligned(16))) unsigned char lds_raw[];
    LAS unsigned char* lds = (LAS unsigned char*)lds_raw;
    const int tid = threadIdx.x, lane = tid & 63, wave = __builtin_amdgcn_readfirstlane(tid >> 6);
    const int G = gridDim.x, bx = blockIdx.x;
    const int vcu = (G % 8 == 0) ? (bx % 8) * (G / 8) + bx / 8 : bx;
    const int gw = vcu * 8 + wave, NGW = G * 8;
    const float* mod = (const float*)(p.ws + WS_MOD);
    bf16_t* Hb = (bf16_t*)(p.ws + WS_H);
#if MK_COOP
    volatile LAS unsigned* bst = (volatile LAS unsigned*)(lds + LDS_BYTES - 16);
    if (tid < 4) bst[tid] = 0u;
    __syncthreads();
    const XcdBarrier xb = xcd_barrier_post((unsigned*)(p.ws + WS_CTL) + 1024, bst);
    if (tid == 0) bst[2] = __hip_atomic_fetch_add((unsigned*)(p.ws + WS_CTL) + CW_XCNT + 64 * xb.x, 1u, __ATOMIC_RELAXED, __HIP_MEMORY_SCOPE_AGENT);
#define PHASE_END(k) do { if ((k) + 1 < p.ph_hi) xcd_barrier(xb); } while (0)
#else
#define PHASE_END(k) do { } while (0)
#endif
#define IN(k) (p.ph_lo <= (k) && (k) < p.ph_hi)
#if MK_PROF_PHASE >= 0
    unsigned long long pt_prev_ = __builtin_amdgcn_s_memrealtime(), pdt_ = 0ull;
#define PMARK(k) do { const unsigned long long n_ = __builtin_amdgcn_s_memrealtime(); if ((k) == MK_PROF_PHASE) pdt_ = n_ - pt_prev_; pt_prev_ = n_; } while (0)
#else
#define PMARK(k) do { } while (0)
#endif
    if (IN(0)) { p0_mod(p, lds, tid, lane, wave); PHASE_END(0); PMARK(0); }
    if (IN(1)) { p0_weights(p, lds, tid, lane, wave); norm_rows<false>(p.x, nullptr, p.norm1_g, mod, 0, 1024, Hb, nullptr, nullptr, gw, NGW, lane); PHASE_END(1); PMARK(1); }
    if (IN(2)) {
        pg8::Gemm g{Hb, (const bf16_t*)(p.ws + WS_WIN), TOK, NQKV, DM}; pg8::StaticOrder S; S.init(TOK, NQKV, G, bx);
        pg8::EpiQKV E{(bf16_t*)(p.ws + WS_QKV), NQKV, QSCALE};
        pg8::gemm_phase<pg8::EpiQKV, pg8::StaticOrder, true, true>(lds, g, S, E);
        PHASE_END(2); PMARK(2);
    }
    if (IN(3)) { attn_phase(p, lds, tid, lane, wave, vcu, G); PHASE_END(3); PMARK(3); }
    if (IN(4)) { merge_norm(p, gw, NGW, lane); PHASE_END(4); PMARK(4); }
    if (IN(5)) {
        pg8::Gemm g{Hb, (const bf16_t*)(p.ws + WS_WOUT), TOK, DM, DM}; pg8::StaticOrder S; S.init(TOK, DM, G, bx);
        pg8::EpiZ E{(bf16_t*)(p.ws + WS_Z), mod};
        pg8::gemm_phase<pg8::EpiZ, pg8::StaticOrder, true, true>(lds, g, S, E);
        PHASE_END(5); PMARK(5);
    }
    if (IN(6)) { norm_rows<true>(p.x, (const bf16_t*)(p.ws + WS_Z), p.norm2_g, mod, 3072, 4096, Hb, p.ws + WS_H8, (float*)(p.ws + WS_SH), gw, NGW, lane); PHASE_END(6); PMARK(6); }
    if (IN(7)) {
        pg8::Gemm g{Hb, (const bf16_t*)(p.ws + WS_WSC), TOK, NPQ, DM}; pg8::StaticOrder S; S.init(TOK, NPQ, G, bx);
        pg8::EpiSC E{(_Float16*)(p.ws + WS_SC), NPQ};
        pg8::gemm_phase<pg8::EpiSC, pg8::StaticOrder, true, true>(lds, g, S, E);
        PHASE_END(7); PMARK(7);
    }
    if (IN(8)) { topk_phase(p, lds, gw, NGW, lane, wave); PHASE_END(8); PMARK(8); }
    Topo tp; tp.xi = 0; tp.nx = 1; tp.rank = bx; tp.nloc = G;
#if MK_COOP
    if (IN(9) || IN(11)) {
        const unsigned* xc = (const unsigned*)(p.ws + WS_CTL) + CW_XCNT; int nx = 0, xi = 0, nloc = 1;
        for (int jx = 0; jx < 16; ++jx) { const unsigned cnt = __hip_atomic_load(xc + 64 * jx, __ATOMIC_RELAXED, __HIP_MEMORY_SCOPE_AGENT); if (cnt) { if (jx < (int)xb.x) ++xi; if (jx == (int)xb.x) nloc = (int)cnt; ++nx; } }
        tp.xi = __builtin_amdgcn_readfirstlane(xi); tp.nx = __builtin_amdgcn_readfirstlane(nx > 0 ? nx : 1); tp.rank = __builtin_amdgcn_readfirstlane((int)bst[2]); tp.nloc = __builtin_amdgcn_readfirstlane(nloc);
    }
#endif
    if (IN(9)) { peer_u_phase(p, tp, lane, wave); PHASE_END(9); PMARK(9); }
    if (IN(10)) { peer_w_phase(p, gw, NGW, lane); PHASE_END(10); PMARK(10); }
    if (IN(11)) { peer_v_phase(p, tp, lane, wave); PHASE_END(11); PMARK(11); }
    if (IN(12)) { final_phase(p, p.out, gw, NGW, lane); }
#if MK_PROF_PHASE >= 0
    if (blockIdx.x == 0 && threadIdx.x < 64) { const unsigned long long t0_ = __builtin_amdgcn_s_memrealtime(), d_ = pdt_ * MK_PROF_MULT; while (__builtin_amdgcn_s_memrealtime() - t0_ < d_) __builtin_amdgcn_s_sleep(8); }
#endif
#undef IN
#undef PHASE_END
}

extern "C" void kernel_launch(void* const* d_in, const int* in_sizes, int n_in, void* d_out, int out_size, void* d_ws, size_t ws_size, hipStream_t stream) {
    static int grid = 0;
    if (grid == 0) {
        if (n_in != 16 || in_sizes[0] != TOK * DM || out_size != TOK * DM || ws_size < WS_END) {
            fprintf(stderr, "kernel_launch: unexpected shapes (n_in %d, in0 %d, out %d, ws %zu)\n", n_in, n_in > 0 ? in_sizes[0] : -1, out_size, ws_size); grid = -1; return; }
        int dev = 0, cus = 0, per_cu = 0;
        if (hipGetDevice(&dev) != hipSuccess || hipDeviceGetAttribute(&cus, hipDeviceAttributeMultiprocessorCount, dev) != hipSuccess) { grid = -1; return; }
        if (hipFuncSetAttribute((const void*)mk_fwd, hipFuncAttributeMaxDynamicSharedMemorySize, LDS_BYTES) != hipSuccess) { fprintf(stderr, "kernel_launch: hipFuncSetAttribute failed\n"); grid = -1; return; }
        if (hipOccupancyMaxActiveBlocksPerMultiprocessor(&per_cu, (const void*)mk_fwd, 512, LDS_BYTES) != hipSuccess || per_cu < 1) { fprintf(stderr, "kernel_launch: occupancy query says %d blocks per CU\n", per_cu); per_cu = 1; }
        (void)hipGetLastError();
        grid = cus;
        if (grid > 2048) { fprintf(stderr, "kernel_launch: %d CUs: the attention phase's table-conversion schedule assumes at most 2048 workgroups\n", grid); grid = -1; return; }
    }
    if (grid < 0) return;
    Params p{};
    p.x = (const float*)d_in[0]; p.c = (const float*)d_in[1]; p.ada_w = (const float*)d_in[2]; p.ada_b = (const float*)d_in[3]; p.norm1_g = (const float*)d_in[4];
    p.w_in = (const float*)d_in[5]; p.na_rpb = (const float*)d_in[6]; p.ong_na = (const float*)d_in[7]; p.ong_dil = (const float*)d_in[8]; p.w_out = (const float*)d_in[9];
    p.norm2_g = (const float*)d_in[10]; p.peer_wq = (const float*)d_in[11]; p.peer_sk = (const float*)d_in[12]; p.peer_u = (const float*)d_in[13]; p.peer_v = (const float*)d_in[14];
    p.final_g = (const float*)d_in[15]; p.out = (float*)d_out; p.ws = (unsigned char*)d_ws;
#if MK_COOP
    if (hipMemsetAsync((char*)d_ws + WS_CTL, 0, 65536, stream) != hipSuccess) { fprintf(stderr, "kernel_launch: memset of the barrier words failed\n"); return; }
    p.ph_lo = 0; p.ph_hi = NPHASE;
    void* args[] = {&p};
    const hipError_t e = hipLaunchCooperativeKernel((const void*)mk_fwd, dim3(grid), dim3(512), args, LDS_BYTES, stream);
    if (e != hipSuccess) fprintf(stderr, "kernel_launch: cooperative launch failed: %s (grid %d)\n", hipGetErrorString(e), grid);
#else
    for (int k = 0; k < NPHASE; ++k) { p.ph_lo = k; p.ph_hi = k + 1; hipLaunchKernelGGL(mk_fwd, dim3(grid), dim3(512), LDS_BYTES, stream, p); }
#endif
}
```

```cpp
#include <hip/hip_runtime.h>
#include <cstdio>
#include <cstdint>

#ifndef MK_COOP
#define MK_COOP 1
#endif

constexpr int DM = 1024, BATCH = 16, SEQ = 2048, TOK = BATCH * SEQ;
constexpr int NQKV = 3072, NPQ = 2048, NEXP = 16384;
constexpr float EPS = 1e-6f;
constexpr float LOG2E = 1.4426950408889634f;
constexpr float QSCALE = 0.125f * LOG2E;

constexpr size_t MiB = 1u << 20;
constexpr size_t WS_CTL = 0;
constexpr size_t WS_MOD = 1 * MiB;
constexpr size_t WS_WIN = 2 * MiB;
constexpr size_t WS_WOUT = 8 * MiB;
constexpr size_t WS_WSC = 10 * MiB;
constexpr size_t WS_SU = 14 * MiB;
constexpr size_t WS_SV = 14 * MiB + 65536;
constexpr size_t WS_UH = 16 * MiB;
constexpr size_t WS_VH = 48 * MiB;
constexpr size_t WS_H = 80 * MiB;
constexpr size_t WS_QKV = 144 * MiB;
constexpr size_t WS_ONA = 336 * MiB;
constexpr size_t WS_OD = 368 * MiB;
constexpr size_t WS_LSE = 464 * MiB;
constexpr size_t WS_IDS = 468 * MiB;
constexpr size_t WS_GATES = 484 * MiB;
constexpr size_t WS_SC = 144 * MiB;
constexpr size_t WS_PART = 144 * MiB;
constexpr size_t WS_PEER = 272 * MiB;
constexpr size_t WS_Z = 336 * MiB;
constexpr size_t WS_H8 = 400 * MiB;
constexpr size_t WS_W8 = 432 * MiB;
constexpr size_t WS_SH = 436 * MiB;
constexpr size_t WS_SW = 437 * MiB;
constexpr size_t WS_W8SC = 478 * MiB;
constexpr size_t WS_SWN = 480 * MiB;
constexpr size_t WS_END = 500 * MiB;

constexpr int LDS_BYTES = 147456;

#define LAS __attribute__((address_space(3)))
typedef unsigned short bf16_t;
typedef short bf16x8 __attribute__((ext_vector_type(8)));
typedef float f32x4 __attribute__((ext_vector_type(4)));
typedef unsigned u32x4 __attribute__((ext_vector_type(4)));
typedef unsigned u32x2 __attribute__((ext_vector_type(2)));
typedef float f32x2_t __attribute__((ext_vector_type(2)));
typedef __bf16 bf16x2_t __attribute__((ext_vector_type(2)));
typedef _Float16 h2_t __attribute__((ext_vector_type(2)));
typedef short v4i16_t __attribute__((ext_vector_type(4)));

__device__ __forceinline__ unsigned pkbf(float lo, float hi) { f32x2_t v = {lo, hi}; bf16x2_t b = __builtin_convertvector(v, bf16x2_t); return __builtin_bit_cast(unsigned, b); }
__device__ __forceinline__ unsigned pkh(float lo, float hi) { h2_t h = {(_Float16)lo, (_Float16)hi}; return __builtin_bit_cast(unsigned, h); }
__device__ __forceinline__ float bf_lo(unsigned u) { return __uint_as_float(u << 16); }
__device__ __forceinline__ float bf_hi(unsigned u) { return __uint_as_float(u & 0xffff0000u); }
__device__ __forceinline__ float wave_sum(float v) {
#pragma unroll
    for (int o = 1; o < 64; o <<= 1) v += __shfl_xor(v, o);
    return v;
}

#define XB_TMO      128
#define XB_XCNT(j)  (256  + 64 * (j))
#define XB_XSUB(j)  (1280 + 64 * (j))
#define XB_XGEN(j)  (2304 + 64 * (j))
#define XB_TOP      3328
#define XB_TOPGEN   3392
#define XCD_BAR_WORDS 3456
#define XB_SPIN_CAP (1u << 18)

__device__ __forceinline__ unsigned xb_ld(unsigned* p)              { return __hip_atomic_load(p, __ATOMIC_RELAXED, __HIP_MEMORY_SCOPE_AGENT); }
__device__ __forceinline__ unsigned xb_add(unsigned* p, unsigned v) { return __hip_atomic_fetch_add(p, v, __ATOMIC_RELAXED, __HIP_MEMORY_SCOPE_AGENT); }
__device__ __forceinline__ unsigned xb_xcc_id() { return (unsigned)__builtin_amdgcn_s_getreg((3 << 11) | 20) & 0xFu; }
#define XB_SPIN(cond, bar) do { unsigned _sp = 0; while (cond) { __builtin_amdgcn_s_sleep(1); \
    if ((++_sp & 255u) == 0u) { if (xb_ld(&(bar)[XB_TMO])) break; if (_sp > XB_SPIN_CAP) { atomicAdd(&(bar)[XB_TMO], 1u); break; } } } } while (0)

struct XcdBarrier {
    unsigned* bar; unsigned x;
    volatile LAS unsigned* st;
};

__device__ __forceinline__ XcdBarrier xcd_barrier_post(unsigned* bar, volatile LAS unsigned* st) {
    XcdBarrier b; b.bar = bar; b.x = xb_xcc_id(); b.st = st;
    if (threadIdx.x == 0) (void)xb_add(&bar[XB_XCNT(b.x)], 1u);
    return b;
}
__device__ __forceinline__ void xcd_barrier_complete(unsigned* bar, unsigned x, unsigned& nloc, unsigned& nx) {
    const unsigned G = gridDim.x * gridDim.y * gridDim.z;
    unsigned sum, cnt, mine, sp = 0u;
    for (;;) {
        sum = 0u; cnt = 0u; mine = 0u;
#pragma unroll
        for (unsigned j = 0; j < 16; ++j) { const unsigned c = xb_ld(&bar[XB_XCNT(j)]); sum += c; cnt += (c > 0u) ? 1u : 0u; mine = (j == x) ? c : mine; }
        if (sum == G) break;
        __builtin_amdgcn_s_sleep(1);
        if ((++sp & 255u) == 0u) { if (xb_ld(&bar[XB_TMO])) break; if (sp > XB_SPIN_CAP) { atomicAdd(&bar[XB_TMO], 1u); break; } }
    }
    nloc = mine > 0u ? mine : 1u; nx = cnt > 0u ? cnt : 1u;
}

__device__ __forceinline__ void xcd_barrier(const XcdBarrier& b) {
    asm volatile("s_waitcnt vmcnt(0)" ::: "memory");
    __syncthreads();
    if (threadIdx.x == 0) {
        unsigned* bar = b.bar;
        __builtin_amdgcn_s_waitcnt(0);
        unsigned nloc = b.st[0], nx = b.st[1];
        if (nloc == 0u) { xcd_barrier_complete(bar, b.x, nloc, nx); b.st[0] = nloc; b.st[1] = nx; }
        const unsigned old = xb_add(&bar[XB_XSUB(b.x)], 1u);
        const unsigned gen = old / nloc;
        if (old + 1u == (gen + 1u) * nloc) {
            __builtin_amdgcn_fence(__ATOMIC_RELEASE, "agent");
            asm volatile("s_waitcnt vmcnt(0)" ::: "memory");
            const unsigned og = xb_add(&bar[XB_TOP], 1u);
            const unsigned tg = og / nx;
            if (og + 1u == (tg + 1u) * nx) xb_add(&bar[XB_TOPGEN], 1u);
            else XB_SPIN(xb_ld(&bar[XB_TOPGEN]) == tg, bar);
            __builtin_amdgcn_fence(__ATOMIC_ACQUIRE, "agent");
            xb_add(&bar[XB_XGEN(b.x)], 1u);
            asm volatile("s_waitcnt vmcnt(0)" ::: "memory");
        } else {
            XB_SPIN(xb_ld(&bar[XB_XGEN(b.x)]) == gen, bar);
            __builtin_amdgcn_fence(__ATOMIC_ACQUIRE, "agent");
            asm volatile("s_waitcnt vmcnt(0)" ::: "memory");
        }
    }
    __syncthreads();
}

namespace pg8 {
#define PG8_LAS __attribute__((address_space(3)))
typedef unsigned short bf16_t;
typedef short bf16x8 __attribute__((ext_vector_type(8)));
typedef float f32x4 __attribute__((ext_vector_type(4)));
typedef unsigned u32x4 __attribute__((ext_vector_type(4)));
typedef int i32x4 __attribute__((ext_vector_type(4)));
constexpr int BM = 256, BK = 64, HALF = 128, HTB = HALF * BK * 2  , STAGE_BYTES = 8 * HTB, NXCD = 8, WGM = 8;

__host__ __device__ __forceinline__ int lds_byte(int r, int c) { const int st = (r >> 4) * 2 + (c >> 5), rr = r & 15, cc = c & 31, ob = rr * 64 + cc * 2; return st * 1024 + (ob ^ (((ob >> 9) & 1) << 5)); }
__host__ __device__ __forceinline__ void stage_rc(int b, int& R, int& C) { const int st = b / 1024, sb = b % 1024, swz = sb ^ (((sb >> 9) & 1) << 5); R = (st >> 1) * 16 + swz / 64; C = (st & 1) * 32 + (swz % 64) / 2; }
__host__ __device__ __forceinline__ int perm32(int rho) { const int n = rho >> 4, i = rho & 15; return 8 * (i >> 2) + 4 * n + (i & 3); }

struct Unit { int pm, pn; };
struct Gemm { const bf16_t* A; const bf16_t* Bt; int M, N, K; };

struct StaticOrder {
    int nM, nN, nwg, G, c;
    __host__ __device__ void init(int M, int N, int G_, int c_) { nM = M / BM; nN = N / BM; nwg = nM * nN; G = G_; c = c_; }
    __host__ __device__ bool next(int i, Unit& u) const {
        const long L = (long)i * G + c; if (L >= nwg) return false;
        int wgid = (int)L; { const int q = nwg / NXCD, r = nwg % NXCD, xcd = wgid % NXCD, off = wgid / NXCD; wgid = (xcd < r ? xcd * (q + 1) : r * (q + 1) + (xcd - r) * q) + off; }
        const int nig = WGM * nN, gid = wgid / nig, fm = gid * WGM, gsz = (nM - fm) < WGM ? (nM - fm) : WGM;
        u.pm = fm + ((wgid % nig) % gsz); u.pn = (wgid % nig) / gsz; return true;
    }
    __device__ __forceinline__ void a_ready(const Unit&) const {}
    __device__ __forceinline__ void done(const Unit&) const {}
};


__device__ __forceinline__ unsigned cvt_pk_bf16(float lo, float hi) { unsigned r; asm volatile("v_cvt_pk_bf16_f32 %0, %1, %2" : "=v"(r) : "v"(lo), "v"(hi)); return r; }

__device__ __forceinline__ __amdgpu_buffer_rsrc_t wt_rsrc(void* base) { return __builtin_amdgcn_make_buffer_rsrc(base, 0, 0x7fffffff, 0x00020000); }
__device__ __forceinline__ void wt_store16(__amdgpu_buffer_rsrc_t r, size_t byte_off, u32x4 v) { __builtin_amdgcn_raw_buffer_store_b128(v, r, (unsigned)byte_off, 0, 16); }
struct EpiQKV {
    static constexpr bool PERM = true, AFTER_DRAIN = false;
    bf16_t* O; int ldc; float qscale;
    __device__ __forceinline__ void operator()(const f32x4 (&acc)[2][2][4][2], const Unit& u, int wr, int wc, int fr, int fq) const {
        const int bb = u.pm >> 3, s0 = (u.pm & 7) * BM + wr * 64 + fr, slot0 = 4 * u.pn + (wc >> 1), d0 = (wc & 1) * 32 + 8 * fq;
        const float sc = (u.pn < 2 || u.pn == 6 || u.pn == 7) ? qscale : 1.f;
        const __amdgpu_buffer_rsrc_t rs_ = wt_rsrc(O);
#pragma unroll
        for (int bj = 0; bj < 2; ++bj) { const size_t hp = ((((size_t)bb * 48 + slot0 + 2 * bj) * 2048 + s0) * 64 + d0) * 2;
#pragma unroll
            for (int ai = 0; ai < 2; ++ai)
#pragma unroll
                for (int m = 0; m < 4; ++m) { const f32x4 v0 = acc[ai][bj][m][0] * sc, v1 = acc[ai][bj][m][1] * sc;
                    u32x4 w; w.x = cvt_pk_bf16(v0[0], v0[1]); w.y = cvt_pk_bf16(v0[2], v0[3]); w.z = cvt_pk_bf16(v1[0], v1[1]); w.w = cvt_pk_bf16(v1[2], v1[3]);
                    wt_store16(rs_, hp + (size_t)(ai * HALF + m * 16) * 128, w); } }
    }
};
struct EpiZ {
    static constexpr bool PERM = true, AFTER_DRAIN = false;
    bf16_t* Z; const float* mod;
    __device__ __forceinline__ void operator()(const f32x4 (&acc)[2][2][4][2], const Unit& u, int wr, int wc, int fr, int fq) const {
        const int row0 = u.pm * BM + wr * 64 + fr, col0 = u.pn * BM + wc * 32 + 8 * fq;
        const float* g1 = mod + (size_t)(u.pm >> 3) * 6144 + 2048 + col0;
        const __amdgpu_buffer_rsrc_t rs_ = wt_rsrc(Z);
        f32x4 gv[2][2];
#pragma unroll
        for (int bj = 0; bj < 2; ++bj)
#pragma unroll
            for (int n = 0; n < 2; ++n) gv[bj][n] = *(const f32x4*)(g1 + bj * HALF + 4 * n);
#pragma unroll
        for (int ai = 0; ai < 2; ++ai)
#pragma unroll
            for (int m = 0; m < 4; ++m) { const size_t off = (size_t)(row0 + ai * HALF + m * 16) * 1024 + col0;
#pragma unroll
                for (int bj = 0; bj < 2; ++bj) { const f32x4 v0 = acc[ai][bj][m][0] * gv[bj][0], v1 = acc[ai][bj][m][1] * gv[bj][1];
                    u32x4 w; w.x = cvt_pk_bf16(v0[0], v0[1]); w.y = cvt_pk_bf16(v0[2], v0[3]); w.z = cvt_pk_bf16(v1[0], v1[1]); w.w = cvt_pk_bf16(v1[2], v1[3]);
                    wt_store16(rs_, (off + bj * HALF) * 2, w); } }
    }
};
struct EpiSC {
    static constexpr bool PERM = true, AFTER_DRAIN = false;
    _Float16* O; int ldc;
    __device__ __forceinline__ void operator()(const f32x4 (&acc)[2][2][4][2], const Unit& u, int wr, int wc, int fr, int fq) const {
        const int row0 = u.pm * BM + wr * 64 + fr, col0 = u.pn * BM + wc * 32 + 8 * fq;
        const __amdgpu_buffer_rsrc_t rs_ = wt_rsrc(O);
#pragma unroll
        for (int ai = 0; ai < 2; ++ai)
#pragma unroll
            for (int m = 0; m < 4; ++m) { const size_t rowp = ((size_t)(row0 + ai * HALF + m * 16) * ldc + col0) * 2;
#pragma unroll
                for (int bj = 0; bj < 2; ++bj) { const f32x4 v0 = acc[ai][bj][m][0], v1 = acc[ai][bj][m][1];
                    u32x4 w; w.x = pkh(v0[0], v0[1]); w.y = pkh(v0[2], v0[3]); w.z = pkh(v1[0], v1[1]); w.w = pkh(v1[2], v1[3]);
                    wt_store16(rs_, rowp + bj * HALF * 2, w); } }
    }
};
struct EpiSC8 {
    static constexpr bool PERM = true, AFTER_DRAIN = false;
    _Float16* O; int ldc; const float* sh; const float* swn;
    __device__ __forceinline__ void operator()(const f32x4 (&acc)[2][2][4][2], const Unit& u, int wr, int wc, int fr, int fq) const {
        const int row0 = u.pm * BM + wr * 64 + fr, col0 = u.pn * BM + wc * 32 + 8 * fq;
        const __amdgpu_buffer_rsrc_t rs_ = wt_rsrc(O);
        f32x4 cs[2][2];
#pragma unroll
        for (int bj = 0; bj < 2; ++bj)
#pragma unroll
            for (int n = 0; n < 2; ++n) cs[bj][n] = *(const f32x4*)(swn + col0 + bj * HALF + 4 * n);
#pragma unroll
        for (int ai = 0; ai < 2; ++ai)
#pragma unroll
            for (int m = 0; m < 4; ++m) { const int row = row0 + ai * HALF + m * 16; const float rsc = sh[row]; const size_t rowp = ((size_t)row * ldc + col0) * 2;
#pragma unroll
                for (int bj = 0; bj < 2; ++bj) { const i32x4 i0 = __builtin_bit_cast(i32x4, acc[ai][bj][m][0]), i1 = __builtin_bit_cast(i32x4, acc[ai][bj][m][1]);
                    const f32x4 v0 = (f32x4){(float)i0[0], (float)i0[1], (float)i0[2], (float)i0[3]} * rsc * cs[bj][0], v1 = (f32x4){(float)i1[0], (float)i1[1], (float)i1[2], (float)i1[3]} * rsc * cs[bj][1];
                    u32x4 w; w.x = pkh(v0[0], v0[1]); w.y = pkh(v0[2], v0[3]); w.z = pkh(v1[0], v1[1]); w.w = pkh(v1[2], v1[3]);
                    wt_store16(rs_, rowp + bj * HALF * 2, w); } }
    }
};

template <class Epi, class Sched, bool ALIGN_EPI = false, bool SP2 = false, bool I8 = false>
__device__ __forceinline__ void gemm_phase(PG8_LAS unsigned char* lds, const Gemm g, const Sched& S, const Epi& E) {
    const int tid = threadIdx.x, wid = __builtin_amdgcn_readfirstlane(tid >> 6), lane = tid & 63, wr = wid >> 2, wc = wid & 3, fr = lane & 15, fq = lane >> 4;
    const int K = g.K, rowb = K * (I8 ? 1 : 2)  , nt = rowb / (BK * 2);
    unsigned voffA[2], voffB[2];
#pragma unroll
    for (int i = 0; i < 2; ++i) { int R, C; stage_rc(tid * 16 + i * 8192, R, C); const int Rb = Epi::PERM ? ((R & ~31) + perm32(R & 31)) : R;
        voffA[i] = (unsigned)(R * rowb + C * 2); voffB[i] = (unsigned)(Rb * rowb + C * 2); }
    const size_t kstep = (size_t)(BK * 2);
    const size_t hstep = (size_t)HALF * rowb;
    const size_t tstep = 2 * hstep;
    const unsigned ldsw = (unsigned)wid * 1024u;
    const int aoff = lds_byte(wr * 64 + fr, fq * 8), boff = lds_byte(wc * 32 + fr, fq * 8);
#define PG8_SA(b, h) (((b) * 2 + (h)) * HTB)
#define PG8_SB(b, h) ((4 + (b) * 2 + (h)) * HTB)
#define PG8_STAGE(bufoff, gbase, voff) do { _Pragma("unroll") for (int _i = 0; _i < 2; ++_i) \
        __builtin_amdgcn_global_load_lds((const unsigned*)((const char*)(gbase) + (voff)[_i]), (PG8_LAS unsigned*)(lds + (bufoff) + ldsw + _i * 8192), 16, 0, 0); } while (0)
#define PG8_LDA(dst, b, h) do { _Pragma("unroll") for (int m = 0; m < 4; ++m) _Pragma("unroll") for (int k = 0; k < 2; ++k) dst[m][k] = *(const PG8_LAS bf16x8*)(lds + PG8_SA(b, h) + aoff + m * 2048 + k * 1024); } while (0)
#define PG8_LDB(dst, b, h) do { _Pragma("unroll") for (int n = 0; n < 2; ++n) _Pragma("unroll") for (int k = 0; k < 2; ++k) dst[n][k] = *(const PG8_LAS bf16x8*)(lds + PG8_SB(b, h) + boff + n * 2048 + k * 1024); } while (0)
#define PG8_MMA(ai, bj, At, Bt) do { __builtin_amdgcn_s_setprio(1); _Pragma("unroll") for (int m = 0; m < 4; ++m) _Pragma("unroll") for (int n = 0; n < 2; ++n) _Pragma("unroll") for (int k = 0; k < 2; ++k) \
        { if constexpr (I8) acc[ai][bj][m][n] = __builtin_bit_cast(f32x4, __builtin_amdgcn_mfma_i32_16x16x64_i8(__builtin_bit_cast(i32x4, Bt[n][k]), __builtin_bit_cast(i32x4, At[m][k]), __builtin_bit_cast(i32x4, acc[ai][bj][m][n]), 0, 0, 0)); \
          else acc[ai][bj][m][n] = __builtin_amdgcn_mfma_f32_16x16x32_bf16(Bt[n][k], At[m][k], acc[ai][bj][m][n], 0, 0, 0); } __builtin_amdgcn_s_setprio(0); } while (0)
#define PG8_WAIT_V(n) asm volatile("s_waitcnt vmcnt(" #n ")" ::: "memory")
#define PG8_WAIT_L(n) asm volatile("s_waitcnt lgkmcnt(" #n ")" ::: "memory")
#define PG8_BAR __builtin_amdgcn_s_barrier()
#define PG8_SCHED __builtin_amdgcn_sched_barrier(0)
    Unit cur, nxt; int ui = 0;
    if (!S.next(0, cur)) return;
    f32x4 acc[2][2][4][2];
#pragma unroll
    for (int a = 0; a < 2; ++a)
#pragma unroll
        for (int b = 0; b < 2; ++b)
#pragma unroll
            for (int m = 0; m < 4; ++m)
#pragma unroll
                for (int n = 0; n < 2; ++n) acc[a][b][m][n] = (f32x4){0.f, 0.f, 0.f, 0.f};
    bf16x8 At[4][2], B0[2][2], B1[2][2];
    const char* cA = (const char*)g.A + (size_t)cur.pm * tstep; const char* cB = (const char*)g.Bt + (size_t)cur.pn * tstep;
    S.a_ready(cur);
    if constexpr (SP2) {
        PG8_STAGE(PG8_SB(0, 0), cB, voffB); PG8_STAGE(PG8_SB(0, 1), cB + hstep, voffB); PG8_STAGE(PG8_SA(0, 0), cA, voffA); PG8_STAGE(PG8_SA(0, 1), cA + hstep, voffA);
        if (wr == 1) PG8_BAR;
        PG8_WAIT_V(2); PG8_BAR;
        PG8_STAGE(PG8_SB(1, 0), cB + kstep, voffB); PG8_STAGE(PG8_SA(1, 0), cA + kstep, voffA); PG8_STAGE(PG8_SB(1, 1), cB + hstep + kstep, voffB);
        PG8_WAIT_V(6); PG8_BAR;
    } else {
        PG8_STAGE(PG8_SB(0, 0), cB, voffB); PG8_STAGE(PG8_SA(0, 0), cA, voffA); PG8_STAGE(PG8_SB(0, 1), cB + hstep, voffB); PG8_STAGE(PG8_SA(0, 1), cA + hstep, voffA);
        if (wr == 1) PG8_BAR;
        PG8_WAIT_V(4); PG8_BAR;
        PG8_STAGE(PG8_SB(1, 0), cB + kstep, voffB); PG8_STAGE(PG8_SA(1, 0), cA + kstep, voffA); PG8_STAGE(PG8_SB(1, 1), cB + hstep + kstep, voffB);
        PG8_WAIT_V(6); PG8_BAR;
    }
    for (;;) {
        const bool has_next = S.next(ui + 1, nxt);
        const char* nA = has_next ? (const char*)g.A + (size_t)nxt.pm * tstep : cA; const char* nB = has_next ? (const char*)g.Bt + (size_t)nxt.pn * tstep : cB;
        for (int t = 0; t < nt; t += 2) {
            const bool last = (t == nt - 2);
            const char* a1 = cA + (size_t)(t + 1) * kstep;
            const char* a2 = last ? nA : cA + (size_t)(t + 2) * kstep; const char* b2 = last ? nB : cB + (size_t)(t + 2) * kstep;
            const char* a3 = a2 + kstep; const char* b3 = b2 + kstep;
            if (last && has_next) S.a_ready(nxt);
            if constexpr (SP2) {
            PG8_LDB(B0, 0, 0); PG8_LDB(B1, 0, 1); PG8_SCHED; PG8_LDA(At, 0, 0); PG8_STAGE(PG8_SA(1, 1), a1 + hstep, voffA);
            PG8_WAIT_V(8); PG8_WAIT_L(0); PG8_BAR; PG8_MMA(0, 0, At, B0); PG8_MMA(0, 1, At, B1); PG8_BAR; PG8_SCHED;
            PG8_LDA(At, 0, 1); PG8_STAGE(PG8_SB(0, 0), b2, voffB); PG8_STAGE(PG8_SB(0, 1), b2 + hstep, voffB); PG8_STAGE(PG8_SA(0, 0), a2, voffA);
            PG8_WAIT_V(8); PG8_WAIT_L(0); PG8_BAR; PG8_MMA(1, 0, At, B0); PG8_MMA(1, 1, At, B1); PG8_BAR; PG8_SCHED;
            PG8_LDB(B0, 1, 0); PG8_LDB(B1, 1, 1); PG8_SCHED; PG8_LDA(At, 1, 0); PG8_STAGE(PG8_SA(0, 1), a2 + hstep, voffA);
            PG8_WAIT_V(8); PG8_WAIT_L(0); PG8_BAR; PG8_MMA(0, 0, At, B0); PG8_MMA(0, 1, At, B1); PG8_BAR; PG8_SCHED;
            PG8_LDA(At, 1, 1); PG8_STAGE(PG8_SB(1, 0), b3, voffB); PG8_STAGE(PG8_SB(1, 1), b3 + hstep, voffB); PG8_STAGE(PG8_SA(1, 0), a3, voffA);
            PG8_WAIT_V(8); PG8_WAIT_L(0); PG8_BAR; PG8_MMA(1, 0, At, B0); PG8_MMA(1, 1, At, B1); PG8_BAR; PG8_SCHED;
            } else {
            PG8_LDB(B0, 0, 0); PG8_SCHED; PG8_LDA(At, 0, 0); PG8_STAGE(PG8_SA(1, 1), a1 + hstep, voffA);
            PG8_WAIT_L(8); PG8_BAR; PG8_WAIT_L(0); PG8_MMA(0, 0, At, B0); PG8_BAR; PG8_SCHED;
            PG8_LDB(B1, 0, 1); PG8_STAGE(PG8_SB(0, 0), b2, voffB);
            PG8_BAR; PG8_WAIT_L(0); PG8_MMA(0, 1, At, B1); PG8_BAR;
            PG8_LDA(At, 0, 1); PG8_STAGE(PG8_SA(0, 0), a2, voffA);
            PG8_BAR; PG8_WAIT_L(0); PG8_MMA(1, 0, At, B0); PG8_BAR; PG8_SCHED;
            PG8_STAGE(PG8_SB(0, 1), b2 + hstep, voffB);
            PG8_WAIT_V(6); PG8_BAR; PG8_MMA(1, 1, At, B1); PG8_BAR;
            PG8_LDB(B0, 1, 0); PG8_SCHED; PG8_LDA(At, 1, 0); PG8_STAGE(PG8_SA(0, 1), a2 + hstep, voffA);
            PG8_WAIT_L(8); PG8_BAR; PG8_WAIT_L(0); PG8_MMA(0, 0, At, B0); PG8_BAR; PG8_SCHED;
            PG8_LDB(B1, 1, 1); PG8_STAGE(PG8_SB(1, 0), b3, voffB);
            PG8_BAR; PG8_WAIT_L(0); PG8_MMA(0, 1, At, B1); PG8_BAR;
            PG8_LDA(At, 1, 1); PG8_STAGE(PG8_SA(1, 0), a3, voffA);
            PG8_BAR; PG8_WAIT_L(0); PG8_MMA(1, 0, At, B0); PG8_BAR; PG8_SCHED;
            PG8_STAGE(PG8_SB(1, 1), b3 + hstep, voffB);
            PG8_WAIT_V(6); PG8_BAR; PG8_MMA(1, 1, At, B1); PG8_BAR;
            }
        }
        if constexpr (ALIGN_EPI) { if (wr == 0) PG8_BAR; }
        if constexpr (!Epi::AFTER_DRAIN) { E(acc, cur, wr, wc, fr, fq); S.done(cur); }
        if (!has_next) break;
#pragma unroll
        for (int a = 0; a < 2; ++a)
#pragma unroll
            for (int b = 0; b < 2; ++b)
#pragma unroll
                for (int m = 0; m < 4; ++m)
#pragma unroll
                    for (int n = 0; n < 2; ++n) acc[a][b][m][n] = (f32x4){0.f, 0.f, 0.f, 0.f};
        cur = nxt; cA = nA; cB = nB; ++ui;
        if constexpr (ALIGN_EPI) { if (wr == 1) PG8_BAR; }
    }
    PG8_WAIT_V(0);
    if constexpr (!ALIGN_EPI) { if (wr == 0) PG8_BAR; }
    PG8_BAR;
    if constexpr (Epi::AFTER_DRAIN) { E.fused(acc, cur, wr, wc, fr, fq, lds, wid, lane); S.done(cur); }
#undef PG8_SA
#undef PG8_SB
#undef PG8_STAGE
#undef PG8_LDA
#undef PG8_LDB
#undef PG8_MMA
#undef PG8_WAIT_V
#undef PG8_WAIT_L
#undef PG8_BAR
#undef PG8_SCHED
}
}

struct Params {
    const float *x, *c, *ada_w, *ada_b, *norm1_g, *w_in, *na_rpb, *ong_na, *ong_dil, *w_out, *norm2_g, *peer_wq, *peer_sk, *peer_u, *peer_v, *final_g;
    float* out; unsigned char* ws; int ph_lo, ph_hi;
};
constexpr int NPHASE = 13;

__device__ __forceinline__ void p0_mod(const Params& p, LAS unsigned char* lds, int tid, int lane, int wave) {
    LAS float* s = (LAS float*)lds;
    LAS float* red = (LAS float*)(lds + 65536);
    for (int idx = tid; idx < 16 * 1024; idx += 512) { const int b = idx >> 10, k = idx & 1023; const float cv = p.c[idx]; s[k * 16 + b] = cv / (1.f + __expf(-cv)); }
    __syncthreads();
    float* mod = (float*)(p.ws + WS_MOD);
    for (int it = blockIdx.x; it < 256; it += gridDim.x) {
        const int j0 = it * 24, c = lane & 31, kq = lane >> 5; const bool act = c < 24;
        float acc[16];
#pragma unroll
        for (int b = 0; b < 16; ++b) acc[b] = 0.f;
        const float* wp = p.ada_w + (size_t)(wave * 128 + kq) * 6144 + j0 + (act ? c : 0);
#pragma unroll 4
        for (int i = 0; i < 64; ++i) {
            const int k = wave * 128 + 2 * i + kq;
            const float wv = act ? __builtin_nontemporal_load(wp + (size_t)i * 2 * 6144) : 0.f;
            const LAS f32x4* sp = (const LAS f32x4*)(s + k * 16);
            const f32x4 s0 = sp[0], s1 = sp[1], s2 = sp[2], s3 = sp[3];
#pragma unroll
            for (int e = 0; e < 4; ++e) { acc[e] += s0[e] * wv; acc[4 + e] += s1[e] * wv; acc[8 + e] += s2[e] * wv; acc[12 + e] += s3[e] * wv; }
        }
#pragma unroll
        for (int b = 0; b < 16; ++b) red[((wave * 2 + kq) * 16 + b) * 32 + c] = acc[b];
        __syncthreads();
        if (tid < 384) { const int b = tid / 24, cc = tid - b * 24; float sum = p.ada_b[j0 + cc];
#pragma unroll
            for (int pp = 0; pp < 16; ++pp) sum += red[(pp * 16 + b) * 32 + cc];
            mod[(size_t)b * 6144 + j0 + cc] = sum; }
        __syncthreads();
    }
}
__device__ __forceinline__ void p0_wsc(const Params& p, LAS unsigned char* lds, int tid) {
    LAS float* wq_s = (LAS float*)lds;
    LAS float* sk_s = (LAS float*)(lds + 32768);
    bf16_t* WscT = (bf16_t*)(p.ws + WS_WSC);
    for (int it = blockIdx.x; it < 256; it += gridDim.x) {
        const int hp = it >> 4, kc = it & 15, pp = hp & 1, k0 = kc * 64;
        for (int i = tid; i < 2048; i += 512) { const int r = i >> 5, c4 = i & 31; *(LAS f32x4*)(wq_s + r * 128 + c4 * 4) = *(const f32x4*)(p.peer_wq + (size_t)(k0 + r) * 2048 + hp * 128 + c4 * 4); }
        for (int i = tid; i < 4096; i += 512) { const int r = i >> 5, c4 = i & 31; *(LAS f32x4*)(sk_s + r * 132 + c4 * 4) = *(const f32x4*)(p.peer_sk + (size_t)pp * 16384 + r * 128 + c4 * 4); }
        __syncthreads();
        const int n = tid & 127, kg = tid >> 7;
        float acc[16];
#pragma unroll
        for (int i = 0; i < 16; ++i) acc[i] = 0.f;
        for (int d = 0; d < 128; d += 4) {
            const f32x4 sv = *(const LAS f32x4*)(sk_s + n * 132 + d);
#pragma unroll
            for (int i = 0; i < 16; ++i) { const f32x4 wv = *(const LAS f32x4*)(wq_s + (kg * 16 + i) * 128 + d); acc[i] += (wv[0] * sv[0] + wv[1] * sv[1]) + (wv[2] * sv[2] + wv[3] * sv[3]); }
        }
        bf16_t* op = WscT + (size_t)(hp * 128 + n) * 1024 + k0 + kg * 16;
        u32x4 w0, w1;
        w0.x = pkbf(acc[0], acc[1]); w0.y = pkbf(acc[2], acc[3]); w0.z = pkbf(acc[4], acc[5]); w0.w = pkbf(acc[6], acc[7]);
        w1.x = pkbf(acc[8], acc[9]); w1.y = pkbf(acc[10], acc[11]); w1.z = pkbf(acc[12], acc[13]); w1.w = pkbf(acc[14], acc[15]);
        *(u32x4*)op = w0; *(u32x4*)(op + 8) = w1;
        __syncthreads();
    }
}
__device__ __forceinline__ void p0_transpose_item(const float* W, int K, int N, bf16_t* WT, const float* ks0, const float* ks1, LAS float* scr, int item, int lane) {
    const int nblk = N / 32, kb = item / nblk, nb = item % nblk, k0 = 64 * kb, n0 = 32 * nb;
#pragma unroll 8
    for (int i = 0; i < 32; ++i) { const int kk = 2 * i + (lane >> 5), kabs = k0 + kk;
        const float sc = ks0 ? (kabs < 512 ? ks0[kabs] : ks1[kabs - 512]) : 1.f;
        scr[kk * 33 + (lane & 31)] = W[(size_t)kabs * N + n0 + (lane & 31)] * sc; }
    asm volatile("s_waitcnt lgkmcnt(0)" ::: "memory");
    const int c = lane & 7;
#pragma unroll
    for (int j = 0; j < 4; ++j) { const int n = (lane >> 3) + 8 * j; const LAS float* s = scr + (8 * c) * 33 + n;
        u32x4 o; o.x = pkbf(s[0 * 33], s[1 * 33]); o.y = pkbf(s[2 * 33], s[3 * 33]); o.z = pkbf(s[4 * 33], s[5 * 33]); o.w = pkbf(s[6 * 33], s[7 * 33]);
        *(u32x4*)(WT + (size_t)(n0 + n) * K + k0 + 8 * c) = o; }
    asm volatile("s_waitcnt lgkmcnt(0)" ::: "memory");
}
__device__ __forceinline__ void p0_weights(const Params& p, LAS unsigned char* lds, int tid, int lane, int wave) {
    p0_wsc(p, lds, tid);
    const int G = gridDim.x, gw = blockIdx.x * 8 + wave, NGW = G * 8;
    LAS float* scr = (LAS float*)(lds + wave * 16384);
    constexpr int I_IN = (DM / 64) * (NQKV / 32), I_OUT = (DM / 64) * (DM / 32);
    for (int it = gw; it < I_IN + I_OUT; it += NGW) {
        if (it < I_IN) p0_transpose_item(p.w_in, DM, NQKV, (bf16_t*)(p.ws + WS_WIN), nullptr, nullptr, scr, it, lane);
        else p0_transpose_item(p.w_out, DM, DM, (bf16_t*)(p.ws + WS_WOUT), p.ong_na, p.ong_dil, scr, it - I_IN, lane);
    }
}

template <bool Q8>
__device__ __forceinline__ void norm_rows(const float* src, const bf16_t* zadd, const float* gain, const float* mod, int sh_off, int sc_off, bf16_t* dst, unsigned char* dst8, float* scale8, int gw, int NGW, int lane) {
    for (int it = gw; it < TOK / 16; it += NGW) {
        const int t0 = it * 16, b = t0 >> 11; const float* mb = mod + (size_t)b * 6144;
        f32x4 Gv[4], Sv[4];
#pragma unroll
        for (int j = 0; j < 4; ++j) { const int k = 4 * lane + 256 * j; const f32x4 g = *(const f32x4*)(gain + k), sc = *(const f32x4*)(mb + sc_off + k); Gv[j] = g * (1.f + sc); Sv[j] = *(const f32x4*)(mb + sh_off + k); }
        f32x4 n1[4], n2[4], n3[4];
#pragma unroll
        for (int j = 0; j < 4; ++j) { n1[j] = __builtin_nontemporal_load((const f32x4*)(src + (size_t)t0 * DM) + lane + 64 * j); n2[j] = __builtin_nontemporal_load((const f32x4*)(src + (size_t)(t0 + 1) * DM) + lane + 64 * j); n3[j] = __builtin_nontemporal_load((const f32x4*)(src + (size_t)(t0 + 2) * DM) + lane + 64 * j); }
        u32x2 z1[4], z2[4], z3[4];
        if (Q8) {
#pragma unroll
            for (int j = 0; j < 4; ++j) { z1[j] = __builtin_nontemporal_load((const u32x2*)(zadd + (size_t)t0 * DM) + lane + 64 * j); z2[j] = __builtin_nontemporal_load((const u32x2*)(zadd + (size_t)(t0 + 1) * DM) + lane + 64 * j); z3[j] = __builtin_nontemporal_load((const u32x2*)(zadd + (size_t)(t0 + 2) * DM) + lane + 64 * j); }
        }
#pragma unroll 4
        for (int r = 0; r < 16; ++r) {
            f32x4 v[4]; float ss = 0.f;
            const f32x4* xn = (const f32x4*)(src + (size_t)(t0 + (r + 3 < 16 ? r + 3 : 15)) * DM) + lane;
#pragma unroll
            for (int j = 0; j < 4; ++j) { v[j] = n1[j]; n1[j] = n2[j]; n2[j] = n3[j]; n3[j] = __builtin_nontemporal_load(xn + 64 * j);
                if (Q8) { const u32x2 zz = z1[j]; v[j] = v[j] + (f32x4){bf_lo(zz.x), bf_hi(zz.x), bf_lo(zz.y), bf_hi(zz.y)}; z1[j] = z2[j]; z2[j] = z3[j]; z3[j] = __builtin_nontemporal_load((const u32x2*)(zadd + (size_t)(t0 + (r + 3 < 16 ? r + 3 : 15)) * DM) + lane + 64 * j); }
                ss += (v[j][0] * v[j][0] + v[j][1] * v[j][1]) + (v[j][2] * v[j][2] + v[j][3] * v[j][3]); }
            const float rs = rsqrtf(wave_sum(ss) * (1.f / DM) + EPS);
            u32x2* o8 = (u32x2*)(dst + (size_t)(t0 + r) * DM) + lane;
            float am = 0.f;
#pragma unroll
            for (int j = 0; j < 4; ++j) { const f32x4 h = v[j] * rs * Gv[j] + Sv[j]; v[j] = h; if (!Q8) { u32x2 w; w.x = pkbf(h[0], h[1]); w.y = pkbf(h[2], h[3]); o8[64 * j] = w; }
                if (Q8) am = fmaxf(fmaxf(am, fmaxf(fabsf(h[0]), fabsf(h[1]))), fmaxf(fabsf(h[2]), fabsf(h[3]))); }
            if (Q8) {
#pragma unroll
                for (int o = 1; o < 64; o <<= 1) am = fmaxf(am, __shfl_xor(am, o));
                const float inv = am > 0.f ? 127.f / am : 0.f;
                unsigned* q8 = (unsigned*)(dst8 + (size_t)(t0 + r) * DM) + lane;
#pragma unroll
                for (int j = 0; j < 4; ++j) { const int q0 = (int)rintf(v[j][0] * inv), q1 = (int)rintf(v[j][1] * inv), q2 = (int)rintf(v[j][2] * inv), q3 = (int)rintf(v[j][3] * inv);
                    q8[64 * j] = ((unsigned)q0 & 255u) | (((unsigned)q1 & 255u) << 8) | (((unsigned)q2 & 255u) << 16) | ((unsigned)q3 << 24); }
                if (lane == 0) scale8[t0 + r] = am * (1.f / 127.f);
            }
        }
    }
}

struct TabRow { f32x4 v[4]; };
__device__ __forceinline__ void tab_row_load(const Params& p, int row, int lane, TabRow& r) {
    const bool second = row >= NEXP; const int e = second ? row - NEXP : row;
    const f32x4* src = (const f32x4*)((second ? p.peer_v : p.peer_u) + (size_t)e * 1024) + lane;
#pragma unroll
    for (int j = 0; j < 4; ++j) r.v[j] = __builtin_nontemporal_load(src + 64 * j);
}
__device__ __forceinline__ void tab_row_finish(const Params& p, int row, int lane, const TabRow& r) {
    asm volatile("" : "+v"(lane));
    const bool second = row >= NEXP; const int e = second ? row - NEXP : row;
    float am = 0.f;
#pragma unroll
    for (int j = 0; j < 4; ++j) am = fmaxf(fmaxf(am, fmaxf(fabsf(r.v[j][0]), fabsf(r.v[j][1]))), fmaxf(fabsf(r.v[j][2]), fabsf(r.v[j][3])));
#pragma unroll
    for (int o = 1; o < 64; o <<= 1) am = fmaxf(am, __shfl_xor(am, o));
    const float inv = am > 0.f ? 127.f / am : 0.f;
    unsigned char* tb_ = p.ws + (second ? WS_VH : WS_UH) + (size_t)e * 128 + 4 * (lane & 31);
#pragma unroll
    for (int j = 0; j < 4; ++j) { const int q0 = (int)rintf(r.v[j][0] * inv), q1 = (int)rintf(r.v[j][1] * inv), q2 = (int)rintf(r.v[j][2] * inv), q3 = (int)rintf(r.v[j][3] * inv);
        *(unsigned*)(tb_ + (size_t)(2 * j + (lane >> 5)) * NEXP * 128) = ((unsigned)q0 & 255u) | (((unsigned)q1 & 255u) << 8) | (((unsigned)q2 & 255u) << 16) | ((unsigned)q3 << 24); }
    if (lane == 0) ((float*)(p.ws + WS_SU))[row] = am * (1.f / 127.f);
}


constexpr int VROW = 160;
constexpr int RPB_OFF = 98304;
constexpr int NUNIT_NA = 2048, NUNIT_DIL = 6144;


template <int NCH> __device__ __forceinline__ void softmax_pack(f32x4 (&S)[NCH][2], bf16x8 (&pa)[NCH], float& mx_out, float& l_out) {
    float mx = -1e30f, mx2 = -1e30f;
#pragma unroll
    for (int ch = 0; ch < NCH; ++ch)
#pragma unroll
        for (int xy = 0; xy < 2; ++xy) { mx = fmaxf(mx, fmaxf(S[ch][xy][0], S[ch][xy][1])); mx2 = fmaxf(mx2, fmaxf(S[ch][xy][2], S[ch][xy][3])); }
    mx = fmaxf(mx, mx2);
    mx = fmaxf(mx, __shfl_xor(mx, 16)); mx = fmaxf(mx, __shfl_xor(mx, 32));
    float l = 0.f;
#pragma unroll
    for (int ch = 0; ch < NCH; ++ch) {
#pragma unroll
        for (int xy = 0; xy < 2; ++xy)
#pragma unroll
            for (int r = 0; r < 4; ++r) { const float e = __builtin_amdgcn_exp2f(S[ch][xy][r] - mx); S[ch][xy][r] = e; l += e; }
        u32x4 w; w.x = pkbf(S[ch][0][0], S[ch][0][1]); w.y = pkbf(S[ch][0][2], S[ch][0][3]); w.z = pkbf(S[ch][1][0], S[ch][1][1]); w.w = pkbf(S[ch][1][2], S[ch][1][3]);
        pa[ch] = __builtin_bit_cast(bf16x8, w);
    }
    l += __shfl_xor(l, 16); l += __shfl_xor(l, 32);
    mx_out = mx; l_out = l;
}
template <int NCH, int CSB> __device__ __forceinline__ void pv_accum(const LAS unsigned char* vb, const bf16x8 (&pa)[NCH], f32x4 (&o)[4]) {
#pragma unroll
    for (int ch = 0; ch < NCH; ++ch)
#pragma unroll
        for (int nt = 0; nt < 4; ++nt) {
            const v4i16_t t0 = __builtin_amdgcn_ds_read_tr16_b64_v4i16((LAS v4i16_t*)(vb + ch * CSB + nt * 32));
            const v4i16_t t1 = __builtin_amdgcn_ds_read_tr16_b64_v4i16((LAS v4i16_t*)(vb + ch * CSB + 16 * VROW + nt * 32));
            const bf16x8 vf = {t0[0], t0[1], t0[2], t0[3], t1[0], t1[1], t1[2], t1[3]};
            o[nt] = __builtin_amdgcn_mfma_f32_16x16x32_bf16(vf, pa[ch], o[nt], 0, 0, 0);
        }
}

__device__ __forceinline__ void o_store16(__amdgpu_buffer_rsrc_t rs, size_t elem_off  , const f32x4 (&o)[4], float inv, int g) {
    const bool odd = (g & 1) != 0;
#pragma unroll
    for (int pr = 0; pr < 2; ++pr) {
        const unsigned x0 = pkbf(o[2 * pr][0] * inv, o[2 * pr][1] * inv), x1 = pkbf(o[2 * pr][2] * inv, o[2 * pr][3] * inv);
        const unsigned y0 = pkbf(o[2 * pr + 1][0] * inv, o[2 * pr + 1][1] * inv), y1 = pkbf(o[2 * pr + 1][2] * inv, o[2 * pr + 1][3] * inv);
        auto r0 = __builtin_amdgcn_permlane16_swap(x0, y0, false, false), r1 = __builtin_amdgcn_permlane16_swap(x1, y1, false, false);
        const u32x4 w = {r0[0], r1[0], r0[1], r1[1]};
        const int d0 = 16 * (2 * pr + (odd ? 1 : 0)) + 4 * (g & ~1);
        pg8::wt_store16(rs, (elem_off + d0) * 2, w);
    }
}

__device__ __forceinline__ void lds_barrier() { asm volatile("s_waitcnt lgkmcnt(0)\n\ts_barrier" ::: "memory"); }
struct NaGeo { int b, h, rp, rr, cg, r0, cw; };
__device__ __forceinline__ NaGeo na_geo(int u, int wave) {
    NaGeo z; z.b = u >> 7; z.h = (u >> 4) & 7; z.rp = u & 15; z.rr = 2 * z.rp + (wave >> 2); z.cg = wave & 3;
    z.r0 = min(max(z.rr - 4, 0), 24); z.cw = min(max(16 * z.cg - 8, 0), 32); return z;
}
__device__ __forceinline__ void na_qload(const bf16_t* QKV, const NaGeo& z, int lane, bf16x8& qf0, bf16x8& qf1) {
    const bf16_t* qp = QKV + (((size_t)z.b * 48 + z.h) * SEQ + z.rr * 64 + 16 * z.cg + (lane & 15)) * 64 + 8 * (lane >> 4);
    qf0 = *(const bf16x8*)qp; qf1 = *(const bf16x8*)(qp + 32);
}
__device__ __forceinline__ void na_kload(const bf16_t* QKV, const NaGeo& z, int hf, int lane, bf16x8 (&kf)[4][2][2]) {
#pragma unroll
    for (int c4 = 0; c4 < 4; ++c4)
#pragma unroll
        for (int xy = 0; xy < 2; ++xy) {
            const bf16_t* kp = QKV + (((size_t)z.b * 48 + 8 + z.h) * SEQ + (z.r0 + 4 * hf + c4) * 64 + z.cw + 16 * xy + (lane & 15)) * 64 + 8 * (lane >> 4);
            kf[c4][xy][0] = *(const bf16x8*)kp; kf[c4][xy][1] = *(const bf16x8*)(kp + 32);
        }
}
__device__ __forceinline__ void s_mfma4(const bf16x8 (&kf)[4][2][2], const bf16x8 qf0, const bf16x8 qf1, f32x4 (&S)[8][2], int base) {
#pragma unroll
    for (int c4 = 0; c4 < 4; ++c4)
#pragma unroll
        for (int xy = 0; xy < 2; ++xy) S[base + c4][xy] = __builtin_amdgcn_mfma_f32_16x16x32_bf16(kf[c4][xy][0], qf0, (f32x4){0.f, 0.f, 0.f, 0.f}, 0, 0, 0);
#pragma unroll
    for (int c4 = 0; c4 < 4; ++c4)
#pragma unroll
        for (int xy = 0; xy < 2; ++xy) S[base + c4][xy] = __builtin_amdgcn_mfma_f32_16x16x32_bf16(kf[c4][xy][1], qf1, S[base + c4][xy], 0, 0, 0);
}
__device__ __forceinline__ void na_unit(const Params& p, LAS unsigned char* lds, int u, int un, int tid, int lane, int wave, bf16x8 (&kfA)[4][2][2], bf16x8 (&kfB)[4][2][2], bf16x8& qf0, bf16x8& qf1) {
    const bf16_t* QKV = (const bf16_t*)(p.ws + WS_QKV);
    const LAS float* rpb = (const LAS float*)(lds + RPB_OFF) + 64;
    const NaGeo z = na_geo(u, wave);
    const int b = z.b, h = z.h, rp = z.rp, rr = z.rr, cg = z.cg, r0 = z.r0, cw = z.cw;
    const int q = lane & 15, g = lane >> 4, c = 16 * cg + q, c0 = min(max(c - 8, 0), 48);
    const int vbase = min(max(2 * rp - 4, 0), 24);
    const size_t tb = (size_t)b * SEQ;
    f32x4 S[8][2];
    s_mfma4(kfA, qf0, qf1, S, 0);
    s_mfma4(kfB, qf0, qf1, S, 4);
    __builtin_amdgcn_sched_barrier(0);
    u32x4 vreg[9];
    const int vr = tid >> 3, vpiece = tid & 7;
#pragma unroll
    for (int ps = 0; ps < 9; ++ps) { const int kr = min(vbase + ps, 31);
        vreg[ps] = *(const u32x4*)(QKV + (((size_t)b * 48 + 16 + h) * SEQ + kr * 64 + vr) * 64 + vpiece * 8); }
    const int thr = c0 - cw;
    const int bbase = h * 465 + (r0 - rr + 7) * 31 + (cw + 4 * g - c + 15);
    bool ux[4]; int bi[4];
#pragma unroll
    for (int r = 0; r < 4; ++r) { ux[r] = (4 * g + r) >= thr; bi[r] = bbase + r + (ux[r] ? 0 : 16); }
    f32x4 Sm[8];
#pragma unroll
    for (int ch = 0; ch < 8; ++ch)
#pragma unroll
        for (int r = 0; r < 4; ++r) Sm[ch][r] = (ux[r] ? S[ch][0][r] : S[ch][1][r]) + rpb[bi[r] + ch * 31];
    bf16x8 pa[8]; float mx, l;
    {
        float m0 = -1e30f, m1 = -1e30f;
#pragma unroll
        for (int ch = 0; ch < 8; ++ch) { m0 = fmaxf(m0, fmaxf(Sm[ch][0], Sm[ch][1])); m1 = fmaxf(m1, fmaxf(Sm[ch][2], Sm[ch][3])); }
        mx = fmaxf(m0, m1);
        mx = fmaxf(mx, __shfl_xor(mx, 16)); mx = fmaxf(mx, __shfl_xor(mx, 32));
        l = 0.f;
#pragma unroll
        for (int ch = 0; ch < 8; ++ch) {
            float ex[4], ey[4];
#pragma unroll
            for (int r = 0; r < 4; ++r) { const float e = __builtin_amdgcn_exp2f(Sm[ch][r] - mx); l += e; ex[r] = ux[r] ? e : 0.f; ey[r] = ux[r] ? 0.f : e; }
            u32x4 w; w.x = pkbf(ex[0], ex[1]); w.y = pkbf(ex[2], ex[3]); w.z = pkbf(ey[0], ey[1]); w.w = pkbf(ey[2], ey[3]);
            pa[ch] = __builtin_bit_cast(bf16x8, w);
        }
        l += __shfl_xor(l, 16); l += __shfl_xor(l, 32);
    }
    __builtin_amdgcn_sched_barrier(0);
    { const NaGeo zn = na_geo(un, wave); na_qload(QKV, zn, lane, qf0, qf1); na_kload(QKV, zn, 0, lane, kfA); na_kload(QKV, zn, 1, lane, kfB); }
    __builtin_amdgcn_sched_barrier(0);
    lds_barrier();
#pragma unroll
    for (int ps = 0; ps < 9; ++ps) *(LAS u32x4*)(lds + (ps * 64 + vr) * VROW + vpiece * 16) = vreg[ps];
    lds_barrier();
    f32x4 o[4];
#pragma unroll
    for (int nt = 0; nt < 4; ++nt) o[nt] = (f32x4){0.f, 0.f, 0.f, 0.f};
    const int i16 = lane & 15, qq = i16 >> 2, pp = i16 & 3;
    const LAS unsigned char* vb = lds + ((r0 - vbase) * 64 + cw + 4 * g + qq) * VROW + pp * 8;
    pv_accum<8, 64 * VROW>(vb, pa, o);
    const float inv = 1.f / l;
    o_store16(pg8::wt_rsrc(p.ws + WS_ONA), (tb + rr * 64 + c) * 512 + h * 64, o, inv, g);
}

struct DilGeo { int b, h, cfg, Dl, L, rho, m0; };
__device__ __forceinline__ DilGeo dil_geo(int v) {
    DilGeo z; z.b = v / 384; int rem = v - z.b * 384; z.h = rem / 48; rem -= z.h * 48; z.cfg = rem >> 4; const int sub = rem & 15;
    z.Dl = z.cfg * 2; z.L = SEQ >> z.Dl; const int nbl = 4 - z.Dl; z.rho = sub >> nbl; z.m0 = (sub & ((1 << nbl) - 1)) * 128; return z;
}
constexpr int DIL_KOFF = 0, DIL_VOFF = 272 * VROW;
struct DilRegs { u32x4 k[4], v[4]; bf16x8 qf0, qf1; };
__device__ __forceinline__ void dil_prefetch(const bf16_t* QKV, const DilGeo& z, int tid, int lane, int wave, DilRegs& R) {
    const int vr = tid >> 3, vpiece = tid & 7;
#pragma unroll
    for (int ps = 0; ps < 4; ++ps) { const int j = ps * 64 + vr; const int mm = min(max(z.m0 - 64 + j, 0), z.L - 1);
        const size_t tok = ((size_t)mm << z.Dl) + z.rho;
        R.k[ps] = *(const u32x4*)(QKV + (((size_t)z.b * 48 + 32 + z.h) * SEQ + tok) * 64 + vpiece * 8);
        R.v[ps] = *(const u32x4*)(QKV + (((size_t)z.b * 48 + 40 + z.h) * SEQ + tok) * 64 + vpiece * 8); }
    const int mq = z.m0 + 16 * wave + (lane & 15);
    const bf16_t* qp = QKV + (((size_t)z.b * 48 + 24 + z.h) * SEQ + ((size_t)mq << z.Dl) + z.rho) * 64 + 8 * (lane >> 4);
    R.qf0 = *(const bf16x8*)qp; R.qf1 = *(const bf16x8*)(qp + 32);
}
__device__ __forceinline__ void dil_unit(const Params& p, LAS unsigned char* lds, int v, int vn, int tid, int lane, int wave, DilRegs& R) {
    const bf16_t* QKV = (const bf16_t*)(p.ws + WS_QKV);
    const DilGeo z = dil_geo(v);
    const int h = z.h, cfg = z.cfg, Dl = z.Dl, L = z.L, rho = z.rho, m0 = z.m0;
    const int q = lane & 15, g = lane >> 4;
    const size_t tb = (size_t)z.b * SEQ;
    const int mq = m0 + 16 * wave + q;
    const int vr = tid >> 3, vpiece = tid & 7;
    lds_barrier();
#pragma unroll
    for (int ps = 0; ps < 4; ++ps) { const int j = ps * 64 + vr;
        *(LAS u32x4*)(lds + DIL_KOFF + j * VROW + vpiece * 16) = R.k[ps]; *(LAS u32x4*)(lds + DIL_VOFF + j * VROW + vpiece * 16) = R.v[ps]; }
    const bf16x8 qf0 = R.qf0, qf1 = R.qf1;
    lds_barrier();
    { const DilGeo zn = dil_geo(vn); dil_prefetch(QKV, zn, tid, lane, wave, R); }
    TabRow trw; const bool tconv = v < 2 * NEXP / 8;
    tab_row_load(p, tconv ? 8 * v + wave : 0, lane, trw);
    __builtin_amdgcn_sched_barrier(0);
    f32x4 S[5][2];
    {
        const LAS unsigned char* kb = lds + DIL_KOFF + (16 * wave + q) * VROW + 16 * g;
#pragma unroll
        for (int ch = 0; ch < 5; ++ch)
#pragma unroll
            for (int xy = 0; xy < 2; ++xy) S[ch][xy] = __builtin_amdgcn_mfma_f32_16x16x32_bf16(*(const LAS bf16x8*)(kb + (32 * ch + 16 * xy) * VROW), qf0, (f32x4){0.f, 0.f, 0.f, 0.f}, 0, 0, 0);
#pragma unroll
        for (int ch = 0; ch < 5; ++ch)
#pragma unroll
            for (int xy = 0; xy < 2; ++xy) S[ch][xy] = __builtin_amdgcn_mfma_f32_16x16x32_bf16(*(const LAS bf16x8*)(kb + (32 * ch + 16 * xy) * VROW + 64), qf1, S[ch][xy], 0, 0, 0);
    }
    const float slope2 = __builtin_amdgcn_exp2f(-(float)(h + 1)) * (float)(1 << Dl) * LOG2E;
#pragma unroll
    for (int ch = 0; ch < 5; ++ch)
#pragma unroll
        for (int xy = 0; xy < 2; ++xy)
#pragma unroll
            for (int r = 0; r < 4; ++r) { const int delta = 32 * ch + 16 * xy + 4 * g + r - 64 - q, ad = delta < 0 ? -delta : delta, mm = mq + delta;
                const bool valid = (ad <= 64) && (mm >= 0) && (mm < L);
                S[ch][xy][r] = valid ? S[ch][xy][r] - slope2 * (float)ad : -1e30f; }
    bf16x8 pa[5]; float mx, l;
    softmax_pack<5>(S, pa, mx, l);
    f32x4 o[4];
#pragma unroll
    for (int nt = 0; nt < 4; ++nt) o[nt] = (f32x4){0.f, 0.f, 0.f, 0.f};
    const int i16 = lane & 15, qq = i16 >> 2, pp = i16 & 3;
    const LAS unsigned char* vb = lds + DIL_VOFF + (16 * wave + 4 * g + qq) * VROW + pp * 8;
    pv_accum<5, 32 * VROW>(vb, pa, o);
    const float inv = 1.f / l;
    int g7 = g; asm volatile("" : "+v"(g7));
    const size_t tq = tb + ((size_t)(m0 + 16 * wave + (lane & 15)) << Dl) + rho;
    o_store16(pg8::wt_rsrc(p.ws + WS_OD), (size_t)cfg * TOK * 512 + tq * 512 + h * 64, o, inv, g7);
    if (g7 == 0) ((float*)(p.ws + WS_LSE))[((size_t)cfg * TOK + tq) * 8 + h] = mx + __builtin_amdgcn_logf(l);
    if (tconv) tab_row_finish(p, 8 * v + wave, lane, trw);
}

__device__ __forceinline__ void attn_phase(const Params& p, LAS unsigned char* lds, int tid, int lane, int wave, int vcu, int G) {
    const bf16_t* QKV = (const bf16_t*)(p.ws + WS_QKV);
    LAS float* rp = (LAS float*)(lds + RPB_OFF);
    for (int i = tid; i < 64 + 8 * 465 + 64; i += 512) { const int k = i - 64; rp[i] = (k >= 0 && k < 8 * 465) ? p.na_rpb[k] * LOG2E : 0.f; }
    __syncthreads();
    {
        bf16x8 kfA[4][2][2], kfB[4][2][2], qf0, qf1;
        int u = vcu;
        if (u < NUNIT_NA) { const NaGeo z = na_geo(u, wave); na_qload(QKV, z, lane, qf0, qf1); na_kload(QKV, z, 0, lane, kfA); na_kload(QKV, z, 1, lane, kfB); }
        for (; u < NUNIT_NA; u += G) na_unit(p, lds, u, (u + G < NUNIT_NA) ? u + G : u, tid, lane, wave, kfA, kfB, qf0, qf1);
    }
    {
        DilRegs R0, R1;
        int v = vcu;
        lds_barrier();
        if (tid < 16 * 8) { const int j = 256 + (tid >> 3); *(LAS u32x4*)(lds + DIL_KOFF + j * VROW + (tid & 7) * 16) = (u32x4){0u, 0u, 0u, 0u}; *(LAS u32x4*)(lds + DIL_VOFF + j * VROW + (tid & 7) * 16) = (u32x4){0u, 0u, 0u, 0u}; }
        if (v < NUNIT_DIL) { const DilGeo z = dil_geo(v); dil_prefetch(QKV, z, tid, lane, wave, R0); }
        if (v + G < NUNIT_DIL) { const DilGeo z = dil_geo(v + G); dil_prefetch(QKV, z, tid, lane, wave, R1); }
        for (; v < NUNIT_DIL; v += 2 * G) {
            dil_unit(p, lds, v, (v + 2 * G < NUNIT_DIL) ? v + 2 * G : v, tid, lane, wave, R0);
            if (v + G < NUNIT_DIL) dil_unit(p, lds, v + G, (v + 3 * G < NUNIT_DIL) ? v + 3 * G : v + G, tid, lane, wave, R1);
        }
    }
}

__device__ __forceinline__ void unpack8(const u32x4 w, float (&f)[8]) { f[0] = bf_lo(w.x); f[1] = bf_hi(w.x); f[2] = bf_lo(w.y); f[3] = bf_hi(w.y); f[4] = bf_lo(w.z); f[5] = bf_hi(w.z); f[6] = bf_lo(w.w); f[7] = bf_hi(w.w); }
__device__ __forceinline__ void wsc_quant(const Params& p, int gw, int NGW, int lane) {
    const bf16_t* W = (const bf16_t*)(p.ws + WS_WSC); unsigned char* Q = p.ws + WS_W8SC; float* S = (float*)(p.ws + WS_SWN);
    for (int n = gw; n < NPQ; n += NGW) {
        float f[16]; { float a[8], b[8]; unpack8(*((const u32x4*)(W + (size_t)n * DM) + 2 * lane), a); unpack8(*((const u32x4*)(W + (size_t)n * DM) + 2 * lane + 1), b);
#pragma unroll
            for (int e = 0; e < 8; ++e) { f[e] = a[e]; f[8 + e] = b[e]; } }
        float am = 0.f;
#pragma unroll
        for (int e = 0; e < 16; ++e) am = fmaxf(am, fabsf(f[e]));
#pragma unroll
        for (int o = 1; o < 64; o <<= 1) am = fmaxf(am, __shfl_xor(am, o));
        const float inv = am > 0.f ? 127.f / am : 0.f;
        u32x4 w;
#pragma unroll
        for (int c = 0; c < 4; ++c) { const int q0 = (int)rintf(f[4 * c] * inv), q1 = (int)rintf(f[4 * c + 1] * inv), q2 = (int)rintf(f[4 * c + 2] * inv), q3 = (int)rintf(f[4 * c + 3] * inv);
            w[c] = ((unsigned)q0 & 255u) | (((unsigned)q1 & 255u) << 8) | (((unsigned)q2 & 255u) << 16) | ((unsigned)q3 << 24); }
        *((u32x4*)(Q + (size_t)n * DM) + lane) = w;
        if (lane == 0) S[n] = am * (1.f / 127.f);
    }
}
__device__ __forceinline__ void merge_norm(const Params& p, int gw, int NGW, int lane) {
    const bf16_t* ONA = (const bf16_t*)(p.ws + WS_ONA); const bf16_t* OD = (const bf16_t*)(p.ws + WS_OD); const float* LSE = (const float*)(p.ws + WS_LSE);
    bf16_t* Hn = (bf16_t*)(p.ws + WS_H);
    const __amdgpu_buffer_rsrc_t hrs = pg8::wt_rsrc(Hn);
    for (int t = gw; t < TOK; t += NGW) {
        float na[8], d0[8], d1[8], d2[8];
        unpack8(__builtin_nontemporal_load((const u32x4*)(ONA + (size_t)t * 512 + 8 * lane)), na);
        unpack8(__builtin_nontemporal_load((const u32x4*)(OD + (size_t)t * 512 + 8 * lane)), d0);
        unpack8(__builtin_nontemporal_load((const u32x4*)(OD + ((size_t)TOK + t) * 512 + 8 * lane)), d1);
        unpack8(__builtin_nontemporal_load((const u32x4*)(OD + ((size_t)2 * TOK + t) * 512 + 8 * lane)), d2);
        const int hh = lane >> 3;
        const float l0 = LSE[(size_t)t * 8 + hh], l1 = LSE[((size_t)TOK + t) * 8 + hh], l2 = LSE[((size_t)2 * TOK + t) * 8 + hh];
        const float m = fmaxf(l0, fmaxf(l1, l2));
        const float e0 = __builtin_amdgcn_exp2f(l0 - m), e1 = __builtin_amdgcn_exp2f(l1 - m), e2 = __builtin_amdgcn_exp2f(l2 - m), ie = 1.f / (e0 + e1 + e2);
        const float al0 = e0 * ie, al1 = e1 * ie, al2 = e2 * ie;
        float ssa = 0.f, ssb = 0.f, dl[8];
#pragma unroll
        for (int k = 0; k < 8; ++k) { dl[k] = al0 * d0[k] + al1 * d1[k] + al2 * d2[k]; ssa += na[k] * na[k]; ssb += dl[k] * dl[k]; }
        const float rsa = rsqrtf(wave_sum(ssa) * (1.f / 512.f) + EPS), rsb = rsqrtf(wave_sum(ssb) * (1.f / 512.f) + EPS);
        u32x4 wa, wb;
        wa.x = pkbf(na[0] * rsa, na[1] * rsa); wa.y = pkbf(na[2] * rsa, na[3] * rsa); wa.z = pkbf(na[4] * rsa, na[5] * rsa); wa.w = pkbf(na[6] * rsa, na[7] * rsa);
        wb.x = pkbf(dl[0] * rsb, dl[1] * rsb); wb.y = pkbf(dl[2] * rsb, dl[3] * rsb); wb.z = pkbf(dl[4] * rsb, dl[5] * rsb); wb.w = pkbf(dl[6] * rsb, dl[7] * rsb);
        pg8::wt_store16(hrs, ((size_t)t * DM + 8 * lane) * 2, wa);
        pg8::wt_store16(hrs, ((size_t)t * DM + 512 + 8 * lane) * 2, wb);
    }
}

__device__ __forceinline__ void ce(float& a, float& b) { const float hi = fmaxf(a, b), lo = fminf(a, b); a = hi; b = lo; }
template <int N> __device__ __forceinline__ void bitonic_sort_desc(float (&v)[N]) {
#pragma unroll
    for (int k = 2; k <= N; k <<= 1)
#pragma unroll
        for (int j = k >> 1; j > 0; j >>= 1)
#pragma unroll
            for (int i = 0; i < N; ++i) { const int l = i ^ j; if (l > i) { if ((i & k) == 0) ce(v[i], v[l]); else ce(v[l], v[i]); } }
}
__device__ __forceinline__ void sort16_desc(float (&v)[16]) {
    ce(v[0], v[1]); ce(v[2], v[3]); ce(v[0], v[2]); ce(v[1], v[3]); ce(v[1], v[2]); ce(v[4], v[5]); ce(v[6], v[7]); ce(v[4], v[6]); ce(v[5], v[7]); ce(v[5], v[6]); ce(v[0], v[4]); ce(v[2], v[6]); ce(v[2], v[4]); ce(v[1], v[5]); ce(v[3], v[7]); ce(v[3], v[5]); ce(v[1], v[2]); ce(v[3], v[4]); ce(v[5], v[6]); ce(v[8], v[9]); ce(v[10], v[11]); ce(v[8], v[10]); ce(v[9], v[11]); ce(v[9], v[10]); ce(v[12], v[13]); ce(v[14], v[15]); ce(v[12], v[14]); ce(v[13], v[15]); ce(v[13], v[14]); ce(v[8], v[12]); ce(v[10], v[14]); ce(v[10], v[12]); ce(v[9], v[13]); ce(v[11], v[15]); ce(v[11], v[13]); ce(v[9], v[10]); ce(v[11], v[12]); ce(v[13], v[14]); ce(v[0], v[8]); ce(v[4], v[12]); ce(v[4], v[8]); ce(v[2], v[10]); ce(v[6], v[14]); ce(v[6], v[10]); ce(v[2], v[4]); ce(v[6], v[8]); ce(v[10], v[12]); ce(v[1], v[9]); ce(v[5], v[13]); ce(v[5], v[9]); ce(v[3], v[11]); ce(v[7], v[15]); ce(v[7], v[11]); ce(v[3], v[5]); ce(v[7], v[9]); ce(v[11], v[13]); ce(v[1], v[2]); ce(v[3], v[4]); ce(v[5], v[6]); ce(v[7], v[8]); ce(v[9], v[10]); ce(v[11], v[12]); ce(v[13], v[14]);
}
template <int N> __device__ __forceinline__ void bitonic_merge_desc(float (&v)[N]) {
#pragma unroll
    for (int j = N >> 1; j > 0; j >>= 1)
#pragma unroll
        for (int i = 0; i < N; ++i) if ((i & j) == 0) ce(v[i], v[i | j]);
}
__device__ __forceinline__ float h2f_lo(unsigned u) { return (float)__builtin_bit_cast(_Float16, (unsigned short)(u & 0xffffu)); }
__device__ __forceinline__ float h2f_hi(unsigned u) { return (float)__builtin_bit_cast(_Float16, (unsigned short)(u >> 16)); }
__device__ __forceinline__ void top16_of_128(const LAS unsigned char* row, float (&run)[16]) {
#pragma unroll
    for (int gi = 0; gi < 8; ++gi) {
        float grp[16];
#pragma unroll
        for (int q4 = 0; q4 < 2; ++q4) { const u32x4 v = *(const LAS u32x4*)(row + gi * 32 + q4 * 16);
#pragma unroll
            for (int e = 0; e < 4; ++e) {
                grp[8 * q4 + 2 * e] = __uint_as_float(__float_as_uint(h2f_lo(v[e])) | (unsigned)(gi * 16 + 8 * q4 + 2 * e));
                grp[8 * q4 + 2 * e + 1] = __uint_as_float(__float_as_uint(h2f_hi(v[e])) | (unsigned)(gi * 16 + 8 * q4 + 2 * e + 1)); } }
        sort16_desc(grp);
        if (gi == 0) {
#pragma unroll
            for (int i = 0; i < 16; ++i) run[i] = grp[i];
        } else {
#pragma unroll
            for (int i = 0; i < 16; ++i) run[i] = fmaxf(run[i], grp[15 - i]);
            bitonic_merge_desc<16>(run);
        }
    }
}
#define CAND(i, j) __uint_as_float((__float_as_uint(v1[i] + v2[j]) & ~0xFFu) | (unsigned)((i) * 16 + (j)))
constexpr int TK_ROW = 272;
__device__ __forceinline__ void tk_stage(const _Float16* SC, LAS unsigned char* wb, int t0, int col0, int lane) {
    u32x4 v[16];
#pragma unroll
    for (int i = 0; i < 16; ++i) { const int pi = i * 64 + lane, row = pi >> 4, ch = pi & 15; v[i] = __builtin_nontemporal_load((const u32x4*)(SC + (size_t)(t0 + row) * NPQ + col0 + ch * 8)); }
#pragma unroll
    for (int i = 0; i < 16; ++i) { const int pi = i * 64 + lane, row = pi >> 4, ch = pi & 15; *(LAS u32x4*)(wb + row * TK_ROW + ch * 16) = v[i]; }
}
__device__ __forceinline__ void topk_phase(const Params& p, LAS unsigned char* lds, int gw, int NGW, int lane, int wave) {
    const _Float16* SC = (const _Float16*)(p.ws + WS_SC);
    unsigned* IDS = (unsigned*)(p.ws + WS_IDS); float* GATES = (float*)(p.ws + WS_GATES);
    LAS unsigned char* wb = lds + wave * (64 * TK_ROW);
    LAS unsigned char* my = wb + lane * TK_ROW;
    const float NEG = -3.0e38f;
    for (int wi = gw; wi < (TOK / 64) * 8; wi += NGW) {
        const int t0 = (wi >> 3) * 64, hh = wi & 7, it = (t0 + lane) * 8 + hh;
        float v1[16], v2[16];
        tk_stage(SC, wb, t0, hh * 256, lane);
        top16_of_128(my, v1);
        tk_stage(SC, wb, t0, hh * 256 + 128, lane);
        top16_of_128(my, v2);
        {
            u32x4 w1, w2;
#define PK4(v, o) ((__float_as_uint(v[o]) & 0x7Fu) | ((__float_as_uint(v[o + 1]) & 0x7Fu) << 8) | ((__float_as_uint(v[o + 2]) & 0x7Fu) << 16) | ((__float_as_uint(v[o + 3]) & 0x7Fu) << 24))
            w1.x = PK4(v1, 0); w1.y = PK4(v1, 4); w1.z = PK4(v1, 8); w1.w = PK4(v1, 12);
            w2.x = PK4(v2, 0); w2.y = PK4(v2, 4); w2.z = PK4(v2, 8); w2.w = PK4(v2, 12);
#undef PK4
            *(LAS u32x4*)my = w1; *(LAS u32x4*)(my + 16) = w2;
        }
        float best[16], grp[16];
        best[0] = CAND(0, 0); best[1] = CAND(0, 1); best[2] = CAND(0, 2); best[3] = CAND(0, 3); best[4] = CAND(0, 4); best[5] = CAND(0, 5); best[6] = CAND(0, 6); best[7] = CAND(0, 7);
        best[8] = CAND(0, 8); best[9] = CAND(0, 9); best[10] = CAND(0, 10); best[11] = CAND(0, 11); best[12] = CAND(0, 12); best[13] = CAND(0, 13); best[14] = CAND(0, 14); best[15] = CAND(0, 15);
        sort16_desc(best);
        grp[0] = CAND(1, 0); grp[1] = CAND(1, 1); grp[2] = CAND(1, 2); grp[3] = CAND(1, 3); grp[4] = CAND(1, 4); grp[5] = CAND(1, 5); grp[6] = CAND(1, 6); grp[7] = CAND(1, 7);
        grp[8] = CAND(2, 0); grp[9] = CAND(2, 1); grp[10] = CAND(2, 2); grp[11] = CAND(2, 3); grp[12] = CAND(2, 4); grp[13] = CAND(3, 0); grp[14] = CAND(3, 1); grp[15] = CAND(3, 2);
        sort16_desc(grp);
#pragma unroll
        for (int i = 0; i < 16; ++i) best[i] = fmaxf(best[i], grp[15 - i]);
        bitonic_merge_desc<16>(best);
        grp[0] = CAND(3, 3); grp[1] = CAND(4, 0); grp[2] = CAND(4, 1); grp[3] = CAND(4, 2); grp[4] = CAND(5, 0); grp[5] = CAND(5, 1); grp[6] = CAND(6, 0); grp[7] = CAND(6, 1);
        grp[8] = CAND(7, 0); grp[9] = CAND(7, 1); grp[10] = CAND(8, 0); grp[11] = CAND(9, 0); grp[12] = CAND(10, 0); grp[13] = CAND(11, 0); grp[14] = CAND(12, 0); grp[15] = CAND(13, 0);
        sort16_desc(grp);
#pragma unroll
        for (int i = 0; i < 16; ++i) best[i] = fmaxf(best[i], grp[15 - i]);
        bitonic_merge_desc<16>(best);
        grp[0] = CAND(14, 0); grp[1] = CAND(15, 0);
#pragma unroll
        for (int i = 2; i < 16; ++i) grp[i] = NEG;
        sort16_desc(grp);
#pragma unroll
        for (int i = 0; i < 16; ++i) best[i] = fmaxf(best[i], grp[15 - i]);
        bitonic_merge_desc<16>(best);
        float e[16], sum = 0.f;
#pragma unroll
        for (int k = 0; k < 16; ++k) { e[k] = __expf(best[k] - best[0]); sum += e[k]; }
        const float isum = 1.f / sum;
        int idv[16];
        asm volatile("s_waitcnt lgkmcnt(0)" ::: "memory");
#pragma unroll
        for (int k = 0; k < 16; ++k) { const unsigned code = __float_as_uint(best[k]) & 0xFFu; const unsigned i1 = my[code >> 4], i2 = my[16 + (code & 15u)]; idv[k] = (int)(i1 * 128u + i2); }
        const int tt = it >> 3;
        unsigned* ip = IDS + (size_t)tt * 64 + hh; float* gp = GATES + (size_t)tt * 128 + 2 * hh;
#pragma unroll
        for (int j = 0; j < 8; ++j) {
            ip[8 * j] = (unsigned)idv[j] | ((unsigned)idv[j + 8] << 16);
            *(f32x2_t*)(gp + 16 * j) = (f32x2_t){e[j] * isum, e[j + 8] * isum};
        }
    }
}
#undef CAND

struct Topo { int xi, nx, rank, nloc; };
constexpr int CW_XCNT = 8192;
__device__ __forceinline__ float wave_max(float v) {
#pragma unroll
    for (int o = 1; o < 64; o <<= 1) v = fmaxf(v, __shfl_xor(v, o));
    return v;
}
__device__ __forceinline__ unsigned pack4(int a, int b, int c, int d) { return ((unsigned)a & 255u) | (((unsigned)b & 255u) << 8) | (((unsigned)c & 255u) << 16) | ((unsigned)d << 24); }
template <int CTRL> __device__ __forceinline__ int dppi(int v) { return __builtin_amdgcn_update_dpp(0, v, CTRL, 0xF, 0xF, false); }

#define PE_LOAD_IDS(ids, tok) do { const u32x4* ip_ = (const u32x4*)(IDST + (size_t)(tok) * 64 + 8 * j); ids[0] = ip_[0]; ids[1] = ip_[1]; } while (0)
#define PE_WARM(pf, ptr) asm volatile("s_load_dword %0, %1, 0x0" : "+s"(pf) : "s"(ptr))
#define PE_WARM_DRAIN(pf) asm volatile("s_waitcnt lgkmcnt(0)" : "+s"(pf))
#define PE_LOAD_SEGS(seg, ids, tab) do { _Pragma("unroll") for (int i_ = 0; i_ < 16; ++i_) seg[i_] = *(const u32x4*)((tab) + (size_t)((i_ & 1) ? (ids[i_ >> 3][(i_ >> 1) & 3] >> 16) : (ids[i_ >> 3][(i_ >> 1) & 3] & 0xffffu)) * 128); } while (0)

__device__ __forceinline__ void pe_u_compute(const u32x4 (&seg)[16], const u32x4 h8, unsigned* dst, bool live, int lane) {
    int a[16];
#pragma unroll
    for (int i = 0; i < 16; ++i) { int s_ = 0;
#pragma unroll
        for (int w = 0; w < 4; ++w) s_ = __builtin_amdgcn_sdot4((int)seg[i][w], (int)h8[w], s_, false);
        a[i] = s_; }
    const bool q2 = (lane & 4) != 0, q1 = (lane & 2) != 0, q0 = (lane & 1) != 0;
    int c[8], d[4], e[2];
#pragma unroll
    for (int i = 0; i < 8; ++i) { const int keep = q2 ? a[i + 8] : a[i], send = q2 ? a[i] : a[i + 8]; c[i] = keep + dppi<0x141>(send); }
#pragma unroll
    for (int i = 0; i < 4; ++i) { const int keep = q1 ? c[i + 4] : c[i], send = q1 ? c[i] : c[i + 4]; d[i] = keep + dppi<0x4E>(send); }
#pragma unroll
    for (int i = 0; i < 2; ++i) { const int keep = q0 ? d[i + 2] : d[i], send = q0 ? d[i] : d[i + 2]; e[i] = keep + dppi<0xB1>(send); }
    if (live) *dst = pkh((float)e[0] * (1.f / 64.f), (float)e[1] * (1.f / 64.f));
}
__device__ __forceinline__ void peer_u_phase(const Params& p, const Topo& tp, int lane, int wave) {
    const unsigned* IDST = (const unsigned*)(p.ws + WS_IDS); const unsigned char* H8 = p.ws + WS_H8; unsigned* PART = (unsigned*)(p.ws + WS_PART);
    const int j = lane >> 3, q = lane & 7;
    const int wv = __builtin_amdgcn_readfirstlane(tp.rank * 8 + wave), nwv = __builtin_amdgcn_readfirstlane(tp.nloc * 8);
    for (int s = tp.xi; s < 8; s += tp.nx) {
        const unsigned char* tab = p.ws + WS_UH + (size_t)s * NEXP * 128 + 16 * q;
        const unsigned char* hb = H8 + 128 * s + 16 * q;
        unsigned* pb = PART + (size_t)s * TOK * 64 + j * 8 + q;
        u32x4 idsA[2], idsB[2], segA[16], segB[16], h8A, h8B;
        int t = wv;
        unsigned pf = 0u;
#define PE_WARM_TOK(tok) do { const unsigned* wi_ = IDST + (size_t)(tok) * 64; PE_WARM(pf, wi_); PE_WARM(pf, wi_ + 32); const unsigned char* wh_ = H8 + 128 * s + (size_t)(tok) * 1024; PE_WARM(pf, wh_); } while (0)
#define TC(x) ((x) < TOK ? (x) : TOK - 1)
        PE_LOAD_IDS(idsA, TC(t));
        PE_LOAD_IDS(idsB, TC(t + nwv));
        PE_LOAD_SEGS(segA, idsA, tab); h8A = *(const u32x4*)(hb + (size_t)TC(t) * 1024);
        for (; t < TOK; t += 8 * nwv) {
            PE_LOAD_IDS(idsA, TC(t + (2 + 0) * nwv));
            PE_WARM_TOK(TC(t + (3 + (2 + 0)) * nwv));
            __builtin_amdgcn_sched_barrier(0);
            PE_LOAD_SEGS(segB, idsB, tab); h8B = *(const u32x4*)(hb + (size_t)TC(t + (1 + 0) * nwv) * 1024);
            __builtin_amdgcn_sched_barrier(0);
            pe_u_compute(segA, h8A, pb + (size_t)TC(t + (0) * nwv) * 64, t + (0) * nwv < TOK, lane);
            PE_LOAD_IDS(idsB, TC(t + (3 + 0) * nwv));
            PE_WARM_TOK(TC(t + (3 + (3 + 0)) * nwv));
            __builtin_amdgcn_sched_barrier(0);
            PE_LOAD_SEGS(segA, idsA, tab); h8A = *(const u32x4*)(hb + (size_t)TC(t + (2 + 0) * nwv) * 1024);
            __builtin_amdgcn_sched_barrier(0);
            pe_u_compute(segB, h8B, pb + (size_t)TC(t + (1 + 0) * nwv) * 64, t + (1 + 0) * nwv < TOK, lane);
            PE_LOAD_IDS(idsA, TC(t + (2 + 2) * nwv));
            PE_WARM_TOK(TC(t + (3 + (2 + 2)) * nwv));
            __builtin_amdgcn_sched_barrier(0);
            PE_LOAD_SEGS(segB, idsB, tab); h8B = *(const u32x4*)(hb + (size_t)TC(t + (1 + 2) * nwv) * 1024);
            __builtin_amdgcn_sched_barrier(0);
            pe_u_compute(segA, h8A, pb + (size_t)TC(t + (2) * nwv) * 64, t + (2) * nwv < TOK, lane);
            PE_LOAD_IDS(idsB, TC(t + (3 + 2) * nwv));
            PE_WARM_TOK(TC(t + (3 + (3 + 2)) * nwv));
            __builtin_amdgcn_sched_barrier(0);
            PE_LOAD_SEGS(segA, idsA, tab); h8A = *(const u32x4*)(hb + (size_t)TC(t + (2 + 2) * nwv) * 1024);
            __builtin_amdgcn_sched_barrier(0);
            pe_u_compute(segB, h8B, pb + (size_t)TC(t + (1 + 2) * nwv) * 64, t + (1 + 2) * nwv < TOK, lane);
            PE_LOAD_IDS(idsA, TC(t + (2 + 4) * nwv));
            PE_WARM_TOK(TC(t + (3 + (2 + 4)) * nwv));
            __builtin_amdgcn_sched_barrier(0);
            PE_LOAD_SEGS(segB, idsB, tab); h8B = *(const u32x4*)(hb + (size_t)TC(t + (1 + 4) * nwv) * 1024);
            __builtin_amdgcn_sched_barrier(0);
            pe_u_compute(segA, h8A, pb + (size_t)TC(t + (4) * nwv) * 64, t + (4) * nwv < TOK, lane);
            PE_LOAD_IDS(idsB, TC(t + (3 + 4) * nwv));
            PE_WARM_TOK(TC(t + (3 + (3 + 4)) * nwv));
            __builtin_amdgcn_sched_barrier(0);
            PE_LOAD_SEGS(segA, idsA, tab); h8A = *(const u32x4*)(hb + (size_t)TC(t + (2 + 4) * nwv) * 1024);
            __builtin_amdgcn_sched_barrier(0);
            pe_u_compute(segB, h8B, pb + (size_t)TC(t + (1 + 4) * nwv) * 64, t + (1 + 4) * nwv < TOK, lane);
            PE_LOAD_IDS(idsA, TC(t + (2 + 6) * nwv));
            PE_WARM_TOK(TC(t + (3 + (2 + 6)) * nwv));
            __builtin_amdgcn_sched_barrier(0);
            PE_LOAD_SEGS(segB, idsB, tab); h8B = *(const u32x4*)(hb + (size_t)TC(t + (1 + 6) * nwv) * 1024);
            __builtin_amdgcn_sched_barrier(0);
            pe_u_compute(segA, h8A, pb + (size_t)TC(t + (6) * nwv) * 64, t + (6) * nwv < TOK, lane);
            PE_LOAD_IDS(idsB, TC(t + (3 + 6) * nwv));
            PE_WARM_TOK(TC(t + (3 + (3 + 6)) * nwv));
            __builtin_amdgcn_sched_barrier(0);
            PE_LOAD_SEGS(segA, idsA, tab); h8A = *(const u32x4*)(hb + (size_t)TC(t + (2 + 6) * nwv) * 1024);
            __builtin_amdgcn_sched_barrier(0);
            pe_u_compute(segB, h8B, pb + (size_t)TC(t + (1 + 6) * nwv) * 64, t + (1 + 6) * nwv < TOK, lane);
        }
        PE_WARM_DRAIN(pf);
#undef PE_WARM_TOK
    }
}
__device__ __forceinline__ void peer_w_phase(const Params& p, int gw, int NGW, int lane) {
    const unsigned* IDST = (const unsigned*)(p.ws + WS_IDS); const float* GT = (const float*)(p.ws + WS_GATES); const unsigned* PART = (const unsigned*)(p.ws + WS_PART);
    const float* SU = (const float*)(p.ws + WS_SU); const float* SV = (const float*)(p.ws + WS_SV); const float* SH = (const float*)(p.ws + WS_SH);
    unsigned short* W8 = (unsigned short*)(p.ws + WS_W8); float* SW = (float*)(p.ws + WS_SW);
    for (int t = gw; t < TOK; t += NGW) {
        const size_t ix = (size_t)t * 128 + 2 * lane;
        float a0 = 0.f, a1 = 0.f;
#pragma unroll
        for (int s = 0; s < 8; ++s) { const unsigned v = __builtin_nontemporal_load(PART + (size_t)s * TOK * 64 + (ix >> 1)); a0 += h2f_lo(v); a1 += h2f_hi(v); }
        const unsigned idp = IDST[ix >> 1]; const u32x2 id = {idp & 0xffffu, idp >> 16}; const f32x2_t g = *(const f32x2_t*)(GT + ix);
        const float sh = SH[t];
        const float x0 = a0 * 64.f * SU[id.x] * sh, x1 = a1 * 64.f * SU[id.y] * sh;
        const float w0 = g.x * 0.5f * x0 * (1.f + erff(x0 * 0.70710678118654752f)) * SV[id.x];
        const float w1 = g.y * 0.5f * x1 * (1.f + erff(x1 * 0.70710678118654752f)) * SV[id.y];
        const float wm = wave_max(fmaxf(fabsf(w0), fabsf(w1)));
        const float inv = wm > 0.f ? 127.f / wm : 0.f;
        W8[ix >> 1] = (unsigned short)(((unsigned)((int)rintf(w0 * inv)) & 255u) | (((unsigned)((int)rintf(w1 * inv)) & 255u) << 8));
        if (lane == 0) SW[t] = wm * (1.f / 127.f);
    }
}
__device__ __forceinline__ void pe_v_compute(const u32x4 (&seg)[16], const u32x4 w8, float sw, bf16_t* dst, bool live, int lane) {
    int o[16];
#pragma unroll
    for (int i = 0; i < 16; ++i) o[i] = 0;
#pragma unroll
    for (int qd = 0; qd < 4; ++qd)
#pragma unroll
        for (int w = 0; w < 4; ++w) {
            const unsigned ra = seg[4 * qd][w], rb = seg[4 * qd + 1][w], rc = seg[4 * qd + 2][w], rd = seg[4 * qd + 3][w];
            const unsigned abl = __builtin_amdgcn_perm(rb, ra, 0x05010400u), abh = __builtin_amdgcn_perm(rb, ra, 0x07030602u);
            const unsigned cdl = __builtin_amdgcn_perm(rd, rc, 0x05010400u), cdh = __builtin_amdgcn_perm(rd, rc, 0x07030602u);
            o[4 * w + 0] = __builtin_amdgcn_sdot4((int)__builtin_amdgcn_perm(cdl, abl, 0x05040100u), (int)w8[qd], o[4 * w + 0], false);
            o[4 * w + 1] = __builtin_amdgcn_sdot4((int)__builtin_amdgcn_perm(cdl, abl, 0x07060302u), (int)w8[qd], o[4 * w + 1], false);
            o[4 * w + 2] = __builtin_amdgcn_sdot4((int)__builtin_amdgcn_perm(cdh, abh, 0x05040100u), (int)w8[qd], o[4 * w + 2], false);
            o[4 * w + 3] = __builtin_amdgcn_sdot4((int)__builtin_amdgcn_perm(cdh, abh, 0x07060302u), (int)w8[qd], o[4 * w + 3], false);
        }
    int b[8], c[4], d[2];
#pragma unroll
    for (int m = 0; m < 8; ++m) { auto r = __builtin_amdgcn_permlane32_swap((unsigned)o[m], (unsigned)o[m + 8], false, false); b[m] = (int)r[0] + (int)r[1]; }
#pragma unroll
    for (int m = 0; m < 4; ++m) { auto r = __builtin_amdgcn_permlane16_swap((unsigned)b[m], (unsigned)b[m + 4], false, false); c[m] = (int)r[0] + (int)r[1]; }
    const bool b3 = (lane & 8) != 0;
#pragma unroll
    for (int m = 0; m < 2; ++m) { const int keep = b3 ? c[m + 2] : c[m], send = b3 ? c[m] : c[m + 2]; d[m] = keep + dppi<0x128>(send); }
    if (live) *(unsigned*)dst = pkbf((float)d[0] * sw, (float)d[1] * sw);
}
__device__ __forceinline__ void peer_v_phase(const Params& p, const Topo& tp, int lane, int wave) {
    const unsigned* IDST = (const unsigned*)(p.ws + WS_IDS); const unsigned char* W8 = p.ws + WS_W8; const float* SW = (const float*)(p.ws + WS_SW); bf16_t* PEER = (bf16_t*)(p.ws + WS_PEER);
    const int j = lane >> 3, q = lane & 7;
    const int wv = __builtin_amdgcn_readfirstlane(tp.rank * 8 + wave), nwv = __builtin_amdgcn_readfirstlane(tp.nloc * 8);
    for (int s = tp.xi; s < 8; s += tp.nx) {
        const unsigned char* tab = p.ws + WS_VH + (size_t)s * NEXP * 128 + 16 * q;
        const unsigned char* wb = W8 + 16 * j;
        bf16_t* ob = PEER + 128 * s + 16 * q + 2 * j;
        u32x4 idsA[2], idsB[2], segA[16], segB[16], w8A, w8B; float swA, swB;
        int t = wv;
        unsigned pf = 0u;
#define PE_WARM_TOK(tok) do { const unsigned* wi_ = IDST + (size_t)(tok) * 64; PE_WARM(pf, wi_); PE_WARM(pf, wi_ + 32); const unsigned char* ww_ = W8 + (size_t)(tok) * 128; PE_WARM(pf, ww_); } while (0)
        PE_LOAD_IDS(idsA, TC(t));
        PE_LOAD_IDS(idsB, TC(t + nwv));
        PE_LOAD_SEGS(segA, idsA, tab); w8A = *(const u32x4*)(wb + (size_t)TC(t) * 128); swA = SW[TC(t)];
        for (; t < TOK; t += 8 * nwv) {
            PE_LOAD_IDS(idsA, TC(t + (2 + 0) * nwv));
            PE_WARM_TOK(TC(t + (3 + (2 + 0)) * nwv));
            __builtin_amdgcn_sched_barrier(0);
            PE_LOAD_SEGS(segB, idsB, tab); w8B = *(const u32x4*)(wb + (size_t)TC(t + (1 + 0) * nwv) * 128); swB = SW[TC(t + (1 + 0) * nwv)];
            __builtin_amdgcn_sched_barrier(0);
            pe_v_compute(segA, w8A, swA, ob + (size_t)TC(t + (0) * nwv) * DM, t + (0) * nwv < TOK, lane);
            PE_LOAD_IDS(idsB, TC(t + (3 + 0) * nwv));
            PE_WARM_TOK(TC(t + (3 + (3 + 0)) * nwv));
            __builtin_amdgcn_sched_barrier(0);
            PE_LOAD_SEGS(segA, idsA, tab); w8A = *(const u32x4*)(wb + (size_t)TC(t + (2 + 0) * nwv) * 128); swA = SW[TC(t + (2 + 0) * nwv)];
            __builtin_amdgcn_sched_barrier(0);
            pe_v_compute(segB, w8B, swB, ob + (size_t)TC(t + (1 + 0) * nwv) * DM, t + (1 + 0) * nwv < TOK, lane);
            PE_LOAD_IDS(idsA, TC(t + (2 + 2) * nwv));
            PE_WARM_TOK(TC(t + (3 + (2 + 2)) * nwv));
            __builtin_amdgcn_sched_barrier(0);
            PE_LOAD_SEGS(segB, idsB, tab); w8B = *(const u32x4*)(wb + (size_t)TC(t + (1 + 2) * nwv) * 128); swB = SW[TC(t + (1 + 2) * nwv)];
            __builtin_amdgcn_sched_barrier(0);
            pe_v_compute(segA, w8A, swA, ob + (size_t)TC(t + (2) * nwv) * DM, t + (2) * nwv < TOK, lane);
            PE_LOAD_IDS(idsB, TC(t + (3 + 2) * nwv));
            PE_WARM_TOK(TC(t + (3 + (3 + 2)) * nwv));
            __builtin_amdgcn_sched_barrier(0);
            PE_LOAD_SEGS(segA, idsA, tab); w8A = *(const u32x4*)(wb + (size_t)TC(t + (2 + 2) * nwv) * 128); swA = SW[TC(t + (2 + 2) * nwv)];
            __builtin_amdgcn_sched_barrier(0);
            pe_v_compute(segB, w8B, swB, ob + (size_t)TC(t + (1 + 2) * nwv) * DM, t + (1 + 2) * nwv < TOK, lane);
            PE_LOAD_IDS(idsA, TC(t + (2 + 4) * nwv));
            PE_WARM_TOK(TC(t + (3 + (2 + 4)) * nwv));
            __builtin_amdgcn_sched_barrier(0);
            PE_LOAD_SEGS(segB, idsB, tab); w8B = *(const u32x4*)(wb + (size_t)TC(t + (1 + 4) * nwv) * 128); swB = SW[TC(t + (1 + 4) * nwv)];
            __builtin_amdgcn_sched_barrier(0);
            pe_v_compute(segA, w8A, swA, ob + (size_t)TC(t + (4) * nwv) * DM, t + (4) * nwv < TOK, lane);
            PE_LOAD_IDS(idsB, TC(t + (3 + 4) * nwv));
            PE_WARM_TOK(TC(t + (3 + (3 + 4)) * nwv));
            __builtin_amdgcn_sched_barrier(0);
            PE_LOAD_SEGS(segA, idsA, tab); w8A = *(const u32x4*)(wb + (size_t)TC(t + (2 + 4) * nwv) * 128); swA = SW[TC(t + (2 + 4) * nwv)];
            __builtin_amdgcn_sched_barrier(0);
            pe_v_compute(segB, w8B, swB, ob + (size_t)TC(t + (1 + 4) * nwv) * DM, t + (1 + 4) * nwv < TOK, lane);
            PE_LOAD_IDS(idsA, TC(t + (2 + 6) * nwv));
            PE_WARM_TOK(TC(t + (3 + (2 + 6)) * nwv));
            __builtin_amdgcn_sched_barrier(0);
            PE_LOAD_SEGS(segB, idsB, tab); w8B = *(const u32x4*)(wb + (size_t)TC(t + (1 + 6) * nwv) * 128); swB = SW[TC(t + (1 + 6) * nwv)];
            __builtin_amdgcn_sched_barrier(0);
            pe_v_compute(segA, w8A, swA, ob + (size_t)TC(t + (6) * nwv) * DM, t + (6) * nwv < TOK, lane);
            PE_LOAD_IDS(idsB, TC(t + (3 + 6) * nwv));
            PE_WARM_TOK(TC(t + (3 + (3 + 6)) * nwv));
            __builtin_amdgcn_sched_barrier(0);
            PE_LOAD_SEGS(segA, idsA, tab); w8A = *(const u32x4*)(wb + (size_t)TC(t + (2 + 6) * nwv) * 128); swA = SW[TC(t + (2 + 6) * nwv)];
            __builtin_amdgcn_sched_barrier(0);
            pe_v_compute(segB, w8B, swB, ob + (size_t)TC(t + (1 + 6) * nwv) * DM, t + (1 + 6) * nwv < TOK, lane);
        }
        PE_WARM_DRAIN(pf);
#undef PE_WARM_TOK
    }
}
#undef TC
#undef PE_LOAD_IDS
#undef PE_LOAD_SEGS
#undef PE_WARM
#undef PE_WARM_DRAIN
__device__ __forceinline__ void final_phase(const Params& p, float* dstbase, int gw, int NGW, int lane) {
    const float* mod = (const float*)(p.ws + WS_MOD); const bf16_t* PEER = (const bf16_t*)(p.ws + WS_PEER);
    f32x4 fg[4];
#pragma unroll
    for (int j = 0; j < 4; ++j) fg[j] = *(const f32x4*)(p.final_g + 4 * lane + 256 * j);
    const __amdgpu_buffer_rsrc_t ors = pg8::wt_rsrc(dstbase);
    for (int t = gw; t < TOK; t += NGW) {
        const float* mb = mod + (size_t)(t >> 11) * 6144 + 5120;
        const f32x4* xr = (const f32x4*)(p.x + (size_t)t * DM) + lane; const u32x2* pr = (const u32x2*)(PEER + (size_t)t * DM) + lane; const u32x2* zr = (const u32x2*)((const bf16_t*)(p.ws + WS_Z) + (size_t)t * DM) + lane;
        f32x4* xw = (f32x4*)(dstbase + (size_t)t * DM) + lane;
        f32x4 x2[4]; float ss = 0.f;
#pragma unroll
        for (int j = 0; j < 4; ++j) { const f32x4 g2 = *(const f32x4*)(mb + 4 * lane + 256 * j); const u32x2 pv = __builtin_nontemporal_load(pr + 64 * j), zv = __builtin_nontemporal_load(zr + 64 * j); x2[j] = __builtin_nontemporal_load(xr + 64 * j) + (f32x4){bf_lo(zv.x), bf_hi(zv.x), bf_lo(zv.y), bf_hi(zv.y)} + g2 * (f32x4){bf_lo(pv.x), bf_hi(pv.x), bf_lo(pv.y), bf_hi(pv.y)};
            ss += (x2[j][0] * x2[j][0] + x2[j][1] * x2[j][1]) + (x2[j][2] * x2[j][2] + x2[j][3] * x2[j][3]); }
        const float rs = rsqrtf(wave_sum(ss) * (1.f / DM) + EPS);
#pragma unroll
        for (int j = 0; j < 4; ++j) pg8::wt_store16(ors, ((size_t)t * DM + 4 * lane + 256 * j) * 4, __builtin_bit_cast(u32x4, x2[j] * rs * fg[j]));
    }
}

#ifndef MK_PROF_PHASE
#define MK_PROF_PHASE -1
#endif
#ifndef MK_PROF_MULT
#define MK_PROF_MULT 4
#endif
__global__ void __launch_bounds__(512, 2) mk_fwd(Params p) {
    extern __shared__ __attribute__((aligned(16))) unsigned char lds_raw[];
    LAS unsigned char* lds = (LAS unsigned char*)lds_raw;
    const int tid = threadIdx.x, lane = tid & 63, wave = __builtin_amdgcn_readfirstlane(tid >> 6);
    const int G = gridDim.x, bx = blockIdx.x;
    const int vcu = (G % 8 == 0) ? (bx % 8) * (G / 8) + bx / 8 : bx;
    const int gw = vcu * 8 + wave, NGW = G * 8;
    const float* mod = (const float*)(p.ws + WS_MOD);
    bf16_t* Hb = (bf16_t*)(p.ws + WS_H);
#if MK_COOP
    volatile LAS unsigned* bst = (volatile LAS unsigned*)(lds + LDS_BYTES - 16);
    if (tid < 4) bst[tid] = 0u;
    __syncthreads();
    const XcdBarrier xb = xcd_barrier_post((unsigned*)(p.ws + WS_CTL) + 1024, bst);
    if (tid == 0) bst[2] = __hip_atomic_fetch_add((unsigned*)(p.ws + WS_CTL) + CW_XCNT + 64 * xb.x, 1u, __ATOMIC_RELAXED, __HIP_MEMORY_SCOPE_AGENT);
#define PHASE_END(k) do { if ((k) + 1 < p.ph_hi) xcd_barrier(xb); } while (0)
#else
#define PHASE_END(k) do { } while (0)
#endif
#define IN(k) (p.ph_lo <= (k) && (k) < p.ph_hi)
#if MK_PROF_PHASE >= 0
    unsigned long long pt_prev_ = __builtin_amdgcn_s_memrealtime(), pdt_ = 0ull;
#define PMARK(k) do { const unsigned long long n_ = __builtin_amdgcn_s_memrealtime(); if ((k) == MK_PROF_PHASE) pdt_ = n_ - pt_prev_; pt_prev_ = n_; } while (0)
#else
#define PMARK(k) do { } while (0)
#endif
    if (IN(0)) { p0_mod(p, lds, tid, lane, wave); PHASE_END(0); PMARK(0); }
    if (IN(1)) { p0_weights(p, lds, tid, lane, wave); norm_rows<false>(p.x, nullptr, p.norm1_g, mod, 0, 1024, Hb, nullptr, nullptr, gw, NGW, lane); PHASE_END(1); PMARK(1); }
    if (IN(2)) {
        pg8::Gemm g{Hb, (const bf16_t*)(p.ws + WS_WIN), TOK, NQKV, DM}; pg8::StaticOrder S; S.init(TOK, NQKV, G, bx);
        pg8::EpiQKV E{(bf16_t*)(p.ws + WS_QKV), NQKV, QSCALE};
        pg8::gemm_phase<pg8::EpiQKV, pg8::StaticOrder, true, true>(lds, g, S, E);
        PHASE_END(2); PMARK(2);
    }
    if (IN(3)) { attn_phase(p, lds, tid, lane, wave, vcu, G); PHASE_END(3); PMARK(3); }
    if (IN(4)) { wsc_quant(p, gw, NGW, lane); merge_norm(p, gw, NGW, lane); PHASE_END(4); PMARK(4); }
    if (IN(5)) {
        pg8::Gemm g{Hb, (const bf16_t*)(p.ws + WS_WOUT), TOK, DM, DM}; pg8::StaticOrder S; S.init(TOK, DM, G, bx);
        pg8::EpiZ E{(bf16_t*)(p.ws + WS_Z), mod};
        pg8::gemm_phase<pg8::EpiZ, pg8::StaticOrder, true, true>(lds, g, S, E);
        PHASE_END(5); PMARK(5);
    }
    if (IN(6)) { norm_rows<true>(p.x, (const bf16_t*)(p.ws + WS_Z), p.norm2_g, mod, 3072, 4096, Hb, p.ws + WS_H8, (float*)(p.ws + WS_SH), gw, NGW, lane); PHASE_END(6); PMARK(6); }
    if (IN(7)) {
        pg8::Gemm g{(const bf16_t*)(p.ws + WS_H8), (const bf16_t*)(p.ws + WS_W8SC), TOK, NPQ, DM}; pg8::StaticOrder S; S.init(TOK, NPQ, G, bx);
        pg8::EpiSC8 E{(_Float16*)(p.ws + WS_SC), NPQ, (const float*)(p.ws + WS_SH), (const float*)(p.ws + WS_SWN)};
        pg8::gemm_phase<pg8::EpiSC8, pg8::StaticOrder, true, true, true>(lds, g, S, E);
        PHASE_END(7); PMARK(7);
    }
    if (IN(8)) { topk_phase(p, lds, gw, NGW, lane, wave); PHASE_END(8); PMARK(8); }
    Topo tp; tp.xi = 0; tp.nx = 1; tp.rank = bx; tp.nloc = G;
#if MK_COOP
    if (IN(9) || IN(11)) {
        const unsigned* xc = (const unsigned*)(p.ws + WS_CTL) + CW_XCNT; int nx = 0, xi = 0, nloc = 1;
        for (int jx = 0; jx < 16; ++jx) { const unsigned cnt = __hip_atomic_load(xc + 64 * jx, __ATOMIC_RELAXED, __HIP_MEMORY_SCOPE_AGENT); if (cnt) { if (jx < (int)xb.x) ++xi; if (jx == (int)xb.x) nloc = (int)cnt; ++nx; } }
        tp.xi = __builtin_amdgcn_readfirstlane(xi); tp.nx = __builtin_amdgcn_readfirstlane(nx > 0 ? nx : 1); tp.rank = __builtin_amdgcn_readfirstlane((int)bst[2]); tp.nloc = __builtin_amdgcn_readfirstlane(nloc);
    }
#endif
    if (IN(9)) { peer_u_phase(p, tp, lane, wave); PHASE_END(9); PMARK(9); }
    if (IN(10)) { peer_w_phase(p, gw, NGW, lane); PHASE_END(10); PMARK(10); }
    if (IN(11)) { peer_v_phase(p, tp, lane, wave); PHASE_END(11); PMARK(11); }
    if (IN(12)) { final_phase(p, p.out, gw, NGW, lane); }
#if MK_PROF_PHASE >= 0
    if (blockIdx.x == 0 && threadIdx.x < 64) { const unsigned long long t0_ = __builtin_amdgcn_s_memrealtime(), d_ = pdt_ * MK_PROF_MULT; while (__builtin_amdgcn_s_memrealtime() - t0_ < d_) __builtin_amdgcn_s_sleep(8); }
#endif
#undef IN
#undef PHASE_END
}

extern "C" void kernel_launch(void* const* d_in, const int* in_sizes, int n_in, void* d_out, int out_size, void* d_ws, size_t ws_size, hipStream_t stream) {
    static int grid = 0;
    if (grid == 0) {
        if (n_in != 16 || in_sizes[0] != TOK * DM || out_size != TOK * DM || ws_size < WS_END) {
            fprintf(stderr, "kernel_launch: unexpected shapes (n_in %d, in0 %d, out %d, ws %zu)\n", n_in, n_in > 0 ? in_sizes[0] : -1, out_size, ws_size); grid = -1; return; }
        int dev = 0, cus = 0, per_cu = 0;
        if (hipGetDevice(&dev) != hipSuccess || hipDeviceGetAttribute(&cus, hipDeviceAttributeMultiprocessorCount, dev) != hipSuccess) { grid = -1; return; }
        if (hipFuncSetAttribute((const void*)mk_fwd, hipFuncAttributeMaxDynamicSharedMemorySize, LDS_BYTES) != hipSuccess) { fprintf(stderr, "kernel_launch: hipFuncSetAttribute failed\n"); grid = -1; return; }
        if (hipOccupancyMaxActiveBlocksPerMultiprocessor(&per_cu, (const void*)mk_fwd, 512, LDS_BYTES) != hipSuccess || per_cu < 1) { fprintf(stderr, "kernel_launch: occupancy query says %d blocks per CU\n", per_cu); per_cu = 1; }
        (void)hipGetLastError();
        grid = cus;
        if (grid > 2048) { fprintf(stderr, "kernel_launch: %d CUs: the attention phase's table-conversion schedule assumes at most 2048 workgroups\n", grid); grid = -1; return; }
    }
    if (grid < 0) return;
    Params p{};
    p.x = (const float*)d_in[0]; p.c = (const float*)d_in[1]; p.ada_w = (const float*)d_in[2]; p.ada_b = (const float*)d_in[3]; p.norm1_g = (const float*)d_in[4];
    p.w_in = (const float*)d_in[5]; p.na_rpb = (const float*)d_in[6]; p.ong_na = (const float*)d_in[7]; p.ong_dil = (const float*)d_in[8]; p.w_out = (const float*)d_in[9];
    p.norm2_g = (const float*)d_in[10]; p.peer_wq = (const float*)d_in[11]; p.peer_sk = (const float*)d_in[12]; p.peer_u = (const float*)d_in[13]; p.peer_v = (const float*)d_in[14];
    p.final_g = (const float*)d_in[15]; p.out = (float*)d_out; p.ws = (unsigned char*)d_ws;
#if MK_COOP
    if (hipMemsetAsync((char*)d_ws + WS_CTL, 0, 65536, stream) != hipSuccess) { fprintf(stderr, "kernel_launch: memset of the barrier words failed\n"); return; }
    p.ph_lo = 0; p.ph_hi = NPHASE;
    void* args[] = {&p};
    const hipError_t e = hipLaunchCooperativeKernel((const void*)mk_fwd, dim3(grid), dim3(512), args, LDS_BYTES, stream);
    if (e != hipSuccess) fprintf(stderr, "kernel_launch: cooperative launch failed: %s (grid %d)\n", hipGetErrorString(e), grid);
#else
    for (int k = 0; k < NPHASE; ++k) { p.ph_lo = k; p.ph_hi = k + 1; hipLaunchKernelGGL(mk_fwd, dim3(grid), dim3(512), LDS_BYTES, stream, p); }
#endif
}
```

```cpp
#include <hip/hip_runtime.h>
#include <cstdio>
#include <cstdint>

#ifndef MK_COOP
#define MK_COOP 1
#endif

constexpr int DM = 1024, BATCH = 16, SEQ = 2048, TOK = BATCH * SEQ;
constexpr int NQKV = 3072, NPQ = 2048, NEXP = 16384;
constexpr float EPS = 1e-6f;
constexpr float LOG2E = 1.4426950408889634f;
constexpr float QSCALE = 0.125f * LOG2E;

constexpr size_t MiB = 1u << 20;
constexpr size_t WS_CTL = 0;
constexpr size_t WS_MOD = 1 * MiB;
constexpr size_t WS_WIN = 2 * MiB;
constexpr size_t WS_WOUT = 8 * MiB;
constexpr size_t WS_WSC = 10 * MiB;
constexpr size_t WS_SU = 14 * MiB;
constexpr size_t WS_SV = 14 * MiB + 65536;
constexpr size_t WS_UH = 16 * MiB;
constexpr size_t WS_VH = 48 * MiB;
constexpr size_t WS_H = 80 * MiB;
constexpr size_t WS_QKV = 144 * MiB;
constexpr size_t WS_ONA = 336 * MiB;
constexpr size_t WS_OD = 368 * MiB;
constexpr size_t WS_LSE = 464 * MiB;
constexpr size_t WS_IDS = 468 * MiB;
constexpr size_t WS_GATES = 484 * MiB;
constexpr size_t WS_SC = 144 * MiB;
constexpr size_t WS_PART = 144 * MiB;
constexpr size_t WS_PEER = 272 * MiB;
constexpr size_t WS_Z = 336 * MiB;
constexpr size_t WS_H8 = 400 * MiB;
constexpr size_t WS_W8 = 432 * MiB;
constexpr size_t WS_SH = 436 * MiB;
constexpr size_t WS_SW = 437 * MiB;
constexpr size_t WS_SHA = 476 * MiB;
constexpr size_t WS_SHB = 476 * MiB + 262144;
constexpr size_t WS_SWN = 476 * MiB + 524288;
constexpr size_t WS_SWOUT = 476 * MiB + 524288 + 65536;
constexpr size_t WS_SWIN = 476 * MiB + 524288 + 131072;
constexpr size_t WS_W8SC = 477 * MiB;
constexpr size_t WS_W8OUT = 479 * MiB;
constexpr size_t WS_W8IN = 480 * MiB;
constexpr size_t WS_END = 500 * MiB;

constexpr int LDS_BYTES = 147456;

#define LAS __attribute__((address_space(3)))
typedef unsigned short bf16_t;
typedef short bf16x8 __attribute__((ext_vector_type(8)));
typedef float f32x4 __attribute__((ext_vector_type(4)));
typedef unsigned u32x4 __attribute__((ext_vector_type(4)));
typedef unsigned u32x2 __attribute__((ext_vector_type(2)));
typedef float f32x2_t __attribute__((ext_vector_type(2)));
typedef __bf16 bf16x2_t __attribute__((ext_vector_type(2)));
typedef _Float16 h2_t __attribute__((ext_vector_type(2)));
typedef short v4i16_t __attribute__((ext_vector_type(4)));

__device__ __forceinline__ unsigned pkbf(float lo, float hi) { f32x2_t v = {lo, hi}; bf16x2_t b = __builtin_convertvector(v, bf16x2_t); return __builtin_bit_cast(unsigned, b); }
__device__ __forceinline__ unsigned pkh(float lo, float hi) { h2_t h = {(_Float16)lo, (_Float16)hi}; return __builtin_bit_cast(unsigned, h); }
__device__ __forceinline__ float bf_lo(unsigned u) { return __uint_as_float(u << 16); }
__device__ __forceinline__ float bf_hi(unsigned u) { return __uint_as_float(u & 0xffff0000u); }
__device__ __forceinline__ float wave_sum(float v) {
#pragma unroll
    for (int o = 1; o < 64; o <<= 1) v += __shfl_xor(v, o);
    return v;
}

#define XB_TMO      128
#define XB_XCNT(j)  (256  + 64 * (j))
#define XB_XSUB(j)  (1280 + 64 * (j))
#define XB_XGEN(j)  (2304 + 64 * (j))
#define XB_TOP      3328
#define XB_TOPGEN   3392
#define XCD_BAR_WORDS 3456
#define XB_SPIN_CAP (1u << 18)

__device__ __forceinline__ unsigned xb_ld(unsigned* p)              { return __hip_atomic_load(p, __ATOMIC_RELAXED, __HIP_MEMORY_SCOPE_AGENT); }
__device__ __forceinline__ unsigned xb_add(unsigned* p, unsigned v) { return __hip_atomic_fetch_add(p, v, __ATOMIC_RELAXED, __HIP_MEMORY_SCOPE_AGENT); }
__device__ __forceinline__ unsigned xb_xcc_id() { return (unsigned)__builtin_amdgcn_s_getreg((3 << 11) | 20) & 0xFu; }
#define XB_SPIN(cond, bar) do { unsigned _sp = 0; while (cond) { __builtin_amdgcn_s_sleep(1); \
    if ((++_sp & 255u) == 0u) { if (xb_ld(&(bar)[XB_TMO])) break; if (_sp > XB_SPIN_CAP) { atomicAdd(&(bar)[XB_TMO], 1u); break; } } } } while (0)

struct XcdBarrier {
    unsigned* bar; unsigned x;
    volatile LAS unsigned* st;
};

__device__ __forceinline__ XcdBarrier xcd_barrier_post(unsigned* bar, volatile LAS unsigned* st) {
    XcdBarrier b; b.bar = bar; b.x = xb_xcc_id(); b.st = st;
    if (threadIdx.x == 0) (void)xb_add(&bar[XB_XCNT(b.x)], 1u);
    return b;
}
__device__ __forceinline__ void xcd_barrier_complete(unsigned* bar, unsigned x, unsigned& nloc, unsigned& nx) {
    const unsigned G = gridDim.x * gridDim.y * gridDim.z;
    unsigned sum, cnt, mine, sp = 0u;
    for (;;) {
        sum = 0u; cnt = 0u; mine = 0u;
#pragma unroll
        for (unsigned j = 0; j < 16; ++j) { const unsigned c = xb_ld(&bar[XB_XCNT(j)]); sum += c; cnt += (c > 0u) ? 1u : 0u; mine = (j == x) ? c : mine; }
        if (sum == G) break;
        __builtin_amdgcn_s_sleep(1);
        if ((++sp & 255u) == 0u) { if (xb_ld(&bar[XB_TMO])) break; if (sp > XB_SPIN_CAP) { atomicAdd(&bar[XB_TMO], 1u); break; } }
    }
    nloc = mine > 0u ? mine : 1u; nx = cnt > 0u ? cnt : 1u;
}

__device__ __forceinline__ void xcd_barrier(const XcdBarrier& b) {
    asm volatile("s_waitcnt vmcnt(0)" ::: "memory");
    __syncthreads();
    if (threadIdx.x == 0) {
        unsigned* bar = b.bar;
        __builtin_amdgcn_s_waitcnt(0);
        unsigned nloc = b.st[0], nx = b.st[1];
        if (nloc == 0u) { xcd_barrier_complete(bar, b.x, nloc, nx); b.st[0] = nloc; b.st[1] = nx; }
        const unsigned old = xb_add(&bar[XB_XSUB(b.x)], 1u);
        const unsigned gen = old / nloc;
        if (old + 1u == (gen + 1u) * nloc) {
            __builtin_amdgcn_fence(__ATOMIC_RELEASE, "agent");
            asm volatile("s_waitcnt vmcnt(0)" ::: "memory");
            const unsigned og = xb_add(&bar[XB_TOP], 1u);
            const unsigned tg = og / nx;
            if (og + 1u == (tg + 1u) * nx) xb_add(&bar[XB_TOPGEN], 1u);
            else XB_SPIN(xb_ld(&bar[XB_TOPGEN]) == tg, bar);
            __builtin_amdgcn_fence(__ATOMIC_ACQUIRE, "agent");
            xb_add(&bar[XB_XGEN(b.x)], 1u);
            asm volatile("s_waitcnt vmcnt(0)" ::: "memory");
        } else {
            XB_SPIN(xb_ld(&bar[XB_XGEN(b.x)]) == gen, bar);
            __builtin_amdgcn_fence(__ATOMIC_ACQUIRE, "agent");
            asm volatile("s_waitcnt vmcnt(0)" ::: "memory");
        }
    }
    __syncthreads();
}

namespace pg8 {
#define PG8_LAS __attribute__((address_space(3)))
typedef unsigned short bf16_t;
typedef short bf16x8 __attribute__((ext_vector_type(8)));
typedef float f32x4 __attribute__((ext_vector_type(4)));
typedef unsigned u32x4 __attribute__((ext_vector_type(4)));
typedef int i32x4 __attribute__((ext_vector_type(4)));
constexpr int BM = 256, BK = 64, HALF = 128, HTB = HALF * BK * 2  , STAGE_BYTES = 8 * HTB, NXCD = 8, WGM = 8;

__host__ __device__ __forceinline__ int lds_byte(int r, int c) { const int st = (r >> 4) * 2 + (c >> 5), rr = r & 15, cc = c & 31, ob = rr * 64 + cc * 2; return st * 1024 + (ob ^ (((ob >> 9) & 1) << 5)); }
__host__ __device__ __forceinline__ void stage_rc(int b, int& R, int& C) { const int st = b / 1024, sb = b % 1024, swz = sb ^ (((sb >> 9) & 1) << 5); R = (st >> 1) * 16 + swz / 64; C = (st & 1) * 32 + (swz % 64) / 2; }
__host__ __device__ __forceinline__ int perm32(int rho) { const int n = rho >> 4, i = rho & 15; return 8 * (i >> 2) + 4 * n + (i & 3); }

struct Unit { int pm, pn; };
struct Gemm { const bf16_t* A; const bf16_t* Bt; int M, N, K; };

struct StaticOrder {
    int nM, nN, nwg, G, c;
    __host__ __device__ void init(int M, int N, int G_, int c_) { nM = M / BM; nN = N / BM; nwg = nM * nN; G = G_; c = c_; }
    __host__ __device__ bool next(int i, Unit& u) const {
        const long L = (long)i * G + c; if (L >= nwg) return false;
        int wgid = (int)L; { const int q = nwg / NXCD, r = nwg % NXCD, xcd = wgid % NXCD, off = wgid / NXCD; wgid = (xcd < r ? xcd * (q + 1) : r * (q + 1) + (xcd - r) * q) + off; }
        const int nig = WGM * nN, gid = wgid / nig, fm = gid * WGM, gsz = (nM - fm) < WGM ? (nM - fm) : WGM;
        u.pm = fm + ((wgid % nig) % gsz); u.pn = (wgid % nig) / gsz; return true;
    }
    __device__ __forceinline__ void a_ready(const Unit&) const {}
    __device__ __forceinline__ void done(const Unit&) const {}
};


__device__ __forceinline__ unsigned cvt_pk_bf16(float lo, float hi) { unsigned r; asm volatile("v_cvt_pk_bf16_f32 %0, %1, %2" : "=v"(r) : "v"(lo), "v"(hi)); return r; }

__device__ __forceinline__ __amdgpu_buffer_rsrc_t wt_rsrc(void* base) { return __builtin_amdgcn_make_buffer_rsrc(base, 0, 0x7fffffff, 0x00020000); }
__device__ __forceinline__ void wt_store16(__amdgpu_buffer_rsrc_t r, size_t byte_off, u32x4 v) { __builtin_amdgcn_raw_buffer_store_b128(v, r, (unsigned)byte_off, 0, 16); }
struct EpiQKV {
    static constexpr bool PERM = true, AFTER_DRAIN = false;
    bf16_t* O; int ldc; float qscale;
    __device__ __forceinline__ void operator()(const f32x4 (&acc)[2][2][4][2], const Unit& u, int wr, int wc, int fr, int fq) const {
        const int bb = u.pm >> 3, s0 = (u.pm & 7) * BM + wr * 64 + fr, slot0 = 4 * u.pn + (wc >> 1), d0 = (wc & 1) * 32 + 8 * fq;
        const float sc = (u.pn < 2 || u.pn == 6 || u.pn == 7) ? qscale : 1.f;
        const __amdgpu_buffer_rsrc_t rs_ = wt_rsrc(O);
#pragma unroll
        for (int bj = 0; bj < 2; ++bj) { const size_t hp = ((((size_t)bb * 48 + slot0 + 2 * bj) * 2048 + s0) * 64 + d0) * 2;
#pragma unroll
            for (int ai = 0; ai < 2; ++ai)
#pragma unroll
                for (int m = 0; m < 4; ++m) { const f32x4 v0 = acc[ai][bj][m][0] * sc, v1 = acc[ai][bj][m][1] * sc;
                    u32x4 w; w.x = cvt_pk_bf16(v0[0], v0[1]); w.y = cvt_pk_bf16(v0[2], v0[3]); w.z = cvt_pk_bf16(v1[0], v1[1]); w.w = cvt_pk_bf16(v1[2], v1[3]);
                    wt_store16(rs_, hp + (size_t)(ai * HALF + m * 16) * 128, w); } }
    }
};
struct EpiZ {
    static constexpr bool PERM = true, AFTER_DRAIN = false;
    bf16_t* Z; const float* mod;
    __device__ __forceinline__ void operator()(const f32x4 (&acc)[2][2][4][2], const Unit& u, int wr, int wc, int fr, int fq) const {
        const int row0 = u.pm * BM + wr * 64 + fr, col0 = u.pn * BM + wc * 32 + 8 * fq;
        const float* g1 = mod + (size_t)(u.pm >> 3) * 6144 + 2048 + col0;
        const __amdgpu_buffer_rsrc_t rs_ = wt_rsrc(Z);
        f32x4 gv[2][2];
#pragma unroll
        for (int bj = 0; bj < 2; ++bj)
#pragma unroll
            for (int n = 0; n < 2; ++n) gv[bj][n] = *(const f32x4*)(g1 + bj * HALF + 4 * n);
#pragma unroll
        for (int ai = 0; ai < 2; ++ai)
#pragma unroll
            for (int m = 0; m < 4; ++m) { const size_t off = (size_t)(row0 + ai * HALF + m * 16) * 1024 + col0;
#pragma unroll
                for (int bj = 0; bj < 2; ++bj) { const f32x4 v0 = acc[ai][bj][m][0] * gv[bj][0], v1 = acc[ai][bj][m][1] * gv[bj][1];
                    u32x4 w; w.x = cvt_pk_bf16(v0[0], v0[1]); w.y = cvt_pk_bf16(v0[2], v0[3]); w.z = cvt_pk_bf16(v1[0], v1[1]); w.w = cvt_pk_bf16(v1[2], v1[3]);
                    wt_store16(rs_, (off + bj * HALF) * 2, w); } }
    }
};
struct EpiSC {
    static constexpr bool PERM = true, AFTER_DRAIN = false;
    _Float16* O; int ldc;
    __device__ __forceinline__ void operator()(const f32x4 (&acc)[2][2][4][2], const Unit& u, int wr, int wc, int fr, int fq) const {
        const int row0 = u.pm * BM + wr * 64 + fr, col0 = u.pn * BM + wc * 32 + 8 * fq;
        const __amdgpu_buffer_rsrc_t rs_ = wt_rsrc(O);
#pragma unroll
        for (int ai = 0; ai < 2; ++ai)
#pragma unroll
            for (int m = 0; m < 4; ++m) { const size_t rowp = ((size_t)(row0 + ai * HALF + m * 16) * ldc + col0) * 2;
#pragma unroll
                for (int bj = 0; bj < 2; ++bj) { const f32x4 v0 = acc[ai][bj][m][0], v1 = acc[ai][bj][m][1];
                    u32x4 w; w.x = pkh(v0[0], v0[1]); w.y = pkh(v0[2], v0[3]); w.z = pkh(v1[0], v1[1]); w.w = pkh(v1[2], v1[3]);
                    wt_store16(rs_, rowp + bj * HALF * 2, w); } }
    }
};
struct EpiQKV8 {
    static constexpr bool PERM = true, AFTER_DRAIN = false;
    bf16_t* O; float qscale; const float* sh; const float* swn;
    __device__ __forceinline__ void operator()(const f32x4 (&acc)[2][2][4][2], const Unit& u, int wr, int wc, int fr, int fq) const {
        const int bb = u.pm >> 3, s0 = (u.pm & 7) * BM + wr * 64 + fr, slot0 = 4 * u.pn + (wc >> 1), d0 = (wc & 1) * 32 + 8 * fq;
        const int row0 = u.pm * BM + wr * 64 + fr, col0 = u.pn * BM + wc * 32 + 8 * fq;
        const float sc = (u.pn < 2 || u.pn == 6 || u.pn == 7) ? qscale : 1.f;
        const __amdgpu_buffer_rsrc_t rs_ = wt_rsrc(O);
#pragma unroll
        for (int bj = 0; bj < 2; ++bj) { const size_t hp = ((((size_t)bb * 48 + slot0 + 2 * bj) * 2048 + s0) * 64 + d0) * 2;
            const f32x4 c0 = *(const f32x4*)(swn + col0 + bj * HALF) * sc, c1 = *(const f32x4*)(swn + col0 + bj * HALF + 4) * sc;
#pragma unroll
            for (int ai = 0; ai < 2; ++ai)
#pragma unroll
                for (int m = 0; m < 4; ++m) { const float rsc = sh[row0 + ai * HALF + m * 16];
                    const i32x4 i0 = __builtin_bit_cast(i32x4, acc[ai][bj][m][0]), i1 = __builtin_bit_cast(i32x4, acc[ai][bj][m][1]);
                    const f32x4 v0 = (f32x4){(float)i0[0], (float)i0[1], (float)i0[2], (float)i0[3]} * rsc * c0, v1 = (f32x4){(float)i1[0], (float)i1[1], (float)i1[2], (float)i1[3]} * rsc * c1;
                    u32x4 w; w.x = cvt_pk_bf16(v0[0], v0[1]); w.y = cvt_pk_bf16(v0[2], v0[3]); w.z = cvt_pk_bf16(v1[0], v1[1]); w.w = cvt_pk_bf16(v1[2], v1[3]);
                    wt_store16(rs_, hp + (size_t)(ai * HALF + m * 16) * 128, w); } }
    }
};
struct EpiZ8 {
    static constexpr bool PERM = true, AFTER_DRAIN = false;
    bf16_t* Z; const float* mod; const float* sh; const float* swn;
    __device__ __forceinline__ void operator()(const f32x4 (&acc)[2][2][4][2], const Unit& u, int wr, int wc, int fr, int fq) const {
        const int row0 = u.pm * BM + wr * 64 + fr, col0 = u.pn * BM + wc * 32 + 8 * fq;
        const float* g1 = mod + (size_t)(u.pm >> 3) * 6144 + 2048 + col0;
        const __amdgpu_buffer_rsrc_t rs_ = wt_rsrc(Z);
        f32x4 gv[2][2];
#pragma unroll
        for (int bj = 0; bj < 2; ++bj)
#pragma unroll
            for (int n = 0; n < 2; ++n) gv[bj][n] = *(const f32x4*)(g1 + bj * HALF + 4 * n) * *(const f32x4*)(swn + col0 + bj * HALF + 4 * n);
#pragma unroll
        for (int ai = 0; ai < 2; ++ai)
#pragma unroll
            for (int m = 0; m < 4; ++m) { const int row = row0 + ai * HALF + m * 16; const float rsc = sh[row]; const size_t off = (size_t)row * 1024 + col0;
#pragma unroll
                for (int bj = 0; bj < 2; ++bj) { const i32x4 i0 = __builtin_bit_cast(i32x4, acc[ai][bj][m][0]), i1 = __builtin_bit_cast(i32x4, acc[ai][bj][m][1]);
                    const f32x4 v0 = (f32x4){(float)i0[0], (float)i0[1], (float)i0[2], (float)i0[3]} * rsc * gv[bj][0], v1 = (f32x4){(float)i1[0], (float)i1[1], (float)i1[2], (float)i1[3]} * rsc * gv[bj][1];
                    u32x4 w; w.x = cvt_pk_bf16(v0[0], v0[1]); w.y = cvt_pk_bf16(v0[2], v0[3]); w.z = cvt_pk_bf16(v1[0], v1[1]); w.w = cvt_pk_bf16(v1[2], v1[3]);
                    wt_store16(rs_, (off + bj * HALF) * 2, w); } }
    }
};
struct EpiSC8 {
    static constexpr bool PERM = true, AFTER_DRAIN = false;
    _Float16* O; int ldc; const float* sh; const float* swn;
    __device__ __forceinline__ void operator()(const f32x4 (&acc)[2][2][4][2], const Unit& u, int wr, int wc, int fr, int fq) const {
        const int row0 = u.pm * BM + wr * 64 + fr, col0 = u.pn * BM + wc * 32 + 8 * fq;
        const __amdgpu_buffer_rsrc_t rs_ = wt_rsrc(O);
        f32x4 cs[2][2];
#pragma unroll
        for (int bj = 0; bj < 2; ++bj)
#pragma unroll
            for (int n = 0; n < 2; ++n) cs[bj][n] = *(const f32x4*)(swn + col0 + bj * HALF + 4 * n);
#pragma unroll
        for (int ai = 0; ai < 2; ++ai)
#pragma unroll
            for (int m = 0; m < 4; ++m) { const int row = row0 + ai * HALF + m * 16; const float rsc = sh[row]; const size_t rowp = ((size_t)row * ldc + col0) * 2;
#pragma unroll
                for (int bj = 0; bj < 2; ++bj) { const i32x4 i0 = __builtin_bit_cast(i32x4, acc[ai][bj][m][0]), i1 = __builtin_bit_cast(i32x4, acc[ai][bj][m][1]);
                    const f32x4 v0 = (f32x4){(float)i0[0], (float)i0[1], (float)i0[2], (float)i0[3]} * rsc * cs[bj][0], v1 = (f32x4){(float)i1[0], (float)i1[1], (float)i1[2], (float)i1[3]} * rsc * cs[bj][1];
                    u32x4 w; w.x = pkh(v0[0], v0[1]); w.y = pkh(v0[2], v0[3]); w.z = pkh(v1[0], v1[1]); w.w = pkh(v1[2], v1[3]);
                    wt_store16(rs_, rowp + bj * HALF * 2, w); } }
    }
};

template <class Epi, class Sched, bool ALIGN_EPI = false, bool SP2 = false, bool I8 = false>
__device__ __forceinline__ void gemm_phase(PG8_LAS unsigned char* lds, const Gemm g, const Sched& S, const Epi& E) {
    const int tid = threadIdx.x, wid = __builtin_amdgcn_readfirstlane(tid >> 6), lane = tid & 63, wr = wid >> 2, wc = wid & 3, fr = lane & 15, fq = lane >> 4;
    const int K = g.K, rowb = K * (I8 ? 1 : 2)  , nt = rowb / (BK * 2);
    unsigned voffA[2], voffB[2];
#pragma unroll
    for (int i = 0; i < 2; ++i) { int R, C; stage_rc(tid * 16 + i * 8192, R, C); const int Rb = Epi::PERM ? ((R & ~31) + perm32(R & 31)) : R;
        voffA[i] = (unsigned)(R * rowb + C * 2); voffB[i] = (unsigned)(Rb * rowb + C * 2); }
    const size_t kstep = (size_t)(BK * 2);
    const size_t hstep = (size_t)HALF * rowb;
    const size_t tstep = 2 * hstep;
    const unsigned ldsw = (unsigned)wid * 1024u;
    const int aoff = lds_byte(wr * 64 + fr, fq * 8), boff = lds_byte(wc * 32 + fr, fq * 8);
#define PG8_SA(b, h) (((b) * 2 + (h)) * HTB)
#define PG8_SB(b, h) ((4 + (b) * 2 + (h)) * HTB)
#define PG8_STAGE(bufoff, gbase, voff) do { _Pragma("unroll") for (int _i = 0; _i < 2; ++_i) \
        __builtin_amdgcn_global_load_lds((const unsigned*)((const char*)(gbase) + (voff)[_i]), (PG8_LAS unsigned*)(lds + (bufoff) + ldsw + _i * 8192), 16, 0, 0); } while (0)
#define PG8_LDA(dst, b, h) do { _Pragma("unroll") for (int m = 0; m < 4; ++m) _Pragma("unroll") for (int k = 0; k < 2; ++k) dst[m][k] = *(const PG8_LAS bf16x8*)(lds + PG8_SA(b, h) + aoff + m * 2048 + k * 1024); } while (0)
#define PG8_LDB(dst, b, h) do { _Pragma("unroll") for (int n = 0; n < 2; ++n) _Pragma("unroll") for (int k = 0; k < 2; ++k) dst[n][k] = *(const PG8_LAS bf16x8*)(lds + PG8_SB(b, h) + boff + n * 2048 + k * 1024); } while (0)
#define PG8_MMA(ai, bj, At, Bt) do { __builtin_amdgcn_s_setprio(1); _Pragma("unroll") for (int m = 0; m < 4; ++m) _Pragma("unroll") for (int n = 0; n < 2; ++n) _Pragma("unroll") for (int k = 0; k < 2; ++k) \
        { if constexpr (I8) acc[ai][bj][m][n] = __builtin_bit_cast(f32x4, __builtin_amdgcn_mfma_i32_16x16x64_i8(__builtin_bit_cast(i32x4, Bt[n][k]), __builtin_bit_cast(i32x4, At[m][k]), __builtin_bit_cast(i32x4, acc[ai][bj][m][n]), 0, 0, 0)); \
          else acc[ai][bj][m][n] = __builtin_amdgcn_mfma_f32_16x16x32_bf16(Bt[n][k], At[m][k], acc[ai][bj][m][n], 0, 0, 0); } __builtin_amdgcn_s_setprio(0); } while (0)
#define PG8_WAIT_V(n) asm volatile("s_waitcnt vmcnt(" #n ")" ::: "memory")
#define PG8_WAIT_L(n) asm volatile("s_waitcnt lgkmcnt(" #n ")" ::: "memory")
#define PG8_BAR __builtin_amdgcn_s_barrier()
#define PG8_SCHED __builtin_amdgcn_sched_barrier(0)
    Unit cur, nxt; int ui = 0;
    if (!S.next(0, cur)) return;
    f32x4 acc[2][2][4][2];
#pragma unroll
    for (int a = 0; a < 2; ++a)
#pragma unroll
        for (int b = 0; b < 2; ++b)
#pragma unroll
            for (int m = 0; m < 4; ++m)
#pragma unroll
                for (int n = 0; n < 2; ++n) acc[a][b][m][n] = (f32x4){0.f, 0.f, 0.f, 0.f};
    bf16x8 At[4][2], B0[2][2], B1[2][2];
    const char* cA = (const char*)g.A + (size_t)cur.pm * tstep; const char* cB = (const char*)g.Bt + (size_t)cur.pn * tstep;
    S.a_ready(cur);
    if constexpr (SP2) {
        PG8_STAGE(PG8_SB(0, 0), cB, voffB); PG8_STAGE(PG8_SB(0, 1), cB + hstep, voffB); PG8_STAGE(PG8_SA(0, 0), cA, voffA); PG8_STAGE(PG8_SA(0, 1), cA + hstep, voffA);
        if (wr == 1) PG8_BAR;
        PG8_WAIT_V(2); PG8_BAR;
        PG8_STAGE(PG8_SB(1, 0), cB + kstep, voffB); PG8_STAGE(PG8_SA(1, 0), cA + kstep, voffA); PG8_STAGE(PG8_SB(1, 1), cB + hstep + kstep, voffB);
        PG8_WAIT_V(6); PG8_BAR;
    } else {
        PG8_STAGE(PG8_SB(0, 0), cB, voffB); PG8_STAGE(PG8_SA(0, 0), cA, voffA); PG8_STAGE(PG8_SB(0, 1), cB + hstep, voffB); PG8_STAGE(PG8_SA(0, 1), cA + hstep, voffA);
        if (wr == 1) PG8_BAR;
        PG8_WAIT_V(4); PG8_BAR;
        PG8_STAGE(PG8_SB(1, 0), cB + kstep, voffB); PG8_STAGE(PG8_SA(1, 0), cA + kstep, voffA); PG8_STAGE(PG8_SB(1, 1), cB + hstep + kstep, voffB);
        PG8_WAIT_V(6); PG8_BAR;
    }
    for (;;) {
        const bool has_next = S.next(ui + 1, nxt);
        const char* nA = has_next ? (const char*)g.A + (size_t)nxt.pm * tstep : cA; const char* nB = has_next ? (const char*)g.Bt + (size_t)nxt.pn * tstep : cB;
        for (int t = 0; t < nt; t += 2) {
            const bool last = (t == nt - 2);
            const char* a1 = cA + (size_t)(t + 1) * kstep;
            const char* a2 = last ? nA : cA + (size_t)(t + 2) * kstep; const char* b2 = last ? nB : cB + (size_t)(t + 2) * kstep;
            const char* a3 = a2 + kstep; const char* b3 = b2 + kstep;
            if (last && has_next) S.a_ready(nxt);
            if constexpr (SP2) {
            PG8_LDB(B0, 0, 0); PG8_LDB(B1, 0, 1); PG8_SCHED; PG8_LDA(At, 0, 0); PG8_STAGE(PG8_SA(1, 1), a1 + hstep, voffA);
            PG8_WAIT_V(8); PG8_WAIT_L(0); PG8_BAR; PG8_MMA(0, 0, At, B0); PG8_MMA(0, 1, At, B1); PG8_BAR; PG8_SCHED;
            PG8_LDA(At, 0, 1); PG8_STAGE(PG8_SB(0, 0), b2, voffB); PG8_STAGE(PG8_SB(0, 1), b2 + hstep, voffB); PG8_STAGE(PG8_SA(0, 0), a2, voffA);
            PG8_WAIT_V(8); PG8_WAIT_L(0); PG8_BAR; PG8_MMA(1, 0, At, B0); PG8_MMA(1, 1, At, B1); PG8_BAR; PG8_SCHED;
            PG8_LDB(B0, 1, 0); PG8_LDB(B1, 1, 1); PG8_SCHED; PG8_LDA(At, 1, 0); PG8_STAGE(PG8_SA(0, 1), a2 + hstep, voffA);
            PG8_WAIT_V(8); PG8_WAIT_L(0); PG8_BAR; PG8_MMA(0, 0, At, B0); PG8_MMA(0, 1, At, B1); PG8_BAR; PG8_SCHED;
            PG8_LDA(At, 1, 1); PG8_STAGE(PG8_SB(1, 0), b3, voffB); PG8_STAGE(PG8_SB(1, 1), b3 + hstep, voffB); PG8_STAGE(PG8_SA(1, 0), a3, voffA);
            PG8_WAIT_V(8); PG8_WAIT_L(0); PG8_BAR; PG8_MMA(1, 0, At, B0); PG8_MMA(1, 1, At, B1); PG8_BAR; PG8_SCHED;
            } else {
            PG8_LDB(B0, 0, 0); PG8_SCHED; PG8_LDA(At, 0, 0); PG8_STAGE(PG8_SA(1, 1), a1 + hstep, voffA);
            PG8_WAIT_L(8); PG8_BAR; PG8_WAIT_L(0); PG8_MMA(0, 0, At, B0); PG8_BAR; PG8_SCHED;
            PG8_LDB(B1, 0, 1); PG8_STAGE(PG8_SB(0, 0), b2, voffB);
            PG8_BAR; PG8_WAIT_L(0); PG8_MMA(0, 1, At, B1); PG8_BAR;
            PG8_LDA(At, 0, 1); PG8_STAGE(PG8_SA(0, 0), a2, voffA);
            PG8_BAR; PG8_WAIT_L(0); PG8_MMA(1, 0, At, B0); PG8_BAR; PG8_SCHED;
            PG8_STAGE(PG8_SB(0, 1), b2 + hstep, voffB);
            PG8_WAIT_V(6); PG8_BAR; PG8_MMA(1, 1, At, B1); PG8_BAR;
            PG8_LDB(B0, 1, 0); PG8_SCHED; PG8_LDA(At, 1, 0); PG8_STAGE(PG8_SA(0, 1), a2 + hstep, voffA);
            PG8_WAIT_L(8); PG8_BAR; PG8_WAIT_L(0); PG8_MMA(0, 0, At, B0); PG8_BAR; PG8_SCHED;
            PG8_LDB(B1, 1, 1); PG8_STAGE(PG8_SB(1, 0), b3, voffB);
            PG8_BAR; PG8_WAIT_L(0); PG8_MMA(0, 1, At, B1); PG8_BAR;
            PG8_LDA(At, 1, 1); PG8_STAGE(PG8_SA(1, 0), a3, voffA);
            PG8_BAR; PG8_WAIT_L(0); PG8_MMA(1, 0, At, B0); PG8_BAR; PG8_SCHED;
            PG8_STAGE(PG8_SB(1, 1), b3 + hstep, voffB);
            PG8_WAIT_V(6); PG8_BAR; PG8_MMA(1, 1, At, B1); PG8_BAR;
            }
        }
        if constexpr (ALIGN_EPI) { if (wr == 0) PG8_BAR; }
        if constexpr (!Epi::AFTER_DRAIN) { E(acc, cur, wr, wc, fr, fq); S.done(cur); }
        if (!has_next) break;
#pragma unroll
        for (int a = 0; a < 2; ++a)
#pragma unroll
            for (int b = 0; b < 2; ++b)
#pragma unroll
                for (int m = 0; m < 4; ++m)
#pragma unroll
                    for (int n = 0; n < 2; ++n) acc[a][b][m][n] = (f32x4){0.f, 0.f, 0.f, 0.f};
        cur = nxt; cA = nA; cB = nB; ++ui;
        if constexpr (ALIGN_EPI) { if (wr == 1) PG8_BAR; }
    }
    PG8_WAIT_V(0);
    if constexpr (!ALIGN_EPI) { if (wr == 0) PG8_BAR; }
    PG8_BAR;
    if constexpr (Epi::AFTER_DRAIN) { E.fused(acc, cur, wr, wc, fr, fq, lds, wid, lane); S.done(cur); }
#undef PG8_SA
#undef PG8_SB
#undef PG8_STAGE
#undef PG8_LDA
#undef PG8_LDB
#undef PG8_MMA
#undef PG8_WAIT_V
#undef PG8_WAIT_L
#undef PG8_BAR
#undef PG8_SCHED
}
}

struct Params {
    const float *x, *c, *ada_w, *ada_b, *norm1_g, *w_in, *na_rpb, *ong_na, *ong_dil, *w_out, *norm2_g, *peer_wq, *peer_sk, *peer_u, *peer_v, *final_g;
    float* out; unsigned char* ws; int ph_lo, ph_hi;
};
constexpr int NPHASE = 13;

__device__ __forceinline__ void p0_mod(const Params& p, LAS unsigned char* lds, int tid, int lane, int wave) {
    LAS float* s = (LAS float*)lds;
    LAS float* red = (LAS float*)(lds + 65536);
    for (int idx = tid; idx < 16 * 1024; idx += 512) { const int b = idx >> 10, k = idx & 1023; const float cv = p.c[idx]; s[k * 16 + b] = cv / (1.f + __expf(-cv)); }
    __syncthreads();
    float* mod = (float*)(p.ws + WS_MOD);
    for (int it = blockIdx.x; it < 256; it += gridDim.x) {
        const int j0 = it * 24, c = lane & 31, kq = lane >> 5; const bool act = c < 24;
        float acc[16];
#pragma unroll
        for (int b = 0; b < 16; ++b) acc[b] = 0.f;
        const float* wp = p.ada_w + (size_t)(wave * 128 + kq) * 6144 + j0 + (act ? c : 0);
#pragma unroll 4
        for (int i = 0; i < 64; ++i) {
            const int k = wave * 128 + 2 * i + kq;
            const float wv = act ? __builtin_nontemporal_load(wp + (size_t)i * 2 * 6144) : 0.f;
            const LAS f32x4* sp = (const LAS f32x4*)(s + k * 16);
            const f32x4 s0 = sp[0], s1 = sp[1], s2 = sp[2], s3 = sp[3];
#pragma unroll
            for (int e = 0; e < 4; ++e) { acc[e] += s0[e] * wv; acc[4 + e] += s1[e] * wv; acc[8 + e] += s2[e] * wv; acc[12 + e] += s3[e] * wv; }
        }
#pragma unroll
        for (int b = 0; b < 16; ++b) red[((wave * 2 + kq) * 16 + b) * 32 + c] = acc[b];
        __syncthreads();
        if (tid < 384) { const int b = tid / 24, cc = tid - b * 24; float sum = p.ada_b[j0 + cc];
#pragma unroll
            for (int pp = 0; pp < 16; ++pp) sum += red[(pp * 16 + b) * 32 + cc];
            mod[(size_t)b * 6144 + j0 + cc] = sum; }
        __syncthreads();
    }
}
__device__ __forceinline__ void p0_wsc(const Params& p, LAS unsigned char* lds, int tid) {
    LAS float* wq_s = (LAS float*)lds;
    LAS float* sk_s = (LAS float*)(lds + 32768);
    bf16_t* WscT = (bf16_t*)(p.ws + WS_WSC);
    for (int it = blockIdx.x; it < 256; it += gridDim.x) {
        const int hp = it >> 4, kc = it & 15, pp = hp & 1, k0 = kc * 64;
        for (int i = tid; i < 2048; i += 512) { const int r = i >> 5, c4 = i & 31; *(LAS f32x4*)(wq_s + r * 128 + c4 * 4) = *(const f32x4*)(p.peer_wq + (size_t)(k0 + r) * 2048 + hp * 128 + c4 * 4); }
        for (int i = tid; i < 4096; i += 512) { const int r = i >> 5, c4 = i & 31; *(LAS f32x4*)(sk_s + r * 132 + c4 * 4) = *(const f32x4*)(p.peer_sk + (size_t)pp * 16384 + r * 128 + c4 * 4); }
        __syncthreads();
        const int n = tid & 127, kg = tid >> 7;
        float acc[16];
#pragma unroll
        for (int i = 0; i < 16; ++i) acc[i] = 0.f;
        for (int d = 0; d < 128; d += 4) {
            const f32x4 sv = *(const LAS f32x4*)(sk_s + n * 132 + d);
#pragma unroll
            for (int i = 0; i < 16; ++i) { const f32x4 wv = *(const LAS f32x4*)(wq_s + (kg * 16 + i) * 128 + d); acc[i] += (wv[0] * sv[0] + wv[1] * sv[1]) + (wv[2] * sv[2] + wv[3] * sv[3]); }
        }
        bf16_t* op = WscT + (size_t)(hp * 128 + n) * 1024 + k0 + kg * 16;
        u32x4 w0, w1;
        w0.x = pkbf(acc[0], acc[1]); w0.y = pkbf(acc[2], acc[3]); w0.z = pkbf(acc[4], acc[5]); w0.w = pkbf(acc[6], acc[7]);
        w1.x = pkbf(acc[8], acc[9]); w1.y = pkbf(acc[10], acc[11]); w1.z = pkbf(acc[12], acc[13]); w1.w = pkbf(acc[14], acc[15]);
        *(u32x4*)op = w0; *(u32x4*)(op + 8) = w1;
        __syncthreads();
    }
}
__device__ __forceinline__ void p0_transpose_item(const float* W, int K, int N, bf16_t* WT, const float* ks0, const float* ks1, LAS float* scr, int item, int lane) {
    const int nblk = N / 32, kb = item / nblk, nb = item % nblk, k0 = 64 * kb, n0 = 32 * nb;
#pragma unroll 8
    for (int i = 0; i < 32; ++i) { const int kk = 2 * i + (lane >> 5), kabs = k0 + kk;
        const float sc = ks0 ? (kabs < 512 ? ks0[kabs] : ks1[kabs - 512]) : 1.f;
        scr[kk * 33 + (lane & 31)] = W[(size_t)kabs * N + n0 + (lane & 31)] * sc; }
    asm volatile("s_waitcnt lgkmcnt(0)" ::: "memory");
    const int c = lane & 7;
#pragma unroll
    for (int j = 0; j < 4; ++j) { const int n = (lane >> 3) + 8 * j; const LAS float* s = scr + (8 * c) * 33 + n;
        u32x4 o; o.x = pkbf(s[0 * 33], s[1 * 33]); o.y = pkbf(s[2 * 33], s[3 * 33]); o.z = pkbf(s[4 * 33], s[5 * 33]); o.w = pkbf(s[6 * 33], s[7 * 33]);
        *(u32x4*)(WT + (size_t)(n0 + n) * K + k0 + 8 * c) = o; }
    asm volatile("s_waitcnt lgkmcnt(0)" ::: "memory");
}
__device__ __forceinline__ void p0_weights(const Params& p, LAS unsigned char* lds, int tid, int lane, int wave) {
    p0_wsc(p, lds, tid);
    const int G = gridDim.x, gw = blockIdx.x * 8 + wave, NGW = G * 8;
    LAS float* scr = (LAS float*)(lds + wave * 16384);
    constexpr int I_IN = (DM / 64) * (NQKV / 32), I_OUT = (DM / 64) * (DM / 32);
    for (int it = gw; it < I_IN + I_OUT; it += NGW) {
        if (it < I_IN) p0_transpose_item(p.w_in, DM, NQKV, (bf16_t*)(p.ws + WS_WIN), nullptr, nullptr, scr, it, lane);
        else p0_transpose_item(p.w_out, DM, DM, (bf16_t*)(p.ws + WS_WOUT), p.ong_na, p.ong_dil, scr, it - I_IN, lane);
    }
}

template <bool ZADD>
__device__ __forceinline__ void norm_rows(const float* src, const bf16_t* zadd, const float* gain, const float* mod, int sh_off, int sc_off, unsigned char* dst8, float* scale8, int gw, int NGW, int lane) {
    constexpr bool Q8 = ZADD;
    for (int it = gw; it < TOK / 16; it += NGW) {
        const int t0 = it * 16, b = t0 >> 11; const float* mb = mod + (size_t)b * 6144;
        f32x4 Gv[4], Sv[4];
#pragma unroll
        for (int j = 0; j < 4; ++j) { const int k = 4 * lane + 256 * j; const f32x4 g = *(const f32x4*)(gain + k), sc = *(const f32x4*)(mb + sc_off + k); Gv[j] = g * (1.f + sc); Sv[j] = *(const f32x4*)(mb + sh_off + k); }
        f32x4 n1[4], n2[4], n3[4];
#pragma unroll
        for (int j = 0; j < 4; ++j) { n1[j] = __builtin_nontemporal_load((const f32x4*)(src + (size_t)t0 * DM) + lane + 64 * j); n2[j] = __builtin_nontemporal_load((const f32x4*)(src + (size_t)(t0 + 1) * DM) + lane + 64 * j); n3[j] = __builtin_nontemporal_load((const f32x4*)(src + (size_t)(t0 + 2) * DM) + lane + 64 * j); }
        u32x2 z1[4], z2[4], z3[4];
        if (ZADD) {
#pragma unroll
            for (int j = 0; j < 4; ++j) { z1[j] = __builtin_nontemporal_load((const u32x2*)(zadd + (size_t)t0 * DM) + lane + 64 * j); z2[j] = __builtin_nontemporal_load((const u32x2*)(zadd + (size_t)(t0 + 1) * DM) + lane + 64 * j); z3[j] = __builtin_nontemporal_load((const u32x2*)(zadd + (size_t)(t0 + 2) * DM) + lane + 64 * j); }
        }
#pragma unroll 4
        for (int r = 0; r < 16; ++r) {
            f32x4 v[4]; float ss = 0.f;
            const f32x4* xn = (const f32x4*)(src + (size_t)(t0 + (r + 3 < 16 ? r + 3 : 15)) * DM) + lane;
#pragma unroll
            for (int j = 0; j < 4; ++j) { v[j] = n1[j]; n1[j] = n2[j]; n2[j] = n3[j]; n3[j] = __builtin_nontemporal_load(xn + 64 * j);
                if (Q8) { const u32x2 zz = z1[j]; v[j] = v[j] + (f32x4){bf_lo(zz.x), bf_hi(zz.x), bf_lo(zz.y), bf_hi(zz.y)}; z1[j] = z2[j]; z2[j] = z3[j]; z3[j] = __builtin_nontemporal_load((const u32x2*)(zadd + (size_t)(t0 + (r + 3 < 16 ? r + 3 : 15)) * DM) + lane + 64 * j); }
                ss += (v[j][0] * v[j][0] + v[j][1] * v[j][1]) + (v[j][2] * v[j][2] + v[j][3] * v[j][3]); }
            const float rs = rsqrtf(wave_sum(ss) * (1.f / DM) + EPS);
            float am = 0.f;
#pragma unroll
            for (int j = 0; j < 4; ++j) { const f32x4 h = v[j] * rs * Gv[j] + Sv[j]; v[j] = h;
                am = fmaxf(fmaxf(am, fmaxf(fabsf(h[0]), fabsf(h[1]))), fmaxf(fabsf(h[2]), fabsf(h[3]))); }
            {
#pragma unroll
                for (int o = 1; o < 64; o <<= 1) am = fmaxf(am, __shfl_xor(am, o));
                const float inv = am > 0.f ? 127.f / am : 0.f;
                unsigned* q8 = (unsigned*)(dst8 + (size_t)(t0 + r) * DM) + lane;
#pragma unroll
                for (int j = 0; j < 4; ++j) { const int q0 = (int)rintf(v[j][0] * inv), q1 = (int)rintf(v[j][1] * inv), q2 = (int)rintf(v[j][2] * inv), q3 = (int)rintf(v[j][3] * inv);
                    q8[64 * j] = ((unsigned)q0 & 255u) | (((unsigned)q1 & 255u) << 8) | (((unsigned)q2 & 255u) << 16) | ((unsigned)q3 << 24); }
                if (lane == 0) scale8[t0 + r] = am * (1.f / 127.f);
            }
        }
    }
}

struct TabRow { f32x4 v[4]; };
__device__ __forceinline__ void tab_row_load(const Params& p, int row, int lane, TabRow& r) {
    const bool second = row >= NEXP; const int e = second ? row - NEXP : row;
    const f32x4* src = (const f32x4*)((second ? p.peer_v : p.peer_u) + (size_t)e * 1024) + lane;
#pragma unroll
    for (int j = 0; j < 4; ++j) r.v[j] = __builtin_nontemporal_load(src + 64 * j);
}
__device__ __forceinline__ void tab_row_finish(const Params& p, int row, int lane, const TabRow& r) {
    asm volatile("" : "+v"(lane));
    const bool second = row >= NEXP; const int e = second ? row - NEXP : row;
    float am = 0.f;
#pragma unroll
    for (int j = 0; j < 4; ++j) am = fmaxf(fmaxf(am, fmaxf(fabsf(r.v[j][0]), fabsf(r.v[j][1]))), fmaxf(fabsf(r.v[j][2]), fabsf(r.v[j][3])));
#pragma unroll
    for (int o = 1; o < 64; o <<= 1) am = fmaxf(am, __shfl_xor(am, o));
    const float inv = am > 0.f ? 127.f / am : 0.f;
    unsigned char* tb_ = p.ws + (second ? WS_VH : WS_UH) + (size_t)e * 128 + 4 * (lane & 31);
#pragma unroll
    for (int j = 0; j < 4; ++j) { const int q0 = (int)rintf(r.v[j][0] * inv), q1 = (int)rintf(r.v[j][1] * inv), q2 = (int)rintf(r.v[j][2] * inv), q3 = (int)rintf(r.v[j][3] * inv);
        *(unsigned*)(tb_ + (size_t)(2 * j + (lane >> 5)) * NEXP * 128) = ((unsigned)q0 & 255u) | (((unsigned)q1 & 255u) << 8) | (((unsigned)q2 & 255u) << 16) | ((unsigned)q3 << 24); }
    if (lane == 0) ((float*)(p.ws + WS_SU))[row] = am * (1.f / 127.f);
}


constexpr int VROW = 160;
constexpr int RPB_OFF = 98304;
constexpr int NUNIT_NA = 2048, NUNIT_DIL = 6144;


template <int NCH> __device__ __forceinline__ void softmax_pack(f32x4 (&S)[NCH][2], bf16x8 (&pa)[NCH], float& mx_out, float& l_out) {
    float mx = -1e30f, mx2 = -1e30f;
#pragma unroll
    for (int ch = 0; ch < NCH; ++ch)
#pragma unroll
        for (int xy = 0; xy < 2; ++xy) { mx = fmaxf(mx, fmaxf(S[ch][xy][0], S[ch][xy][1])); mx2 = fmaxf(mx2, fmaxf(S[ch][xy][2], S[ch][xy][3])); }
    mx = fmaxf(mx, mx2);
    mx = fmaxf(mx, __shfl_xor(mx, 16)); mx = fmaxf(mx, __shfl_xor(mx, 32));
    float l = 0.f;
#pragma unroll
    for (int ch = 0; ch < NCH; ++ch) {
#pragma unroll
        for (int xy = 0; xy < 2; ++xy)
#pragma unroll
            for (int r = 0; r < 4; ++r) { const float e = __builtin_amdgcn_exp2f(S[ch][xy][r] - mx); S[ch][xy][r] = e; l += e; }
        u32x4 w; w.x = pkbf(S[ch][0][0], S[ch][0][1]); w.y = pkbf(S[ch][0][2], S[ch][0][3]); w.z = pkbf(S[ch][1][0], S[ch][1][1]); w.w = pkbf(S[ch][1][2], S[ch][1][3]);
        pa[ch] = __builtin_bit_cast(bf16x8, w);
    }
    l += __shfl_xor(l, 16); l += __shfl_xor(l, 32);
    mx_out = mx; l_out = l;
}
template <int NCH, int CSB> __device__ __forceinline__ void pv_accum(const LAS unsigned char* vb, const bf16x8 (&pa)[NCH], f32x4 (&o)[4]) {
#pragma unroll
    for (int ch = 0; ch < NCH; ++ch)
#pragma unroll
        for (int nt = 0; nt < 4; ++nt) {
            const v4i16_t t0 = __builtin_amdgcn_ds_read_tr16_b64_v4i16((LAS v4i16_t*)(vb + ch * CSB + nt * 32));
            const v4i16_t t1 = __builtin_amdgcn_ds_read_tr16_b64_v4i16((LAS v4i16_t*)(vb + ch * CSB + 16 * VROW + nt * 32));
            const bf16x8 vf = {t0[0], t0[1], t0[2], t0[3], t1[0], t1[1], t1[2], t1[3]};
            o[nt] = __builtin_amdgcn_mfma_f32_16x16x32_bf16(vf, pa[ch], o[nt], 0, 0, 0);
        }
}

__device__ __forceinline__ void o_store16(__amdgpu_buffer_rsrc_t rs, size_t elem_off  , const f32x4 (&o)[4], float inv, int g) {
    const bool odd = (g & 1) != 0;
#pragma unroll
    for (int pr = 0; pr < 2; ++pr) {
        const unsigned x0 = pkbf(o[2 * pr][0] * inv, o[2 * pr][1] * inv), x1 = pkbf(o[2 * pr][2] * inv, o[2 * pr][3] * inv);
        const unsigned y0 = pkbf(o[2 * pr + 1][0] * inv, o[2 * pr + 1][1] * inv), y1 = pkbf(o[2 * pr + 1][2] * inv, o[2 * pr + 1][3] * inv);
        auto r0 = __builtin_amdgcn_permlane16_swap(x0, y0, false, false), r1 = __builtin_amdgcn_permlane16_swap(x1, y1, false, false);
        const u32x4 w = {r0[0], r1[0], r0[1], r1[1]};
        const int d0 = 16 * (2 * pr + (odd ? 1 : 0)) + 4 * (g & ~1);
        pg8::wt_store16(rs, (elem_off + d0) * 2, w);
    }
}

__device__ __forceinline__ void lds_barrier() { asm volatile("s_waitcnt lgkmcnt(0)\n\ts_barrier" ::: "memory"); }
struct NaGeo { int b, h, rp, rr, cg, r0, cw; };
__device__ __forceinline__ NaGeo na_geo(int u, int wave) {
    NaGeo z; z.b = u >> 7; z.h = (u >> 4) & 7; z.rp = u & 15; z.rr = 2 * z.rp + (wave >> 2); z.cg = wave & 3;
    z.r0 = min(max(z.rr - 4, 0), 24); z.cw = min(max(16 * z.cg - 8, 0), 32); return z;
}
__device__ __forceinline__ void na_qload(const bf16_t* QKV, const NaGeo& z, int lane, bf16x8& qf0, bf16x8& qf1) {
    const bf16_t* qp = QKV + (((size_t)z.b * 48 + z.h) * SEQ + z.rr * 64 + 16 * z.cg + (lane & 15)) * 64 + 8 * (lane >> 4);
    qf0 = *(const bf16x8*)qp; qf1 = *(const bf16x8*)(qp + 32);
}
__device__ __forceinline__ void na_kload(const bf16_t* QKV, const NaGeo& z, int hf, int lane, bf16x8 (&kf)[4][2][2]) {
#pragma unroll
    for (int c4 = 0; c4 < 4; ++c4)
#pragma unroll
        for (int xy = 0; xy < 2; ++xy) {
            const bf16_t* kp = QKV + (((size_t)z.b * 48 + 8 + z.h) * SEQ + (z.r0 + 4 * hf + c4) * 64 + z.cw + 16 * xy + (lane & 15)) * 64 + 8 * (lane >> 4);
            kf[c4][xy][0] = *(const bf16x8*)kp; kf[c4][xy][1] = *(const bf16x8*)(kp + 32);
        }
}
__device__ __forceinline__ void s_mfma4(const bf16x8 (&kf)[4][2][2], const bf16x8 qf0, const bf16x8 qf1, f32x4 (&S)[8][2], int base) {
#pragma unroll
    for (int c4 = 0; c4 < 4; ++c4)
#pragma unroll
        for (int xy = 0; xy < 2; ++xy) S[base + c4][xy] = __builtin_amdgcn_mfma_f32_16x16x32_bf16(kf[c4][xy][0], qf0, (f32x4){0.f, 0.f, 0.f, 0.f}, 0, 0, 0);
#pragma unroll
    for (int c4 = 0; c4 < 4; ++c4)
#pragma unroll
        for (int xy = 0; xy < 2; ++xy) S[base + c4][xy] = __builtin_amdgcn_mfma_f32_16x16x32_bf16(kf[c4][xy][1], qf1, S[base + c4][xy], 0, 0, 0);
}
__device__ __forceinline__ void na_unit(const Params& p, LAS unsigned char* lds, int u, int un, int tid, int lane, int wave, bf16x8 (&kfA)[4][2][2], bf16x8 (&kfB)[4][2][2], bf16x8& qf0, bf16x8& qf1) {
    const bf16_t* QKV = (const bf16_t*)(p.ws + WS_QKV);
    const LAS float* rpb = (const LAS float*)(lds + RPB_OFF) + 64;
    const NaGeo z = na_geo(u, wave);
    const int b = z.b, h = z.h, rp = z.rp, rr = z.rr, cg = z.cg, r0 = z.r0, cw = z.cw;
    const int q = lane & 15, g = lane >> 4, c = 16 * cg + q, c0 = min(max(c - 8, 0), 48);
    const int vbase = min(max(2 * rp - 4, 0), 24);
    const size_t tb = (size_t)b * SEQ;
    f32x4 S[8][2];
    s_mfma4(kfA, qf0, qf1, S, 0);
    s_mfma4(kfB, qf0, qf1, S, 4);
    __builtin_amdgcn_sched_barrier(0);
    u32x4 vreg[9];
    const int vr = tid >> 3, vpiece = tid & 7;
#pragma unroll
    for (int ps = 0; ps < 9; ++ps) { const int kr = min(vbase + ps, 31);
        vreg[ps] = *(const u32x4*)(QKV + (((size_t)b * 48 + 16 + h) * SEQ + kr * 64 + vr) * 64 + vpiece * 8); }
    const int thr = c0 - cw;
    const int bbase = h * 465 + (r0 - rr + 7) * 31 + (cw + 4 * g - c + 15);
    bool ux[4]; int bi[4];
#pragma unroll
    for (int r = 0; r < 4; ++r) { ux[r] = (4 * g + r) >= thr; bi[r] = bbase + r + (ux[r] ? 0 : 16); }
    f32x4 Sm[8];
#pragma unroll
    for (int ch = 0; ch < 8; ++ch)
#pragma unroll
        for (int r = 0; r < 4; ++r) Sm[ch][r] = (ux[r] ? S[ch][0][r] : S[ch][1][r]) + rpb[bi[r] + ch * 31];
    bf16x8 pa[8]; float mx, l;
    {
        float m0 = -1e30f, m1 = -1e30f;
#pragma unroll
        for (int ch = 0; ch < 8; ++ch) { m0 = fmaxf(m0, fmaxf(Sm[ch][0], Sm[ch][1])); m1 = fmaxf(m1, fmaxf(Sm[ch][2], Sm[ch][3])); }
        mx = fmaxf(m0, m1);
        mx = fmaxf(mx, __shfl_xor(mx, 16)); mx = fmaxf(mx, __shfl_xor(mx, 32));
        l = 0.f;
#pragma unroll
        for (int ch = 0; ch < 8; ++ch) {
            float ex[4], ey[4];
#pragma unroll
            for (int r = 0; r < 4; ++r) { const float e = __builtin_amdgcn_exp2f(Sm[ch][r] - mx); l += e; ex[r] = ux[r] ? e : 0.f; ey[r] = ux[r] ? 0.f : e; }
            u32x4 w; w.x = pkbf(ex[0], ex[1]); w.y = pkbf(ex[2], ex[3]); w.z = pkbf(ey[0], ey[1]); w.w = pkbf(ey[2], ey[3]);
            pa[ch] = __builtin_bit_cast(bf16x8, w);
        }
        l += __shfl_xor(l, 16); l += __shfl_xor(l, 32);
    }
    __builtin_amdgcn_sched_barrier(0);
    { const NaGeo zn = na_geo(un, wave); na_qload(QKV, zn, lane, qf0, qf1); na_kload(QKV, zn, 0, lane, kfA); na_kload(QKV, zn, 1, lane, kfB); }
    __builtin_amdgcn_sched_barrier(0);
    lds_barrier();
#pragma unroll
    for (int ps = 0; ps < 9; ++ps) *(LAS u32x4*)(lds + (ps * 64 + vr) * VROW + vpiece * 16) = vreg[ps];
    lds_barrier();
    f32x4 o[4];
#pragma unroll
    for (int nt = 0; nt < 4; ++nt) o[nt] = (f32x4){0.f, 0.f, 0.f, 0.f};
    const int i16 = lane & 15, qq = i16 >> 2, pp = i16 & 3;
    const LAS unsigned char* vb = lds + ((r0 - vbase) * 64 + cw + 4 * g + qq) * VROW + pp * 8;
    pv_accum<8, 64 * VROW>(vb, pa, o);
    const float inv = 1.f / l;
    o_store16(pg8::wt_rsrc(p.ws + WS_ONA), (tb + rr * 64 + c) * 512 + h * 64, o, inv, g);
}

struct DilGeo { int b, h, cfg, Dl, L, rho, m0; };
__device__ __forceinline__ DilGeo dil_geo(int v) {
    DilGeo z; z.b = v / 384; int rem = v - z.b * 384; z.h = rem / 48; rem -= z.h * 48; z.cfg = rem >> 4; const int sub = rem & 15;
    z.Dl = z.cfg * 2; z.L = SEQ >> z.Dl; const int nbl = 4 - z.Dl; z.rho = sub >> nbl; z.m0 = (sub & ((1 << nbl) - 1)) * 128; return z;
}
constexpr int DIL_KOFF = 0, DIL_VOFF = 272 * VROW;
struct DilRegs { u32x4 k[4], v[4]; bf16x8 qf0, qf1; };
__device__ __forceinline__ void dil_prefetch(const bf16_t* QKV, const DilGeo& z, int tid, int lane, int wave, DilRegs& R) {
    const int vr = tid >> 3, vpiece = tid & 7;
#pragma unroll
    for (int ps = 0; ps < 4; ++ps) { const int j = ps * 64 + vr; const int mm = min(max(z.m0 - 64 + j, 0), z.L - 1);
        const size_t tok = ((size_t)mm << z.Dl) + z.rho;
        R.k[ps] = *(const u32x4*)(QKV + (((size_t)z.b * 48 + 32 + z.h) * SEQ + tok) * 64 + vpiece * 8);
        R.v[ps] = *(const u32x4*)(QKV + (((size_t)z.b * 48 + 40 + z.h) * SEQ + tok) * 64 + vpiece * 8); }
    const int mq = z.m0 + 16 * wave + (lane & 15);
    const bf16_t* qp = QKV + (((size_t)z.b * 48 + 24 + z.h) * SEQ + ((size_t)mq << z.Dl) + z.rho) * 64 + 8 * (lane >> 4);
    R.qf0 = *(const bf16x8*)qp; R.qf1 = *(const bf16x8*)(qp + 32);
}
__device__ __forceinline__ void dil_unit(const Params& p, LAS unsigned char* lds, int v, int vn, int tid, int lane, int wave, DilRegs& R) {
    const bf16_t* QKV = (const bf16_t*)(p.ws + WS_QKV);
    const DilGeo z = dil_geo(v);
    const int h = z.h, cfg = z.cfg, Dl = z.Dl, L = z.L, rho = z.rho, m0 = z.m0;
    const int q = lane & 15, g = lane >> 4;
    const size_t tb = (size_t)z.b * SEQ;
    const int mq = m0 + 16 * wave + q;
    const int vr = tid >> 3, vpiece = tid & 7;
    lds_barrier();
#pragma unroll
    for (int ps = 0; ps < 4; ++ps) { const int j = ps * 64 + vr;
        *(LAS u32x4*)(lds + DIL_KOFF + j * VROW + vpiece * 16) = R.k[ps]; *(LAS u32x4*)(lds + DIL_VOFF + j * VROW + vpiece * 16) = R.v[ps]; }
    const bf16x8 qf0 = R.qf0, qf1 = R.qf1;
    lds_barrier();
    { const DilGeo zn = dil_geo(vn); dil_prefetch(QKV, zn, tid, lane, wave, R); }
    TabRow trw; const bool tconv = v < 2 * NEXP / 8;
    tab_row_load(p, tconv ? 8 * v + wave : 0, lane, trw);
    __builtin_amdgcn_sched_barrier(0);
    f32x4 S[5][2];
    {
        const LAS unsigned char* kb = lds + DIL_KOFF + (16 * wave + q) * VROW + 16 * g;
#pragma unroll
        for (int ch = 0; ch < 5; ++ch)
#pragma unroll
            for (int xy = 0; xy < 2; ++xy) S[ch][xy] = __builtin_amdgcn_mfma_f32_16x16x32_bf16(*(const LAS bf16x8*)(kb + (32 * ch + 16 * xy) * VROW), qf0, (f32x4){0.f, 0.f, 0.f, 0.f}, 0, 0, 0);
#pragma unroll
        for (int ch = 0; ch < 5; ++ch)
#pragma unroll
            for (int xy = 0; xy < 2; ++xy) S[ch][xy] = __builtin_amdgcn_mfma_f32_16x16x32_bf16(*(const LAS bf16x8*)(kb + (32 * ch + 16 * xy) * VROW + 64), qf1, S[ch][xy], 0, 0, 0);
    }
    const float slope2 = __builtin_amdgcn_exp2f(-(float)(h + 1)) * (float)(1 << Dl) * LOG2E;
#pragma unroll
    for (int ch = 0; ch < 5; ++ch)
#pragma unroll
        for (int xy = 0; xy < 2; ++xy)
#pragma unroll
            for (int r = 0; r < 4; ++r) { const int delta = 32 * ch + 16 * xy + 4 * g + r - 64 - q, ad = delta < 0 ? -delta : delta, mm = mq + delta;
                const bool valid = (ad <= 64) && (mm >= 0) && (mm < L);
                S[ch][xy][r] = valid ? S[ch][xy][r] - slope2 * (float)ad : -1e30f; }
    bf16x8 pa[5]; float mx, l;
    softmax_pack<5>(S, pa, mx, l);
    f32x4 o[4];
#pragma unroll
    for (int nt = 0; nt < 4; ++nt) o[nt] = (f32x4){0.f, 0.f, 0.f, 0.f};
    const int i16 = lane & 15, qq = i16 >> 2, pp = i16 & 3;
    const LAS unsigned char* vb = lds + DIL_VOFF + (16 * wave + 4 * g + qq) * VROW + pp * 8;
    pv_accum<5, 32 * VROW>(vb, pa, o);
    const float inv = 1.f / l;
    int g7 = g; asm volatile("" : "+v"(g7));
    const size_t tq = tb + ((size_t)(m0 + 16 * wave + (lane & 15)) << Dl) + rho;
    o_store16(pg8::wt_rsrc(p.ws + WS_OD), (size_t)cfg * TOK * 512 + tq * 512 + h * 64, o, inv, g7);
    if (g7 == 0) ((float*)(p.ws + WS_LSE))[((size_t)cfg * TOK + tq) * 8 + h] = mx + __builtin_amdgcn_logf(l);
    if (tconv) tab_row_finish(p, 8 * v + wave, lane, trw);
}

__device__ __forceinline__ void attn_phase(const Params& p, LAS unsigned char* lds, int tid, int lane, int wave, int vcu, int G) {
    const bf16_t* QKV = (const bf16_t*)(p.ws + WS_QKV);
    LAS float* rp = (LAS float*)(lds + RPB_OFF);
    for (int i = tid; i < 64 + 8 * 465 + 64; i += 512) { const int k = i - 64; rp[i] = (k >= 0 && k < 8 * 465) ? p.na_rpb[k] * LOG2E : 0.f; }
    __syncthreads();
    {
        bf16x8 kfA[4][2][2], kfB[4][2][2], qf0, qf1;
        int u = vcu;
        if (u < NUNIT_NA) { const NaGeo z = na_geo(u, wave); na_qload(QKV, z, lane, qf0, qf1); na_kload(QKV, z, 0, lane, kfA); na_kload(QKV, z, 1, lane, kfB); }
        for (; u < NUNIT_NA; u += G) na_unit(p, lds, u, (u + G < NUNIT_NA) ? u + G : u, tid, lane, wave, kfA, kfB, qf0, qf1);
    }
    {
        DilRegs R0, R1;
        int v = vcu;
        lds_barrier();
        if (tid < 16 * 8) { const int j = 256 + (tid >> 3); *(LAS u32x4*)(lds + DIL_KOFF + j * VROW + (tid & 7) * 16) = (u32x4){0u, 0u, 0u, 0u}; *(LAS u32x4*)(lds + DIL_VOFF + j * VROW + (tid & 7) * 16) = (u32x4){0u, 0u, 0u, 0u}; }
        if (v < NUNIT_DIL) { const DilGeo z = dil_geo(v); dil_prefetch(QKV, z, tid, lane, wave, R0); }
        if (v + G < NUNIT_DIL) { const DilGeo z = dil_geo(v + G); dil_prefetch(QKV, z, tid, lane, wave, R1); }
        for (; v < NUNIT_DIL; v += 2 * G) {
            dil_unit(p, lds, v, (v + 2 * G < NUNIT_DIL) ? v + 2 * G : v, tid, lane, wave, R0);
            if (v + G < NUNIT_DIL) dil_unit(p, lds, v + G, (v + 3 * G < NUNIT_DIL) ? v + 3 * G : v + G, tid, lane, wave, R1);
        }
    }
}

__device__ __forceinline__ void unpack8(const u32x4 w, float (&f)[8]) { f[0] = bf_lo(w.x); f[1] = bf_hi(w.x); f[2] = bf_lo(w.y); f[3] = bf_hi(w.y); f[4] = bf_lo(w.z); f[5] = bf_hi(w.z); f[6] = bf_lo(w.w); f[7] = bf_hi(w.w); }
__device__ __forceinline__ void quant_rows(const bf16_t* W, unsigned char* Q, float* S, int R, int gw, int NGW, int lane) {
    for (int n = gw; n < R; n += NGW) {
        float f[16]; { float a[8], b[8]; unpack8(*((const u32x4*)(W + (size_t)n * DM) + 2 * lane), a); unpack8(*((const u32x4*)(W + (size_t)n * DM) + 2 * lane + 1), b);
#pragma unroll
            for (int e = 0; e < 8; ++e) { f[e] = a[e]; f[8 + e] = b[e]; } }
        float am = 0.f;
#pragma unroll
        for (int e = 0; e < 16; ++e) am = fmaxf(am, fabsf(f[e]));
#pragma unroll
        for (int o = 1; o < 64; o <<= 1) am = fmaxf(am, __shfl_xor(am, o));
        const float inv = am > 0.f ? 127.f / am : 0.f;
        u32x4 w;
#pragma unroll
        for (int c = 0; c < 4; ++c) { const int q0 = (int)rintf(f[4 * c] * inv), q1 = (int)rintf(f[4 * c + 1] * inv), q2 = (int)rintf(f[4 * c + 2] * inv), q3 = (int)rintf(f[4 * c + 3] * inv);
            w[c] = ((unsigned)q0 & 255u) | (((unsigned)q1 & 255u) << 8) | (((unsigned)q2 & 255u) << 16) | ((unsigned)q3 << 24); }
        *((u32x4*)(Q + (size_t)n * DM) + lane) = w;
        if (lane == 0) S[n] = am * (1.f / 127.f);
    }
}
__device__ __forceinline__ void merge_norm(const Params& p, int gw, int NGW, int lane) {
    const bf16_t* ONA = (const bf16_t*)(p.ws + WS_ONA); const bf16_t* OD = (const bf16_t*)(p.ws + WS_OD); const float* LSE = (const float*)(p.ws + WS_LSE);
    unsigned char* Hn = p.ws + WS_H; float* SHB = (float*)(p.ws + WS_SHB);
    for (int t = gw; t < TOK; t += NGW) {
        float na[8], d0[8], d1[8], d2[8];
        unpack8(__builtin_nontemporal_load((const u32x4*)(ONA + (size_t)t * 512 + 8 * lane)), na);
        unpack8(__builtin_nontemporal_load((const u32x4*)(OD + (size_t)t * 512 + 8 * lane)), d0);
        unpack8(__builtin_nontemporal_load((const u32x4*)(OD + ((size_t)TOK + t) * 512 + 8 * lane)), d1);
        unpack8(__builtin_nontemporal_load((const u32x4*)(OD + ((size_t)2 * TOK + t) * 512 + 8 * lane)), d2);
        const int hh = lane >> 3;
        const float l0 = LSE[(size_t)t * 8 + hh], l1 = LSE[((size_t)TOK + t) * 8 + hh], l2 = LSE[((size_t)2 * TOK + t) * 8 + hh];
        const float m = fmaxf(l0, fmaxf(l1, l2));
        const float e0 = __builtin_amdgcn_exp2f(l0 - m), e1 = __builtin_amdgcn_exp2f(l1 - m), e2 = __builtin_amdgcn_exp2f(l2 - m), ie = 1.f / (e0 + e1 + e2);
        const float al0 = e0 * ie, al1 = e1 * ie, al2 = e2 * ie;
        float ssa = 0.f, ssb = 0.f, dl[8];
#pragma unroll
        for (int k = 0; k < 8; ++k) { dl[k] = al0 * d0[k] + al1 * d1[k] + al2 * d2[k]; ssa += na[k] * na[k]; ssb += dl[k] * dl[k]; }
        const float rsa = rsqrtf(wave_sum(ssa) * (1.f / 512.f) + EPS), rsb = rsqrtf(wave_sum(ssb) * (1.f / 512.f) + EPS);
        float am = 0.f;
#pragma unroll
        for (int k = 0; k < 8; ++k) { na[k] *= rsa; dl[k] *= rsb; am = fmaxf(am, fmaxf(fabsf(na[k]), fabsf(dl[k]))); }
#pragma unroll
        for (int o = 1; o < 64; o <<= 1) am = fmaxf(am, __shfl_xor(am, o));
        const float inv = am > 0.f ? 127.f / am : 0.f;
        u32x2 wa, wb;
#pragma unroll
        for (int c = 0; c < 2; ++c) {
            wa[c] = ((unsigned)(int)rintf(na[4 * c] * inv) & 255u) | (((unsigned)(int)rintf(na[4 * c + 1] * inv) & 255u) << 8) | (((unsigned)(int)rintf(na[4 * c + 2] * inv) & 255u) << 16) | ((unsigned)(int)rintf(na[4 * c + 3] * inv) << 24);
            wb[c] = ((unsigned)(int)rintf(dl[4 * c] * inv) & 255u) | (((unsigned)(int)rintf(dl[4 * c + 1] * inv) & 255u) << 8) | (((unsigned)(int)rintf(dl[4 * c + 2] * inv) & 255u) << 16) | ((unsigned)(int)rintf(dl[4 * c + 3] * inv) << 24); }
        *(u32x2*)(Hn + (size_t)t * DM + 8 * lane) = wa;
        *(u32x2*)(Hn + (size_t)t * DM + 512 + 8 * lane) = wb;
        if (lane == 0) SHB[t] = am * (1.f / 127.f);
    }
}

__device__ __forceinline__ void ce(float& a, float& b) { const float hi = fmaxf(a, b), lo = fminf(a, b); a = hi; b = lo; }
template <int N> __device__ __forceinline__ void bitonic_sort_desc(float (&v)[N]) {
#pragma unroll
    for (int k = 2; k <= N; k <<= 1)
#pragma unroll
        for (int j = k >> 1; j > 0; j >>= 1)
#pragma unroll
            for (int i = 0; i < N; ++i) { const int l = i ^ j; if (l > i) { if ((i & k) == 0) ce(v[i], v[l]); else ce(v[l], v[i]); } }
}
__device__ __forceinline__ void sort16_desc(float (&v)[16]) {
    ce(v[0], v[1]); ce(v[2], v[3]); ce(v[0], v[2]); ce(v[1], v[3]); ce(v[1], v[2]); ce(v[4], v[5]); ce(v[6], v[7]); ce(v[4], v[6]); ce(v[5], v[7]); ce(v[5], v[6]); ce(v[0], v[4]); ce(v[2], v[6]); ce(v[2], v[4]); ce(v[1], v[5]); ce(v[3], v[7]); ce(v[3], v[5]); ce(v[1], v[2]); ce(v[3], v[4]); ce(v[5], v[6]); ce(v[8], v[9]); ce(v[10], v[11]); ce(v[8], v[10]); ce(v[9], v[11]); ce(v[9], v[10]); ce(v[12], v[13]); ce(v[14], v[15]); ce(v[12], v[14]); ce(v[13], v[15]); ce(v[13], v[14]); ce(v[8], v[12]); ce(v[10], v[14]); ce(v[10], v[12]); ce(v[9], v[13]); ce(v[11], v[15]); ce(v[11], v[13]); ce(v[9], v[10]); ce(v[11], v[12]); ce(v[13], v[14]); ce(v[0], v[8]); ce(v[4], v[12]); ce(v[4], v[8]); ce(v[2], v[10]); ce(v[6], v[14]); ce(v[6], v[10]); ce(v[2], v[4]); ce(v[6], v[8]); ce(v[10], v[12]); ce(v[1], v[9]); ce(v[5], v[13]); ce(v[5], v[9]); ce(v[3], v[11]); ce(v[7], v[15]); ce(v[7], v[11]); ce(v[3], v[5]); ce(v[7], v[9]); ce(v[11], v[13]); ce(v[1], v[2]); ce(v[3], v[4]); ce(v[5], v[6]); ce(v[7], v[8]); ce(v[9], v[10]); ce(v[11], v[12]); ce(v[13], v[14]);
}
template <int N> __device__ __forceinline__ void bitonic_merge_desc(float (&v)[N]) {
#pragma unroll
    for (int j = N >> 1; j > 0; j >>= 1)
#pragma unroll
        for (int i = 0; i < N; ++i) if ((i & j) == 0) ce(v[i], v[i | j]);
}
__device__ __forceinline__ float h2f_lo(unsigned u) { return (float)__builtin_bit_cast(_Float16, (unsigned short)(u & 0xffffu)); }
__device__ __forceinline__ float h2f_hi(unsigned u) { return (float)__builtin_bit_cast(_Float16, (unsigned short)(u >> 16)); }
__device__ __forceinline__ void top16_of_128(const LAS unsigned char* row, float (&run)[16]) {
#pragma unroll
    for (int gi = 0; gi < 8; ++gi) {
        float grp[16];
#pragma unroll
        for (int q4 = 0; q4 < 2; ++q4) { const u32x4 v = *(const LAS u32x4*)(row + gi * 32 + q4 * 16);
#pragma unroll
            for (int e = 0; e < 4; ++e) {
                grp[8 * q4 + 2 * e] = __uint_as_float(__float_as_uint(h2f_lo(v[e])) | (unsigned)(gi * 16 + 8 * q4 + 2 * e));
                grp[8 * q4 + 2 * e + 1] = __uint_as_float(__float_as_uint(h2f_hi(v[e])) | (unsigned)(gi * 16 + 8 * q4 + 2 * e + 1)); } }
        sort16_desc(grp);
        if (gi == 0) {
#pragma unroll
            for (int i = 0; i < 16; ++i) run[i] = grp[i];
        } else {
#pragma unroll
            for (int i = 0; i < 16; ++i) run[i] = fmaxf(run[i], grp[15 - i]);
            bitonic_merge_desc<16>(run);
        }
    }
}
#define CAND(i, j) __uint_as_float((__float_as_uint(v1[i] + v2[j]) & ~0xFFu) | (unsigned)((i) * 16 + (j)))
constexpr int TK_ROW = 272;
__device__ __forceinline__ void tk_stage(const _Float16* SC, LAS unsigned char* wb, int t0, int col0, int lane) {
    u32x4 v[16];
#pragma unroll
    for (int i = 0; i < 16; ++i) { const int pi = i * 64 + lane, row = pi >> 4, ch = pi & 15; v[i] = __builtin_nontemporal_load((const u32x4*)(SC + (size_t)(t0 + row) * NPQ + col0 + ch * 8)); }
#pragma unroll
    for (int i = 0; i < 16; ++i) { const int pi = i * 64 + lane, row = pi >> 4, ch = pi & 15; *(LAS u32x4*)(wb + row * TK_ROW + ch * 16) = v[i]; }
}
__device__ __forceinline__ void topk_phase(const Params& p, LAS unsigned char* lds, int gw, int NGW, int lane, int wave) {
    const _Float16* SC = (const _Float16*)(p.ws + WS_SC);
    unsigned* IDS = (unsigned*)(p.ws + WS_IDS); float* GATES = (float*)(p.ws + WS_GATES);
    LAS unsigned char* wb = lds + wave * (64 * TK_ROW);
    LAS unsigned char* my = wb + lane * TK_ROW;
    const float NEG = -3.0e38f;
    for (int wi = gw; wi < (TOK / 64) * 8; wi += NGW) {
        const int t0 = (wi >> 3) * 64, hh = wi & 7, it = (t0 + lane) * 8 + hh;
        float v1[16], v2[16];
        tk_stage(SC, wb, t0, hh * 256, lane);
        top16_of_128(my, v1);
        tk_stage(SC, wb, t0, hh * 256 + 128, lane);
        top16_of_128(my, v2);
        {
            u32x4 w1, w2;
#define PK4(v, o) ((__float_as_uint(v[o]) & 0x7Fu) | ((__float_as_uint(v[o + 1]) & 0x7Fu) << 8) | ((__float_as_uint(v[o + 2]) & 0x7Fu) << 16) | ((__float_as_uint(v[o + 3]) & 0x7Fu) << 24))
            w1.x = PK4(v1, 0); w1.y = PK4(v1, 4); w1.z = PK4(v1, 8); w1.w = PK4(v1, 12);
            w2.x = PK4(v2, 0); w2.y = PK4(v2, 4); w2.z = PK4(v2, 8); w2.w = PK4(v2, 12);
#undef PK4
            *(LAS u32x4*)my = w1; *(LAS u32x4*)(my + 16) = w2;
        }
        float best[16], grp[16];
        best[0] = CAND(0, 0); best[1] = CAND(0, 1); best[2] = CAND(0, 2); best[3] = CAND(0, 3); best[4] = CAND(0, 4); best[5] = CAND(0, 5); best[6] = CAND(0, 6); best[7] = CAND(0, 7);
        best[8] = CAND(0, 8); best[9] = CAND(0, 9); best[10] = CAND(0, 10); best[11] = CAND(0, 11); best[12] = CAND(0, 12); best[13] = CAND(0, 13); best[14] = CAND(0, 14); best[15] = CAND(0, 15);
        sort16_desc(best);
        grp[0] = CAND(1, 0); grp[1] = CAND(1, 1); grp[2] = CAND(1, 2); grp[3] = CAND(1, 3); grp[4] = CAND(1, 4); grp[5] = CAND(1, 5); grp[6] = CAND(1, 6); grp[7] = CAND(1, 7);
        grp[8] = CAND(2, 0); grp[9] = CAND(2, 1); grp[10] = CAND(2, 2); grp[11] = CAND(2, 3); grp[12] = CAND(2, 4); grp[13] = CAND(3, 0); grp[14] = CAND(3, 1); grp[15] = CAND(3, 2);
        sort16_desc(grp);
#pragma unroll
        for (int i = 0; i < 16; ++i) best[i] = fmaxf(best[i], grp[15 - i]);
        bitonic_merge_desc<16>(best);
        grp[0] = CAND(3, 3); grp[1] = CAND(4, 0); grp[2] = CAND(4, 1); grp[3] = CAND(4, 2); grp[4] = CAND(5, 0); grp[5] = CAND(5, 1); grp[6] = CAND(6, 0); grp[7] = CAND(6, 1);
        grp[8] = CAND(7, 0); grp[9] = CAND(7, 1); grp[10] = CAND(8, 0); grp[11] = CAND(9, 0); grp[12] = CAND(10, 0); grp[13] = CAND(11, 0); grp[14] = CAND(12, 0); grp[15] = CAND(13, 0);
        sort16_desc(grp);
#pragma unroll
        for (int i = 0; i < 16; ++i) best[i] = fmaxf(best[i], grp[15 - i]);
        bitonic_merge_desc<16>(best);
        grp[0] = CAND(14, 0); grp[1] = CAND(15, 0);
#pragma unroll
        for (int i = 2; i < 16; ++i) grp[i] = NEG;
        sort16_desc(grp);
#pragma unroll
        for (int i = 0; i < 16; ++i) best[i] = fmaxf(best[i], grp[15 - i]);
        bitonic_merge_desc<16>(best);
        float e[16], sum = 0.f;
#pragma unroll
        for (int k = 0; k < 16; ++k) { e[k] = __expf(best[k] - best[0]); sum += e[k]; }
        const float isum = 1.f / sum;
        int idv[16];
        asm volatile("s_waitcnt lgkmcnt(0)" ::: "memory");
#pragma unroll
        for (int k = 0; k < 16; ++k) { const unsigned code = __float_as_uint(best[k]) & 0xFFu; const unsigned i1 = my[code >> 4], i2 = my[16 + (code & 15u)]; idv[k] = (int)(i1 * 128u + i2); }
        const int tt = it >> 3;
        unsigned* ip = IDS + (size_t)tt * 64 + hh; float* gp = GATES + (size_t)tt * 128 + 2 * hh;
#pragma unroll
        for (int j = 0; j < 8; ++j) {
            ip[8 * j] = (unsigned)idv[j] | ((unsigned)idv[j + 8] << 16);
            *(f32x2_t*)(gp + 16 * j) = (f32x2_t){e[j] * isum, e[j + 8] * isum};
        }
    }
}
#undef CAND

struct Topo { int xi, nx, rank, nloc; };
constexpr int CW_XCNT = 8192;
__device__ __forceinline__ float wave_max(float v) {
#pragma unroll
    for (int o = 1; o < 64; o <<= 1) v = fmaxf(v, __shfl_xor(v, o));
    return v;
}
__device__ __forceinline__ unsigned pack4(int a, int b, int c, int d) { return ((unsigned)a & 255u) | (((unsigned)b & 255u) << 8) | (((unsigned)c & 255u) << 16) | ((unsigned)d << 24); }
template <int CTRL> __device__ __forceinline__ int dppi(int v) { return __builtin_amdgcn_update_dpp(0, v, CTRL, 0xF, 0xF, false); }

#define PE_LOAD_IDS(ids, tok) do { const u32x4* ip_ = (const u32x4*)(IDST + (size_t)(tok) * 64 + 8 * j); ids[0] = ip_[0]; ids[1] = ip_[1]; } while (0)
#define PE_WARM(pf, ptr) asm volatile("s_load_dword %0, %1, 0x0" : "+s"(pf) : "s"(ptr))
#define PE_WARM_DRAIN(pf) asm volatile("s_waitcnt lgkmcnt(0)" : "+s"(pf))
#define PE_LOAD_SEGS(seg, ids, tab) do { _Pragma("unroll") for (int i_ = 0; i_ < 16; ++i_) seg[i_] = *(const u32x4*)((tab) + (size_t)((i_ & 1) ? (ids[i_ >> 3][(i_ >> 1) & 3] >> 16) : (ids[i_ >> 3][(i_ >> 1) & 3] & 0xffffu)) * 128); } while (0)

__device__ __forceinline__ void pe_u_compute(const u32x4 (&seg)[16], const u32x4 h8, unsigned* dst, bool live, int lane) {
    int a[16];
#pragma unroll
    for (int i = 0; i < 16; ++i) { int s_ = 0;
#pragma unroll
        for (int w = 0; w < 4; ++w) s_ = __builtin_amdgcn_sdot4((int)seg[i][w], (int)h8[w], s_, false);
        a[i] = s_; }
    const bool q2 = (lane & 4) != 0, q1 = (lane & 2) != 0, q0 = (lane & 1) != 0;
    int c[8], d[4], e[2];
#pragma unroll
    for (int i = 0; i < 8; ++i) { const int keep = q2 ? a[i + 8] : a[i], send = q2 ? a[i] : a[i + 8]; c[i] = keep + dppi<0x141>(send); }
#pragma unroll
    for (int i = 0; i < 4; ++i) { const int keep = q1 ? c[i + 4] : c[i], send = q1 ? c[i] : c[i + 4]; d[i] = keep + dppi<0x4E>(send); }
#pragma unroll
    for (int i = 0; i < 2; ++i) { const int keep = q0 ? d[i + 2] : d[i], send = q0 ? d[i] : d[i + 2]; e[i] = keep + dppi<0xB1>(send); }
    if (live) *dst = pkh((float)e[0] * (1.f / 64.f), (float)e[1] * (1.f / 64.f));
}
__device__ __forceinline__ void peer_u_phase(const Params& p, const Topo& tp, int lane, int wave) {
    const unsigned* IDST = (const unsigned*)(p.ws + WS_IDS); const unsigned char* H8 = p.ws + WS_H8; unsigned* PART = (unsigned*)(p.ws + WS_PART);
    const int j = lane >> 3, q = lane & 7;
    const int wv = __builtin_amdgcn_readfirstlane(tp.rank * 8 + wave), nwv = __builtin_amdgcn_readfirstlane(tp.nloc * 8);
    for (int s = tp.xi; s < 8; s += tp.nx) {
        const unsigned char* tab = p.ws + WS_UH + (size_t)s * NEXP * 128 + 16 * q;
        const unsigned char* hb = H8 + 128 * s + 16 * q;
        unsigned* pb = PART + (size_t)s * TOK * 64 + j * 8 + q;
        u32x4 idsA[2], idsB[2], segA[16], segB[16], h8A, h8B;
        int t = wv;
        unsigned pf = 0u;
#define PE_WARM_TOK(tok) do { const unsigned* wi_ = IDST + (size_t)(tok) * 64; PE_WARM(pf, wi_); PE_WARM(pf, wi_ + 32); const unsigned char* wh_ = H8 + 128 * s + (size_t)(tok) * 1024; PE_WARM(pf, wh_); } while (0)
#define TC(x) ((x) < TOK ? (x) : TOK - 1)
        PE_LOAD_IDS(idsA, TC(t));
        PE_LOAD_IDS(idsB, TC(t + nwv));
        PE_LOAD_SEGS(segA, idsA, tab); h8A = *(const u32x4*)(hb + (size_t)TC(t) * 1024);
        for (; t < TOK; t += 8 * nwv) {
            PE_LOAD_IDS(idsA, TC(t + (2 + 0) * nwv));
            PE_WARM_TOK(TC(t + (3 + (2 + 0)) * nwv));
            __builtin_amdgcn_sched_barrier(0);
            PE_LOAD_SEGS(segB, idsB, tab); h8B = *(const u32x4*)(hb + (size_t)TC(t + (1 + 0) * nwv) * 1024);
            __builtin_amdgcn_sched_barrier(0);
            pe_u_compute(segA, h8A, pb + (size_t)TC(t + (0) * nwv) * 64, t + (0) * nwv < TOK, lane);
            PE_LOAD_IDS(idsB, TC(t + (3 + 0) * nwv));
            PE_WARM_TOK(TC(t + (3 + (3 + 0)) * nwv));
            __builtin_amdgcn_sched_barrier(0);
            PE_LOAD_SEGS(segA, idsA, tab); h8A = *(const u32x4*)(hb + (size_t)TC(t + (2 + 0) * nwv) * 1024);
            __builtin_amdgcn_sched_barrier(0);
            pe_u_compute(segB, h8B, pb + (size_t)TC(t + (1 + 0) * nwv) * 64, t + (1 + 0) * nwv < TOK, lane);
            PE_LOAD_IDS(idsA, TC(t + (2 + 2) * nwv));
            PE_WARM_TOK(TC(t + (3 + (2 + 2)) * nwv));
            __builtin_amdgcn_sched_barrier(0);
            PE_LOAD_SEGS(segB, idsB, tab); h8B = *(const u32x4*)(hb + (size_t)TC(t + (1 + 2) * nwv) * 1024);
            __builtin_amdgcn_sched_barrier(0);
            pe_u_compute(segA, h8A, pb + (size_t)TC(t + (2) * nwv) * 64, t + (2) * nwv < TOK, lane);
            PE_LOAD_IDS(idsB, TC(t + (3 + 2) * nwv));
            PE_WARM_TOK(TC(t + (3 + (3 + 2)) * nwv));
            __builtin_amdgcn_sched_barrier(0);
            PE_LOAD_SEGS(segA, idsA, tab); h8A = *(const u32x4*)(hb + (size_t)TC(t + (2 + 2) * nwv) * 1024);
            __builtin_amdgcn_sched_barrier(0);
            pe_u_compute(segB, h8B, pb + (size_t)TC(t + (1 + 2) * nwv) * 64, t + (1 + 2) * nwv < TOK, lane);
            PE_LOAD_IDS(idsA, TC(t + (2 + 4) * nwv));
            PE_WARM_TOK(TC(t + (3 + (2 + 4)) * nwv));
            __builtin_amdgcn_sched_barrier(0);
            PE_LOAD_SEGS(segB, idsB, tab); h8B = *(const u32x4*)(hb + (size_t)TC(t + (1 + 4) * nwv) * 1024);
            __builtin_amdgcn_sched_barrier(0);
            pe_u_compute(segA, h8A, pb + (size_t)TC(t + (4) * nwv) * 64, t + (4) * nwv < TOK, lane);
            PE_LOAD_IDS(idsB, TC(t + (3 + 4) * nwv));
            PE_WARM_TOK(TC(t + (3 + (3 + 4)) * nwv));
            __builtin_amdgcn_sched_barrier(0);
            PE_LOAD_SEGS(segA, idsA, tab); h8A = *(const u32x4*)(hb + (size_t)TC(t + (2 + 4) * nwv) * 1024);
            __builtin_amdgcn_sched_barrier(0);
            pe_u_compute(segB, h8B, pb + (size_t)TC(t + (1 + 4) * nwv) * 64, t + (1 + 4) * nwv < TOK, lane);
            PE_LOAD_IDS(idsA, TC(t + (2 + 6) * nwv));
            PE_WARM_TOK(TC(t + (3 + (2 + 6)) * nwv));
            __builtin_amdgcn_sched_barrier(0);
            PE_LOAD_SEGS(segB, idsB, tab); h8B = *(const u32x4*)(hb + (size_t)TC(t + (1 + 6) * nwv) * 1024);
            __builtin_amdgcn_sched_barrier(0);
            pe_u_compute(segA, h8A, pb + (size_t)TC(t + (6) * nwv) * 64, t + (6) * nwv < TOK, lane);
            PE_LOAD_IDS(idsB, TC(t + (3 + 6) * nwv));
            PE_WARM_TOK(TC(t + (3 + (3 + 6)) * nwv));
            __builtin_amdgcn_sched_barrier(0);
            PE_LOAD_SEGS(segA, idsA, tab); h8A = *(const u32x4*)(hb + (size_t)TC(t + (2 + 6) * nwv) * 1024);
            __builtin_amdgcn_sched_barrier(0);
            pe_u_compute(segB, h8B, pb + (size_t)TC(t + (1 + 6) * nwv) * 64, t + (1 + 6) * nwv < TOK, lane);
        }
        PE_WARM_DRAIN(pf);
#undef PE_WARM_TOK
    }
}
__device__ __forceinline__ void peer_w_phase(const Params& p, int gw, int NGW, int lane) {
    const unsigned* IDST = (const unsigned*)(p.ws + WS_IDS); const float* GT = (const float*)(p.ws + WS_GATES); const unsigned* PART = (const unsigned*)(p.ws + WS_PART);
    const float* SU = (const float*)(p.ws + WS_SU); const float* SV = (const float*)(p.ws + WS_SV); const float* SH = (const float*)(p.ws + WS_SH);
    unsigned short* W8 = (unsigned short*)(p.ws + WS_W8); float* SW = (float*)(p.ws + WS_SW);
    for (int t = gw; t < TOK; t += NGW) {
        const size_t ix = (size_t)t * 128 + 2 * lane;
        float a0 = 0.f, a1 = 0.f;
#pragma unroll
        for (int s = 0; s < 8; ++s) { const unsigned v = __builtin_nontemporal_load(PART + (size_t)s * TOK * 64 + (ix >> 1)); a0 += h2f_lo(v); a1 += h2f_hi(v); }
        const unsigned idp = IDST[ix >> 1]; const u32x2 id = {idp & 0xffffu, idp >> 16}; const f32x2_t g = *(const f32x2_t*)(GT + ix);
        const float sh = SH[t];
        const float x0 = a0 * 64.f * SU[id.x] * sh, x1 = a1 * 64.f * SU[id.y] * sh;
        const float w0 = g.x * 0.5f * x0 * (1.f + erff(x0 * 0.70710678118654752f)) * SV[id.x];
        const float w1 = g.y * 0.5f * x1 * (1.f + erff(x1 * 0.70710678118654752f)) * SV[id.y];
        const float wm = wave_max(fmaxf(fabsf(w0), fabsf(w1)));
        const float inv = wm > 0.f ? 127.f / wm : 0.f;
        W8[ix >> 1] = (unsigned short)(((unsigned)((int)rintf(w0 * inv)) & 255u) | (((unsigned)((int)rintf(w1 * inv)) & 255u) << 8));
        if (lane == 0) SW[t] = wm * (1.f / 127.f);
    }
}
__device__ __forceinline__ void pe_v_compute(const u32x4 (&seg)[16], const u32x4 w8, float sw, bf16_t* dst, bool live, int lane) {
    int o[16];
#pragma unroll
    for (int i = 0; i < 16; ++i) o[i] = 0;
#pragma unroll
    for (int qd = 0; qd < 4; ++qd)
#pragma unroll
        for (int w = 0; w < 4; ++w) {
            const unsigned ra = seg[4 * qd][w], rb = seg[4 * qd + 1][w], rc = seg[4 * qd + 2][w], rd = seg[4 * qd + 3][w];
            const unsigned abl = __builtin_amdgcn_perm(rb, ra, 0x05010400u), abh = __builtin_amdgcn_perm(rb, ra, 0x07030602u);
            const unsigned cdl = __builtin_amdgcn_perm(rd, rc, 0x05010400u), cdh = __builtin_amdgcn_perm(rd, rc, 0x07030602u);
            o[4 * w + 0] = __builtin_amdgcn_sdot4((int)__builtin_amdgcn_perm(cdl, abl, 0x05040100u), (int)w8[qd], o[4 * w + 0], false);
            o[4 * w + 1] = __builtin_amdgcn_sdot4((int)__builtin_amdgcn_perm(cdl, abl, 0x07060302u), (int)w8[qd], o[4 * w + 1], false);
            o[4 * w + 2] = __builtin_amdgcn_sdot4((int)__builtin_amdgcn_perm(cdh, abh, 0x05040100u), (int)w8[qd], o[4 * w + 2], false);
            o[4 * w + 3] = __builtin_amdgcn_sdot4((int)__builtin_amdgcn_perm(cdh, abh, 0x07060302u), (int)w8[qd], o[4 * w + 3], false);
        }
    int b[8], c[4], d[2];
#pragma unroll
    for (int m = 0; m < 8; ++m) { auto r = __builtin_amdgcn_permlane32_swap((unsigned)o[m], (unsigned)o[m + 8], false, false); b[m] = (int)r[0] + (int)r[1]; }
#pragma unroll
    for (int m = 0; m < 4; ++m) { auto r = __builtin_amdgcn_permlane16_swap((unsigned)b[m], (unsigned)b[m + 4], false, false); c[m] = (int)r[0] + (int)r[1]; }
    const bool b3 = (lane & 8) != 0;
#pragma unroll
    for (int m = 0; m < 2; ++m) { const int keep = b3 ? c[m + 2] : c[m], send = b3 ? c[m] : c[m + 2]; d[m] = keep + dppi<0x128>(send); }
    if (live) *(unsigned*)dst = pkbf((float)d[0] * sw, (float)d[1] * sw);
}
__device__ __forceinline__ void peer_v_phase(const Params& p, const Topo& tp, int lane, int wave) {
    const unsigned* IDST = (const unsigned*)(p.ws + WS_IDS); const unsigned char* W8 = p.ws + WS_W8; const float* SW = (const float*)(p.ws + WS_SW); bf16_t* PEER = (bf16_t*)(p.ws + WS_PEER);
    const int j = lane >> 3, q = lane & 7;
    const int wv = __builtin_amdgcn_readfirstlane(tp.rank * 8 + wave), nwv = __builtin_amdgcn_readfirstlane(tp.nloc * 8);
    for (int s = tp.xi; s < 8; s += tp.nx) {
        const unsigned char* tab = p.ws + WS_VH + (size_t)s * NEXP * 128 + 16 * q;
        const unsigned char* wb = W8 + 16 * j;
        bf16_t* ob = PEER + 128 * s + 16 * q + 2 * j;
        u32x4 idsA[2], idsB[2], segA[16], segB[16], w8A, w8B; float swA, swB;
        int t = wv;
        unsigned pf = 0u;
#define PE_WARM_TOK(tok) do { const unsigned* wi_ = IDST + (size_t)(tok) * 64; PE_WARM(pf, wi_); PE_WARM(pf, wi_ + 32); const unsigned char* ww_ = W8 + (size_t)(tok) * 128; PE_WARM(pf, ww_); } while (0)
        PE_LOAD_IDS(idsA, TC(t));
        PE_LOAD_IDS(idsB, TC(t + nwv));
        PE_LOAD_SEGS(segA, idsA, tab); w8A = *(const u32x4*)(wb + (size_t)TC(t) * 128); swA = SW[TC(t)];
        for (; t < TOK; t += 8 * nwv) {
            PE_LOAD_IDS(idsA, TC(t + (2 + 0) * nwv));
            PE_WARM_TOK(TC(t + (3 + (2 + 0)) * nwv));
            __builtin_amdgcn_sched_barrier(0);
            PE_LOAD_SEGS(segB, idsB, tab); w8B = *(const u32x4*)(wb + (size_t)TC(t + (1 + 0) * nwv) * 128); swB = SW[TC(t + (1 + 0) * nwv)];
            __builtin_amdgcn_sched_barrier(0);
            pe_v_compute(segA, w8A, swA, ob + (size_t)TC(t + (0) * nwv) * DM, t + (0) * nwv < TOK, lane);
            PE_LOAD_IDS(idsB, TC(t + (3 + 0) * nwv));
            PE_WARM_TOK(TC(t + (3 + (3 + 0)) * nwv));
            __builtin_amdgcn_sched_barrier(0);
            PE_LOAD_SEGS(segA, idsA, tab); w8A = *(const u32x4*)(wb + (size_t)TC(t + (2 + 0) * nwv) * 128); swA = SW[TC(t + (2 + 0) * nwv)];
            __builtin_amdgcn_sched_barrier(0);
            pe_v_compute(segB, w8B, swB, ob + (size_t)TC(t + (1 + 0) * nwv) * DM, t + (1 + 0) * nwv < TOK, lane);
            PE_LOAD_IDS(idsA, TC(t + (2 + 2) * nwv));
            PE_WARM_TOK(TC(t + (3 + (2 + 2)) * nwv));
            __builtin_amdgcn_sched_barrier(0);
            PE_LOAD_SEGS(segB, idsB, tab); w8B = *(const u32x4*)(wb + (size_t)TC(t + (1 + 2) * nwv) * 128); swB = SW[TC(t + (1 + 2) * nwv)];
            __builtin_amdgcn_sched_barrier(0);
            pe_v_compute(segA, w8A, swA, ob + (size_t)TC(t + (2) * nwv) * DM, t + (2) * nwv < TOK, lane);
            PE_LOAD_IDS(idsB, TC(t + (3 + 2) * nwv));
            PE_WARM_TOK(TC(t + (3 + (3 + 2)) * nwv));
            __builtin_amdgcn_sched_barrier(0);
            PE_LOAD_SEGS(segA, idsA, tab); w8A = *(const u32x4*)(wb + (size_t)TC(t + (2 + 2) * nwv) * 128); swA = SW[TC(t + (2 + 2) * nwv)];
            __builtin_amdgcn_sched_barrier(0);
            pe_v_compute(segB, w8B, swB, ob + (size_t)TC(t + (1 + 2) * nwv) * DM, t + (1 + 2) * nwv < TOK, lane);
            PE_LOAD_IDS(idsA, TC(t + (2 + 4) * nwv));
            PE_WARM_TOK(TC(t + (3 + (2 + 4)) * nwv));
            __builtin_amdgcn_sched_barrier(0);
            PE_LOAD_SEGS(segB, idsB, tab); w8B = *(const u32x4*)(wb + (size_t)TC(t + (1 + 4) * nwv) * 128); swB = SW[TC(t + (1 + 4) * nwv)];
            __builtin_amdgcn_sched_barrier(0);
            pe_v_compute(segA, w8A, swA, ob + (size_t)TC(t + (4) * nwv) * DM, t + (4) * nwv < TOK, lane);
            PE_LOAD_IDS(idsB, TC(t + (3 + 4) * nwv));
            PE_WARM_TOK(TC(t + (3 + (3 + 4)) * nwv));
            __builtin_amdgcn_sched_barrier(0);
            PE_LOAD_SEGS(segA, idsA, tab); w8A = *(const u32x4*)(wb + (size_t)TC(t + (2 + 4) * nwv) * 128); swA = SW[TC(t + (2 + 4) * nwv)];
            __builtin_amdgcn_sched_barrier(0);
            pe_v_compute(segB, w8B, swB, ob + (size_t)TC(t + (1 + 4) * nwv) * DM, t + (1 + 4) * nwv < TOK, lane);
            PE_LOAD_IDS(idsA, TC(t + (2 + 6) * nwv));
            PE_WARM_TOK(TC(t + (3 + (2 + 6)) * nwv));
            __builtin_amdgcn_sched_barrier(0);
            PE_LOAD_SEGS(segB, idsB, tab); w8B = *(const u32x4*)(wb + (size_t)TC(t + (1 + 6) * nwv) * 128); swB = SW[TC(t + (1 + 6) * nwv)];
            __builtin_amdgcn_sched_barrier(0);
            pe_v_compute(segA, w8A, swA, ob + (size_t)TC(t + (6) * nwv) * DM, t + (6) * nwv < TOK, lane);
            PE_LOAD_IDS(idsB, TC(t + (3 + 6) * nwv));
            PE_WARM_TOK(TC(t + (3 + (3 + 6)) * nwv));
            __builtin_amdgcn_sched_barrier(0);
            PE_LOAD_SEGS(segA, idsA, tab); w8A = *(const u32x4*)(wb + (size_t)TC(t + (2 + 6) * nwv) * 128); swA = SW[TC(t + (2 + 6) * nwv)];
            __builtin_amdgcn_sched_barrier(0);
            pe_v_compute(segB, w8B, swB, ob + (size_t)TC(t + (1 + 6) * nwv) * DM, t + (1 + 6) * nwv < TOK, lane);
        }
        PE_WARM_DRAIN(pf);
#undef PE_WARM_TOK
    }
}
#undef TC
#undef PE_LOAD_IDS
#undef PE_LOAD_SEGS
#undef PE_WARM
#undef PE_WARM_DRAIN
__device__ __forceinline__ void final_phase(const Params& p, float* dstbase, int gw, int NGW, int lane) {
    const float* mod = (const float*)(p.ws + WS_MOD); const bf16_t* PEER = (const bf16_t*)(p.ws + WS_PEER);
    f32x4 fg[4];
#pragma unroll
    for (int j = 0; j < 4; ++j) fg[j] = *(const f32x4*)(p.final_g + 4 * lane + 256 * j);
    const __amdgpu_buffer_rsrc_t ors = pg8::wt_rsrc(dstbase);
    for (int t = gw; t < TOK; t += NGW) {
        const float* mb = mod + (size_t)(t >> 11) * 6144 + 5120;
        const f32x4* xr = (const f32x4*)(p.x + (size_t)t * DM) + lane; const u32x2* pr = (const u32x2*)(PEER + (size_t)t * DM) + lane; const u32x2* zr = (const u32x2*)((const bf16_t*)(p.ws + WS_Z) + (size_t)t * DM) + lane;
        f32x4* xw = (f32x4*)(dstbase + (size_t)t * DM) + lane;
        f32x4 x2[4]; float ss = 0.f;
#pragma unroll
        for (int j = 0; j < 4; ++j) { const f32x4 g2 = *(const f32x4*)(mb + 4 * lane + 256 * j); const u32x2 pv = __builtin_nontemporal_load(pr + 64 * j), zv = __builtin_nontemporal_load(zr + 64 * j); x2[j] = __builtin_nontemporal_load(xr + 64 * j) + (f32x4){bf_lo(zv.x), bf_hi(zv.x), bf_lo(zv.y), bf_hi(zv.y)} + g2 * (f32x4){bf_lo(pv.x), bf_hi(pv.x), bf_lo(pv.y), bf_hi(pv.y)};
            ss += (x2[j][0] * x2[j][0] + x2[j][1] * x2[j][1]) + (x2[j][2] * x2[j][2] + x2[j][3] * x2[j][3]); }
        const float rs = rsqrtf(wave_sum(ss) * (1.f / DM) + EPS);
#pragma unroll
        for (int j = 0; j < 4; ++j) pg8::wt_store16(ors, ((size_t)t * DM + 4 * lane + 256 * j) * 4, __builtin_bit_cast(u32x4, x2[j] * rs * fg[j]));
    }
}

#ifndef MK_PROF_PHASE
#define MK_PROF_PHASE -1
#endif
#ifndef MK_PROF_MULT
#define MK_PROF_MULT 4
#endif
__global__ void __launch_bounds__(512, 2) mk_fwd(Params p) {
    extern __shared__ __attribute__((aligned(16))) unsigned char lds_raw[];
    LAS unsigned char* lds = (LAS unsigned char*)lds_raw;
    const int tid = threadIdx.x, lane = tid & 63, wave = __builtin_amdgcn_readfirstlane(tid >> 6);
    const int G = gridDim.x, bx = blockIdx.x;
    const int vcu = (G % 8 == 0) ? (bx % 8) * (G / 8) + bx / 8 : bx;
    const int gw = vcu * 8 + wave, NGW = G * 8;
    const float* mod = (const float*)(p.ws + WS_MOD);
#if MK_COOP
    volatile LAS unsigned* bst = (volatile LAS unsigned*)(lds + LDS_BYTES - 16);
    if (tid < 4) bst[tid] = 0u;
    __syncthreads();
    const XcdBarrier xb = xcd_barrier_post((unsigned*)(p.ws + WS_CTL) + 1024, bst);
    if (tid == 0) bst[2] = __hip_atomic_fetch_add((unsigned*)(p.ws + WS_CTL) + CW_XCNT + 64 * xb.x, 1u, __ATOMIC_RELAXED, __HIP_MEMORY_SCOPE_AGENT);
#define PHASE_END(k) do { if ((k) + 1 < p.ph_hi) xcd_barrier(xb); } while (0)
#else
#define PHASE_END(k) do { } while (0)
#endif
#define IN(k) (p.ph_lo <= (k) && (k) < p.ph_hi)
#if MK_PROF_PHASE >= 0
    unsigned long long pt_prev_ = __builtin_amdgcn_s_memrealtime(), pdt_ = 0ull;
#define PMARK(k) do { const unsigned long long n_ = __builtin_amdgcn_s_memrealtime(); if ((k) == MK_PROF_PHASE) pdt_ = n_ - pt_prev_; pt_prev_ = n_; } while (0)
#else
#define PMARK(k) do { } while (0)
#endif
    if (IN(0)) { p0_mod(p, lds, tid, lane, wave); p0_weights(p, lds, tid, lane, wave); PHASE_END(0); PMARK(0); }
    if (IN(1)) {
        quant_rows((const bf16_t*)(p.ws + WS_WIN), p.ws + WS_W8IN, (float*)(p.ws + WS_SWIN), NQKV, gw, NGW, lane);
        quant_rows((const bf16_t*)(p.ws + WS_WOUT), p.ws + WS_W8OUT, (float*)(p.ws + WS_SWOUT), DM, gw, NGW, lane);
        quant_rows((const bf16_t*)(p.ws + WS_WSC), p.ws + WS_W8SC, (float*)(p.ws + WS_SWN), NPQ, NGW - 1 - gw, NGW, lane);
        norm_rows<false>(p.x, nullptr, p.norm1_g, mod, 0, 1024, p.ws + WS_H, (float*)(p.ws + WS_SHA), gw, NGW, lane); PHASE_END(1); PMARK(1);
    }
    if (IN(2)) {
        pg8::Gemm g{(const bf16_t*)(p.ws + WS_H), (const bf16_t*)(p.ws + WS_W8IN), TOK, NQKV, DM}; pg8::StaticOrder S; S.init(TOK, NQKV, G, bx);
        pg8::EpiQKV8 E{(bf16_t*)(p.ws + WS_QKV), QSCALE, (const float*)(p.ws + WS_SHA), (const float*)(p.ws + WS_SWIN)};
        pg8::gemm_phase<pg8::EpiQKV8, pg8::StaticOrder, true, true, true>(lds, g, S, E);
        PHASE_END(2); PMARK(2);
    }
    if (IN(3)) { attn_phase(p, lds, tid, lane, wave, vcu, G); PHASE_END(3); PMARK(3); }
    if (IN(4)) { merge_norm(p, gw, NGW, lane); PHASE_END(4); PMARK(4); }
    if (IN(5)) {
        pg8::Gemm g{(const bf16_t*)(p.ws + WS_H), (const bf16_t*)(p.ws + WS_W8OUT), TOK, DM, DM}; pg8::StaticOrder S; S.init(TOK, DM, G, bx);
        pg8::EpiZ8 E{(bf16_t*)(p.ws + WS_Z), mod, (const float*)(p.ws + WS_SHB), (const float*)(p.ws + WS_SWOUT)};
        pg8::gemm_phase<pg8::EpiZ8, pg8::StaticOrder, true, true, true>(lds, g, S, E);
        PHASE_END(5); PMARK(5);
    }
    if (IN(6)) { norm_rows<true>(p.x, (const bf16_t*)(p.ws + WS_Z), p.norm2_g, mod, 3072, 4096, p.ws + WS_H8, (float*)(p.ws + WS_SH), gw, NGW, lane); PHASE_END(6); PMARK(6); }
    if (IN(7)) {
        pg8::Gemm g{(const bf16_t*)(p.ws + WS_H8), (const bf16_t*)(p.ws + WS_W8SC), TOK, NPQ, DM}; pg8::StaticOrder S; S.init(TOK, NPQ, G, bx);
        pg8::EpiSC8 E{(_Float16*)(p.ws + WS_SC), NPQ, (const float*)(p.ws + WS_SH), (const float*)(p.ws + WS_SWN)};
        pg8::gemm_phase<pg8::EpiSC8, pg8::StaticOrder, true, true, true>(lds, g, S, E);
        PHASE_END(7); PMARK(7);
    }
    if (IN(8)) { topk_phase(p, lds, gw, NGW, lane, wave); PHASE_END(8); PMARK(8); }
    Topo tp; tp.xi = 0; tp.nx = 1; tp.rank = bx; tp.nloc = G;
#if MK_COOP
    if (IN(9) || IN(11)) {
        const unsigned* xc = (const unsigned*)(p.ws + WS_CTL) + CW_XCNT; int nx = 0, xi = 0, nloc = 1;
        for (int jx = 0; jx < 16; ++jx) { const unsigned cnt = __hip_atomic_load(xc + 64 * jx, __ATOMIC_RELAXED, __HIP_MEMORY_SCOPE_AGENT); if (cnt) { if (jx < (int)xb.x) ++xi; if (jx == (int)xb.x) nloc = (int)cnt; ++nx; } }
        tp.xi = __builtin_amdgcn_readfirstlane(xi); tp.nx = __builtin_amdgcn_readfirstlane(nx > 0 ? nx : 1); tp.rank = __builtin_amdgcn_readfirstlane((int)bst[2]); tp.nloc = __builtin_amdgcn_readfirstlane(nloc);
    }
#endif
    if (IN(9)) { peer_u_phase(p, tp, lane, wave); PHASE_END(9); PMARK(9); }
    if (IN(10)) { peer_w_phase(p, gw, NGW, lane); PHASE_END(10); PMARK(10); }
    if (IN(11)) { peer_v_phase(p, tp, lane, wave); PHASE_END(11); PMARK(11); }
    if (IN(12)) { final_phase(p, p.out, gw, NGW, lane); }
#if MK_PROF_PHASE >= 0
    if (blockIdx.x == 0 && threadIdx.x < 64) { const unsigned long long t0_ = __builtin_amdgcn_s_memrealtime(), d_ = pdt_ * MK_PROF_MULT; while (__builtin_amdgcn_s_memrealtime() - t0_ < d_) __builtin_amdgcn_s_sleep(8); }
#endif
#undef IN
#undef PHASE_END
}

extern "C" void kernel_launch(void* const* d_in, const int* in_sizes, int n_in, void* d_out, int out_size, void* d_ws, size_t ws_size, hipStream_t stream) {
    static int grid = 0;
    if (grid == 0) {
        if (n_in != 16 || in_sizes[0] != TOK * DM || out_size != TOK * DM || ws_size < WS_END) {
            fprintf(stderr, "kernel_launch: unexpected shapes (n_in %d, in0 %d, out %d, ws %zu)\n", n_in, n_in > 0 ? in_sizes[0] : -1, out_size, ws_size); grid = -1; return; }
        int dev = 0, cus = 0, per_cu = 0;
        if (hipGetDevice(&dev) != hipSuccess || hipDeviceGetAttribute(&cus, hipDeviceAttributeMultiprocessorCount, dev) != hipSuccess) { grid = -1; return; }
        if (hipFuncSetAttribute((const void*)mk_fwd, hipFuncAttributeMaxDynamicSharedMemorySize, LDS_BYTES) != hipSuccess) { fprintf(stderr, "kernel_launch: hipFuncSetAttribute failed\n"); grid = -1; return; }
        if (hipOccupancyMaxActiveBlocksPerMultiprocessor(&per_cu, (const void*)mk_fwd, 512, LDS_BYTES) != hipSuccess || per_cu < 1) { fprintf(stderr, "kernel_launch: occupancy query says %d blocks per CU\n", per_cu); per_cu = 1; }
        (void)hipGetLastError();
        grid = cus;
        if (grid > 2048) { fprintf(stderr, "kernel_launch: %d CUs: the attention phase's table-conversion schedule assumes at most 2048 workgroups\n", grid); grid = -1; return; }
    }
    if (grid < 0) return;
    Params p{};
    p.x = (const float*)d_in[0]; p.c = (const float*)d_in[1]; p.ada_w = (const float*)d_in[2]; p.ada_b = (const float*)d_in[3]; p.norm1_g = (const float*)d_in[4];
    p.w_in = (const float*)d_in[5]; p.na_rpb = (const float*)d_in[6]; p.ong_na = (const float*)d_in[7]; p.ong_dil = (const float*)d_in[8]; p.w_out = (const float*)d_in[9];
    p.norm2_g = (const float*)d_in[10]; p.peer_wq = (const float*)d_in[11]; p.peer_sk = (const float*)d_in[12]; p.peer_u = (const float*)d_in[13]; p.peer_v = (const float*)d_in[14];
    p.final_g = (const float*)d_in[15]; p.out = (float*)d_out; p.ws = (unsigned char*)d_ws;
#if MK_COOP
    if (hipMemsetAsync((char*)d_ws + WS_CTL, 0, 65536, stream) != hipSuccess) { fprintf(stderr, "kernel_launch: memset of the barrier words failed\n"); return; }
    p.ph_lo = 0; p.ph_hi = NPHASE;
    void* args[] = {&p};
    const hipError_t e = hipLaunchCooperativeKernel((const void*)mk_fwd, dim3(grid), dim3(512), args, LDS_BYTES, stream);
    if (e != hipSuccess) fprintf(stderr, "kernel_launch: cooperative launch failed: %s (grid %d)\n", hipGetErrorString(e), grid);
#else
    for (int k = 0; k < NPHASE; ++k) { p.ph_lo = k; p.ph_hi = k + 1; hipLaunchKernelGGL(mk_fwd, dim3(grid), dim3(512), LDS_BYTES, stream, p); }
#endif
}
```

```cpp
#include <hip/hip_runtime.h>
#include <cstdio>
#include <cstdint>

#ifndef MK_COOP
#define MK_COOP 1
#endif

constexpr int DM = 1024, BATCH = 16, SEQ = 2048, TOK = BATCH * SEQ;
constexpr int NQKV = 3072, NPQ = 2048, NEXP = 16384;
constexpr float EPS = 1e-6f;
constexpr float LOG2E = 1.4426950408889634f;
constexpr float QSCALE = 0.125f * LOG2E;

constexpr size_t MiB = 1u << 20;
constexpr size_t WS_CTL = 0;
constexpr size_t WS_MOD = 1 * MiB;
constexpr size_t WS_WIN = 2 * MiB;
constexpr size_t WS_WOUT = 8 * MiB;
constexpr size_t WS_WSC = 10 * MiB;
constexpr size_t WS_SU = 14 * MiB;
constexpr size_t WS_UH = 16 * MiB;
constexpr size_t WS_VH = 48 * MiB;
constexpr size_t WS_H = 80 * MiB;
constexpr size_t WS_QKV = 144 * MiB;
constexpr size_t WS_ONA = 336 * MiB;
constexpr size_t WS_OD = 368 * MiB;
constexpr size_t WS_LSE = 464 * MiB;
constexpr size_t WS_IDS = 468 * MiB;
constexpr size_t WS_GATES = 484 * MiB;
constexpr size_t WS_SC = 144 * MiB;
constexpr size_t WS_PART = 144 * MiB;
constexpr size_t WS_PEER = 272 * MiB;
constexpr size_t WS_Z = 336 * MiB;
constexpr size_t WS_H8 = 400 * MiB;
constexpr size_t WS_W8 = 432 * MiB;
constexpr size_t WS_SH = 436 * MiB;
constexpr size_t WS_SW = 437 * MiB;
constexpr size_t WS_SHA = 476 * MiB;
constexpr size_t WS_SHB = 476 * MiB + 262144;
constexpr size_t WS_SWN = 476 * MiB + 524288;
constexpr size_t WS_SWOUT = 476 * MiB + 524288 + 65536;
constexpr size_t WS_SWIN = 476 * MiB + 524288 + 131072;
constexpr size_t WS_W8SC = 477 * MiB;
constexpr size_t WS_W8OUT = 479 * MiB;
constexpr size_t WS_W8IN = 480 * MiB;
constexpr size_t WS_END = 500 * MiB;

constexpr int LDS_BYTES = 147456;

#define LAS __attribute__((address_space(3)))
typedef unsigned short bf16_t;
typedef short bf16x8 __attribute__((ext_vector_type(8)));
typedef float f32x4 __attribute__((ext_vector_type(4)));
typedef unsigned u32x4 __attribute__((ext_vector_type(4)));
typedef unsigned u32x2 __attribute__((ext_vector_type(2)));
typedef float f32x2_t __attribute__((ext_vector_type(2)));
typedef __bf16 bf16x2_t __attribute__((ext_vector_type(2)));
typedef _Float16 h2_t __attribute__((ext_vector_type(2)));
typedef short v4i16_t __attribute__((ext_vector_type(4)));

__device__ __forceinline__ unsigned pkbf(float lo, float hi) { f32x2_t v = {lo, hi}; bf16x2_t b = __builtin_convertvector(v, bf16x2_t); return __builtin_bit_cast(unsigned, b); }
__device__ __forceinline__ unsigned pkh(float lo, float hi) { h2_t h = {(_Float16)lo, (_Float16)hi}; return __builtin_bit_cast(unsigned, h); }
__device__ __forceinline__ float bf_lo(unsigned u) { return __uint_as_float(u << 16); }
__device__ __forceinline__ float bf_hi(unsigned u) { return __uint_as_float(u & 0xffff0000u); }
template <int CTRL> __device__ __forceinline__ float dppf(float v) { return __int_as_float(__builtin_amdgcn_update_dpp(0, __float_as_int(v), CTRL, 0xF, 0xF, false)); }
__device__ __forceinline__ float rdlane(float v, int l) { return __int_as_float(__builtin_amdgcn_readlane(__float_as_int(v), l)); }
__device__ __forceinline__ float xrow_max(float v) {
    auto r = __builtin_amdgcn_permlane16_swap(__float_as_uint(v), __float_as_uint(v), false, false); v = fmaxf(__uint_as_float(r[0]), __uint_as_float(r[1]));
    auto q = __builtin_amdgcn_permlane32_swap(__float_as_uint(v), __float_as_uint(v), false, false); return fmaxf(__uint_as_float(q[0]), __uint_as_float(q[1]));
}
__device__ __forceinline__ float xrow_sum(float v) {
    auto r = __builtin_amdgcn_permlane16_swap(__float_as_uint(v), __float_as_uint(v), false, false); v = __uint_as_float(r[0]) + __uint_as_float(r[1]);
    auto q = __builtin_amdgcn_permlane32_swap(__float_as_uint(v), __float_as_uint(v), false, false); return __uint_as_float(q[0]) + __uint_as_float(q[1]);
}
__device__ __forceinline__ float wave_sum(float v) {
    v += dppf<0xB1>(v); v += dppf<0x4E>(v); v += dppf<0x141>(v); v += dppf<0x140>(v);
    return (rdlane(v, 0) + rdlane(v, 16)) + (rdlane(v, 32) + rdlane(v, 48));
}
__device__ __forceinline__ float wave_max(float v) {
    v = fmaxf(v, dppf<0xB1>(v)); v = fmaxf(v, dppf<0x4E>(v)); v = fmaxf(v, dppf<0x141>(v)); v = fmaxf(v, dppf<0x140>(v));
    return fmaxf(fmaxf(rdlane(v, 0), rdlane(v, 16)), fmaxf(rdlane(v, 32), rdlane(v, 48)));
}

#define XB_TMO      128
#define XB_XCNT(j)  (256  + 64 * (j))
#define XB_XSUB(j)  (1280 + 64 * (j))
#define XB_XGEN(j)  (2304 + 64 * (j))
#define XB_TOP      3328
#define XB_TOPGEN   3392
#define XCD_BAR_WORDS 3456
#define XB_SPIN_CAP (1u << 18)

__device__ __forceinline__ unsigned xb_ld(unsigned* p)              { return __hip_atomic_load(p, __ATOMIC_RELAXED, __HIP_MEMORY_SCOPE_AGENT); }
__device__ __forceinline__ unsigned xb_add(unsigned* p, unsigned v) { return __hip_atomic_fetch_add(p, v, __ATOMIC_RELAXED, __HIP_MEMORY_SCOPE_AGENT); }
__device__ __forceinline__ unsigned xb_xcc_id() { return (unsigned)__builtin_amdgcn_s_getreg((3 << 11) | 20) & 0xFu; }
#define XB_SPIN(cond, bar) do { unsigned _sp = 0; while (cond) { __builtin_amdgcn_s_sleep(1); \
    if ((++_sp & 255u) == 0u) { if (xb_ld(&(bar)[XB_TMO])) break; if (_sp > XB_SPIN_CAP) { atomicAdd(&(bar)[XB_TMO], 1u); break; } } } } while (0)

struct XcdBarrier {
    unsigned* bar; unsigned x;
    volatile LAS unsigned* st;
};

__device__ __forceinline__ XcdBarrier xcd_barrier_post(unsigned* bar, volatile LAS unsigned* st) {
    XcdBarrier b; b.bar = bar; b.x = xb_xcc_id(); b.st = st;
    if (threadIdx.x == 0) (void)xb_add(&bar[XB_XCNT(b.x)], 1u);
    return b;
}
__device__ __forceinline__ void xcd_barrier_complete(unsigned* bar, unsigned x, unsigned& nloc, unsigned& nx) {
    const unsigned G = gridDim.x * gridDim.y * gridDim.z;
    unsigned sum, cnt, mine, sp = 0u;
    for (;;) {
        sum = 0u; cnt = 0u; mine = 0u;
#pragma unroll
        for (unsigned j = 0; j < 16; ++j) { const unsigned c = xb_ld(&bar[XB_XCNT(j)]); sum += c; cnt += (c > 0u) ? 1u : 0u; mine = (j == x) ? c : mine; }
        if (sum == G) break;
        __builtin_amdgcn_s_sleep(1);
        if ((++sp & 255u) == 0u) { if (xb_ld(&bar[XB_TMO])) break; if (sp > XB_SPIN_CAP) { atomicAdd(&bar[XB_TMO], 1u); break; } }
    }
    nloc = mine > 0u ? mine : 1u; nx = cnt > 0u ? cnt : 1u;
}

__device__ __forceinline__ void xcd_barrier(const XcdBarrier& b) {
    asm volatile("s_waitcnt vmcnt(0)" ::: "memory");
    __syncthreads();
    if (threadIdx.x == 0) {
        unsigned* bar = b.bar;
        __builtin_amdgcn_s_waitcnt(0);
        unsigned nloc = b.st[0], nx = b.st[1];
        if (nloc == 0u) { xcd_barrier_complete(bar, b.x, nloc, nx); b.st[0] = nloc; b.st[1] = nx; }
        const unsigned old = xb_add(&bar[XB_XSUB(b.x)], 1u);
        const unsigned gen = old / nloc;
        if (old + 1u == (gen + 1u) * nloc) {
            __builtin_amdgcn_fence(__ATOMIC_RELEASE, "agent");
            asm volatile("s_waitcnt vmcnt(0)" ::: "memory");
            const unsigned og = xb_add(&bar[XB_TOP], 1u);
            const unsigned tg = og / nx;
            if (og + 1u == (tg + 1u) * nx) xb_add(&bar[XB_TOPGEN], 1u);
            else XB_SPIN(xb_ld(&bar[XB_TOPGEN]) == tg, bar);
            __builtin_amdgcn_fence(__ATOMIC_ACQUIRE, "agent");
            asm volatile("s_waitcnt vmcnt(0)" ::: "memory");
        } else {
            XB_SPIN(xb_ld(&bar[XB_TOPGEN]) == gen, bar);
            __builtin_amdgcn_fence(__ATOMIC_ACQUIRE, "agent");
            asm volatile("s_waitcnt vmcnt(0)" ::: "memory");
        }
    }
    __syncthreads();
}

namespace pg8 {
#define PG8_LAS __attribute__((address_space(3)))
typedef unsigned short bf16_t;
typedef short bf16x8 __attribute__((ext_vector_type(8)));
typedef float f32x4 __attribute__((ext_vector_type(4)));
typedef unsigned u32x4 __attribute__((ext_vector_type(4)));
typedef int i32x4 __attribute__((ext_vector_type(4)));
constexpr int BM = 256, BK = 64, HALF = 128, HTB = HALF * BK * 2  , STAGE_BYTES = 8 * HTB, NXCD = 8, WGM = 4;

__host__ __device__ __forceinline__ int lds_byte(int r, int c) { const int st = (r >> 4) * 2 + (c >> 5), rr = r & 15, cc = c & 31, ob = rr * 64 + cc * 2; return st * 1024 + (ob ^ (((ob >> 9) & 1) << 5)); }
__host__ __device__ __forceinline__ void stage_rc(int b, int& R, int& C) { const int st = b / 1024, sb = b % 1024, swz = sb ^ (((sb >> 9) & 1) << 5); R = (st >> 1) * 16 + swz / 64; C = (st & 1) * 32 + (swz % 64) / 2; }
__host__ __device__ __forceinline__ int perm32(int rho) { const int n = rho >> 4, i = rho & 15; return 8 * (i >> 2) + 4 * n + (i & 3); }

struct Unit { int pm, pn; };
struct Gemm { const bf16_t* A; const bf16_t* Bt; int M, N, K; };

struct StaticOrder {
    int nM, nN, nwg, G, c;
    __host__ __device__ void init(int M, int N, int G_, int c_) { nM = M / BM; nN = N / BM; nwg = nM * nN; G = G_; c = c_; }
    __host__ __device__ bool next(int i, Unit& u) const {
        const long L = (long)i * G + c; if (L >= nwg) return false;
        int wgid = (int)L; { const int q = nwg / NXCD, r = nwg % NXCD, xcd = wgid % NXCD, off = wgid / NXCD; wgid = (xcd < r ? xcd * (q + 1) : r * (q + 1) + (xcd - r) * q) + off; }
        const int nig = WGM * nN, gid = wgid / nig, fm = gid * WGM, gsz = (nM - fm) < WGM ? (nM - fm) : WGM;
        u.pm = fm + ((wgid % nig) % gsz); u.pn = (wgid % nig) / gsz; return true;
    }
    __device__ __forceinline__ void a_ready(const Unit&) const {}
    __device__ __forceinline__ void done(const Unit&) const {}
};


__device__ __forceinline__ unsigned cvt_pk_bf16(float lo, float hi) { unsigned r; asm volatile("v_cvt_pk_bf16_f32 %0, %1, %2" : "=v"(r) : "v"(lo), "v"(hi)); return r; }

__device__ __forceinline__ __amdgpu_buffer_rsrc_t wt_rsrc(void* base) { return __builtin_amdgcn_make_buffer_rsrc(base, 0, 0x7fffffff, 0x00020000); }
__device__ __forceinline__ void wt_store16(__amdgpu_buffer_rsrc_t r, size_t byte_off, u32x4 v) { __builtin_amdgcn_raw_buffer_store_b128(v, r, (unsigned)byte_off, 0, 16); }
__device__ __forceinline__ void epi_store128(__amdgpu_buffer_rsrc_t rs, size_t off_row0, size_t row_stride, u32x4 w0, u32x4 w1, bool odd) {
    u32x4 snd, rcv;
#pragma unroll
    for (int c = 0; c < 4; ++c) { snd[c] = odd ? w0[c] : w1[c]; rcv[c] = (unsigned)__builtin_amdgcn_update_dpp(0, (int)snd[c], 0xB1, 0xF, 0xF, false); }
    u32x4 da, db;
#pragma unroll
    for (int c = 0; c < 4; ++c) { da[c] = odd ? rcv[c] : w0[c]; db[c] = odd ? w1[c] : rcv[c]; }
    const size_t o = off_row0 + (odd ? 64 : 0);
    wt_store16(rs, o, da);
    wt_store16(rs, o + row_stride, db);
}
struct EpiQKV8 {
    static constexpr bool PERM = true, AFTER_DRAIN = false;
    bf16_t* O; float qscale; const float* sh; const float* swn;
    __device__ __forceinline__ void operator()(const f32x4 (&acc)[2][2][4][2], const Unit& u, int wr, int wc, int fr, int fq) const {
        const bool odd = (fr & 1) != 0;
        const int bb = u.pm >> 3, s0 = (u.pm & 7) * BM + wr * 64 + (fr & ~1), slot = 4 * u.pn + wc, d0 = 8 * fq;
        const int row0 = u.pm * BM + wr * 64 + fr, col0 = u.pn * BM + wc * 64 + 8 * fq;
        const float sc = (u.pn < 2 || u.pn == 6 || u.pn == 7) ? qscale : 1.f;
        const __amdgpu_buffer_rsrc_t rs_ = wt_rsrc(O);
        const size_t hp = ((((size_t)bb * 48 + slot) * 2048 + s0) * 64 + d0) * 2;
        f32x4 cs[2][2];
#pragma unroll
        for (int bj = 0; bj < 2; ++bj)
#pragma unroll
            for (int n = 0; n < 2; ++n) cs[bj][n] = *(const f32x4*)(swn + col0 + 32 * bj + 4 * n) * sc;
#pragma unroll
        for (int ai = 0; ai < 2; ++ai)
#pragma unroll
            for (int m = 0; m < 4; ++m) { const float rsc = sh[row0 + ai * HALF + m * 16];
                u32x4 w[2];
#pragma unroll
                for (int bj = 0; bj < 2; ++bj) {
                    const i32x4 i0 = __builtin_bit_cast(i32x4, acc[ai][bj][m][0]), i1 = __builtin_bit_cast(i32x4, acc[ai][bj][m][1]);
                    const f32x4 v0 = (f32x4){(float)i0[0], (float)i0[1], (float)i0[2], (float)i0[3]} * rsc * cs[bj][0], v1 = (f32x4){(float)i1[0], (float)i1[1], (float)i1[2], (float)i1[3]} * rsc * cs[bj][1];
                    w[bj].x = cvt_pk_bf16(v0[0], v0[1]); w[bj].y = cvt_pk_bf16(v0[2], v0[3]); w[bj].z = cvt_pk_bf16(v1[0], v1[1]); w[bj].w = cvt_pk_bf16(v1[2], v1[3]); }
                epi_store128(rs_, hp + (size_t)(ai * HALF + m * 16) * 128, 128, w[0], w[1], odd); }
    }
};
struct EpiZ8 {
    static constexpr bool PERM = true, AFTER_DRAIN = false;
    bf16_t* Z; const float* mod; const float* sh; const float* swn;
    __device__ __forceinline__ void operator()(const f32x4 (&acc)[2][2][4][2], const Unit& u, int wr, int wc, int fr, int fq) const {
        const int row0 = u.pm * BM + wr * 64 + fr, col0 = u.pn * BM + wc * 64 + 8 * fq;
        const float* g1 = mod + (size_t)(u.pm >> 3) * 6144 + 2048 + col0;
        const __amdgpu_buffer_rsrc_t rs_ = wt_rsrc(Z);
        f32x4 gv[2][2];
#pragma unroll
        for (int bj = 0; bj < 2; ++bj)
#pragma unroll
            for (int n = 0; n < 2; ++n) gv[bj][n] = *(const f32x4*)(g1 + 32 * bj + 4 * n) * *(const f32x4*)(swn + col0 + 32 * bj + 4 * n);
#pragma unroll
        for (int ai = 0; ai < 2; ++ai)
#pragma unroll
            for (int m = 0; m < 4; ++m) { const int row = row0 + ai * HALF + m * 16; const float rsc = sh[row]; const size_t off = (size_t)(row & ~1) * 1024 + col0;
                u32x4 w[2];
#pragma unroll
                for (int bj = 0; bj < 2; ++bj) { const i32x4 i0 = __builtin_bit_cast(i32x4, acc[ai][bj][m][0]), i1 = __builtin_bit_cast(i32x4, acc[ai][bj][m][1]);
                    const f32x4 v0 = (f32x4){(float)i0[0], (float)i0[1], (float)i0[2], (float)i0[3]} * rsc * gv[bj][0], v1 = (f32x4){(float)i1[0], (float)i1[1], (float)i1[2], (float)i1[3]} * rsc * gv[bj][1];
                    w[bj].x = cvt_pk_bf16(v0[0], v0[1]); w[bj].y = cvt_pk_bf16(v0[2], v0[3]); w[bj].z = cvt_pk_bf16(v1[0], v1[1]); w[bj].w = cvt_pk_bf16(v1[2], v1[3]); }
                epi_store128(rs_, off * 2, 2048, w[0], w[1], (fr & 1) != 0); }
    }
};
struct EpiSC8 {
    static constexpr bool PERM = true, AFTER_DRAIN = false;
    _Float16* O; int ldc; const float* sh; const float* swn;
    __device__ __forceinline__ void operator()(const f32x4 (&acc)[2][2][4][2], const Unit& u, int wr, int wc, int fr, int fq) const {
        const int row0 = u.pm * BM + wr * 64 + fr, col0 = u.pn * BM + wc * 64 + 8 * fq;
        const __amdgpu_buffer_rsrc_t rs_ = wt_rsrc(O);
        f32x4 cs[2][2];
#pragma unroll
        for (int bj = 0; bj < 2; ++bj)
#pragma unroll
            for (int n = 0; n < 2; ++n) cs[bj][n] = *(const f32x4*)(swn + col0 + 32 * bj + 4 * n);
#pragma unroll
        for (int ai = 0; ai < 2; ++ai)
#pragma unroll
            for (int m = 0; m < 4; ++m) { const int row = row0 + ai * HALF + m * 16; const float rsc = sh[row]; const size_t rowp = ((size_t)(row & ~1) * ldc + col0) * 2;
                u32x4 w[2];
#pragma unroll
                for (int bj = 0; bj < 2; ++bj) { const i32x4 i0 = __builtin_bit_cast(i32x4, acc[ai][bj][m][0]), i1 = __builtin_bit_cast(i32x4, acc[ai][bj][m][1]);
                    const f32x4 v0 = (f32x4){(float)i0[0], (float)i0[1], (float)i0[2], (float)i0[3]} * rsc * cs[bj][0], v1 = (f32x4){(float)i1[0], (float)i1[1], (float)i1[2], (float)i1[3]} * rsc * cs[bj][1];
                    w[bj].x = pkh(v0[0], v0[1]); w[bj].y = pkh(v0[2], v0[3]); w[bj].z = pkh(v1[0], v1[1]); w[bj].w = pkh(v1[2], v1[3]); }
                epi_store128(rs_, rowp, (size_t)ldc * 2, w[0], w[1], (fr & 1) != 0); }
    }
};

template <class Epi, class Sched, bool ALIGN_EPI = false, bool SP2 = false, bool I8 = false>
__device__ __forceinline__ void gemm_phase(PG8_LAS unsigned char* lds, const Gemm g, const Sched& S, const Epi& E) {
    const int tid = threadIdx.x, wid = __builtin_amdgcn_readfirstlane(tid >> 6), lane = tid & 63, wr = wid >> 2, wc = wid & 3, fr = lane & 15, fq = lane >> 4;
    const int K = g.K, rowb = K * (I8 ? 1 : 2)  , nt = rowb / (BK * 2);
    unsigned voffA[2], voffB[2];
#pragma unroll
    for (int i = 0; i < 2; ++i) { int R, C; stage_rc(tid * 16 + i * 8192, R, C); const int Rb = Epi::PERM ? (64 * (R >> 5) + perm32(R & 31)) : R;
        voffA[i] = (unsigned)(R * rowb + C * 2); voffB[i] = (unsigned)(Rb * rowb + C * 2); }
    const size_t kstep = (size_t)(BK * 2);
    const size_t hstep = (size_t)HALF * rowb;
    const size_t hB = Epi::PERM ? (size_t)32 * rowb : hstep;
    const size_t tstep = 2 * hstep;
    const unsigned ldsw = (unsigned)wid * 1024u;
    const int aoff = lds_byte(wr * 64 + fr, fq * 8), boff = lds_byte(wc * 32 + fr, fq * 8);
#define PG8_SA(b, h) (((b) * 2 + (h)) * HTB)
#define PG8_SB(b, h) ((4 + (b) * 2 + (h)) * HTB)
#define PG8_STAGE(bufoff, gbase, voff) do { _Pragma("unroll") for (int _i = 0; _i < 2; ++_i) \
        __builtin_amdgcn_global_load_lds((const unsigned*)((const char*)(gbase) + (voff)[_i]), (PG8_LAS unsigned*)(lds + (bufoff) + ldsw + _i * 8192), 16, 0, 0); } while (0)
#define PG8_LDA(dst, b, h) do { _Pragma("unroll") for (int m = 0; m < 4; ++m) _Pragma("unroll") for (int k = 0; k < 2; ++k) dst[m][k] = *(const PG8_LAS bf16x8*)(lds + PG8_SA(b, h) + aoff + m * 2048 + k * 1024); } while (0)
#define PG8_LDB(dst, b, h) do { _Pragma("unroll") for (int n = 0; n < 2; ++n) _Pragma("unroll") for (int k = 0; k < 2; ++k) dst[n][k] = *(const PG8_LAS bf16x8*)(lds + PG8_SB(b, h) + boff + n * 2048 + k * 1024); } while (0)
#define PG8_MMA(ai, bj, At, Bt) do { __builtin_amdgcn_s_setprio(1); _Pragma("unroll") for (int m = 0; m < 4; ++m) _Pragma("unroll") for (int n = 0; n < 2; ++n) _Pragma("unroll") for (int k = 0; k < 2; ++k) \
        { if constexpr (I8) acc[ai][bj][m][n] = __builtin_bit_cast(f32x4, __builtin_amdgcn_mfma_i32_16x16x64_i8(__builtin_bit_cast(i32x4, Bt[n][k]), __builtin_bit_cast(i32x4, At[m][k]), __builtin_bit_cast(i32x4, acc[ai][bj][m][n]), 0, 0, 0)); \
          else acc[ai][bj][m][n] = __builtin_amdgcn_mfma_f32_16x16x32_bf16(Bt[n][k], At[m][k], acc[ai][bj][m][n], 0, 0, 0); } __builtin_amdgcn_s_setprio(0); } while (0)
#define PG8_WAIT_V(n) asm volatile("s_waitcnt vmcnt(" #n ")" ::: "memory")
#define PG8_WAIT_L(n) asm volatile("s_waitcnt lgkmcnt(" #n ")" ::: "memory")
#define PG8_BAR __builtin_amdgcn_s_barrier()
#define PG8_SCHED __builtin_amdgcn_sched_barrier(0)
    Unit cur, nxt; int ui = 0;
    if (!S.next(0, cur)) return;
    f32x4 acc[2][2][4][2];
#pragma unroll
    for (int a = 0; a < 2; ++a)
#pragma unroll
        for (int b = 0; b < 2; ++b)
#pragma unroll
            for (int m = 0; m < 4; ++m)
#pragma unroll
                for (int n = 0; n < 2; ++n) acc[a][b][m][n] = (f32x4){0.f, 0.f, 0.f, 0.f};
    bf16x8 At[4][2], B0[2][2], B1[2][2];
    const char* cA = (const char*)g.A + (size_t)cur.pm * tstep; const char* cB = (const char*)g.Bt + (size_t)cur.pn * tstep;
    S.a_ready(cur);
    if constexpr (SP2) {
        PG8_STAGE(PG8_SB(0, 0), cB, voffB); PG8_STAGE(PG8_SB(0, 1), cB + hB, voffB); PG8_STAGE(PG8_SA(0, 0), cA, voffA); PG8_STAGE(PG8_SA(0, 1), cA + hstep, voffA);
        if (wr == 1) PG8_BAR;
        PG8_WAIT_V(2); PG8_BAR;
        PG8_STAGE(PG8_SB(1, 0), cB + kstep, voffB); PG8_STAGE(PG8_SA(1, 0), cA + kstep, voffA); PG8_STAGE(PG8_SB(1, 1), cB + hB + kstep, voffB);
        PG8_WAIT_V(6); PG8_BAR;
    } else {
        PG8_STAGE(PG8_SB(0, 0), cB, voffB); PG8_STAGE(PG8_SA(0, 0), cA, voffA); PG8_STAGE(PG8_SB(0, 1), cB + hB, voffB); PG8_STAGE(PG8_SA(0, 1), cA + hstep, voffA);
        if (wr == 1) PG8_BAR;
        PG8_WAIT_V(4); PG8_BAR;
        PG8_STAGE(PG8_SB(1, 0), cB + kstep, voffB); PG8_STAGE(PG8_SA(1, 0), cA + kstep, voffA); PG8_STAGE(PG8_SB(1, 1), cB + hB + kstep, voffB);
        PG8_WAIT_V(6); PG8_BAR;
    }
    for (;;) {
        const bool has_next = S.next(ui + 1, nxt);
        const char* nA = has_next ? (const char*)g.A + (size_t)nxt.pm * tstep : cA; const char* nB = has_next ? (const char*)g.Bt + (size_t)nxt.pn * tstep : cB;
        for (int t = 0; t < nt; t += 2) {
            const bool last = (t == nt - 2);
            const char* a1 = cA + (size_t)(t + 1) * kstep;
            const char* a2 = last ? nA : cA + (size_t)(t + 2) * kstep; const char* b2 = last ? nB : cB + (size_t)(t + 2) * kstep;
            const char* a3 = a2 + kstep; const char* b3 = b2 + kstep;
            if (last && has_next) S.a_ready(nxt);
            if constexpr (SP2) {
            PG8_LDB(B0, 0, 0); PG8_LDB(B1, 0, 1); PG8_SCHED; PG8_LDA(At, 0, 0); PG8_STAGE(PG8_SA(1, 1), a1 + hstep, voffA);
            PG8_WAIT_V(8); PG8_WAIT_L(0); PG8_BAR; PG8_MMA(0, 0, At, B0); PG8_MMA(0, 1, At, B1); PG8_BAR; PG8_SCHED;
            PG8_LDA(At, 0, 1); PG8_STAGE(PG8_SB(0, 0), b2, voffB); PG8_STAGE(PG8_SB(0, 1), b2 + hB, voffB); PG8_STAGE(PG8_SA(0, 0), a2, voffA);
            PG8_WAIT_V(8); PG8_WAIT_L(0); PG8_BAR; PG8_MMA(1, 0, At, B0); PG8_MMA(1, 1, At, B1); PG8_BAR; PG8_SCHED;
            PG8_LDB(B0, 1, 0); PG8_LDB(B1, 1, 1); PG8_SCHED; PG8_LDA(At, 1, 0); PG8_STAGE(PG8_SA(0, 1), a2 + hstep, voffA);
            PG8_WAIT_V(8); PG8_WAIT_L(0); PG8_BAR; PG8_MMA(0, 0, At, B0); PG8_MMA(0, 1, At, B1); PG8_BAR; PG8_SCHED;
            PG8_LDA(At, 1, 1); PG8_STAGE(PG8_SB(1, 0), b3, voffB); PG8_STAGE(PG8_SB(1, 1), b3 + hB, voffB); PG8_STAGE(PG8_SA(1, 0), a3, voffA);
            PG8_WAIT_V(8); PG8_WAIT_L(0); PG8_BAR; PG8_MMA(1, 0, At, B0); PG8_MMA(1, 1, At, B1); PG8_BAR; PG8_SCHED;
            } else {
            PG8_LDB(B0, 0, 0); PG8_SCHED; PG8_LDA(At, 0, 0); PG8_STAGE(PG8_SA(1, 1), a1 + hstep, voffA);
            PG8_WAIT_L(8); PG8_BAR; PG8_WAIT_L(0); PG8_MMA(0, 0, At, B0); PG8_BAR; PG8_SCHED;
            PG8_LDB(B1, 0, 1); PG8_STAGE(PG8_SB(0, 0), b2, voffB);
            PG8_BAR; PG8_WAIT_L(0); PG8_MMA(0, 1, At, B1); PG8_BAR;
            PG8_LDA(At, 0, 1); PG8_STAGE(PG8_SA(0, 0), a2, voffA);
            PG8_BAR; PG8_WAIT_L(0); PG8_MMA(1, 0, At, B0); PG8_BAR; PG8_SCHED;
            PG8_STAGE(PG8_SB(0, 1), b2 + hB, voffB);
            PG8_WAIT_V(6); PG8_BAR; PG8_MMA(1, 1, At, B1); PG8_BAR;
            PG8_LDB(B0, 1, 0); PG8_SCHED; PG8_LDA(At, 1, 0); PG8_STAGE(PG8_SA(0, 1), a2 + hstep, voffA);
            PG8_WAIT_L(8); PG8_BAR; PG8_WAIT_L(0); PG8_MMA(0, 0, At, B0); PG8_BAR; PG8_SCHED;
            PG8_LDB(B1, 1, 1); PG8_STAGE(PG8_SB(1, 0), b3, voffB);
            PG8_BAR; PG8_WAIT_L(0); PG8_MMA(0, 1, At, B1); PG8_BAR;
            PG8_LDA(At, 1, 1); PG8_STAGE(PG8_SA(1, 0), a3, voffA);
            PG8_BAR; PG8_WAIT_L(0); PG8_MMA(1, 0, At, B0); PG8_BAR; PG8_SCHED;
            PG8_STAGE(PG8_SB(1, 1), b3 + hB, voffB);
            PG8_WAIT_V(6); PG8_BAR; PG8_MMA(1, 1, At, B1); PG8_BAR;
            }
        }
        if constexpr (ALIGN_EPI) { if (wr == 0) PG8_BAR; }
        if constexpr (!Epi::AFTER_DRAIN) { E(acc, cur, wr, wc, fr, fq); S.done(cur); }
        if (!has_next) break;
#pragma unroll
        for (int a = 0; a < 2; ++a)
#pragma unroll
            for (int b = 0; b < 2; ++b)
#pragma unroll
                for (int m = 0; m < 4; ++m)
#pragma unroll
                    for (int n = 0; n < 2; ++n) acc[a][b][m][n] = (f32x4){0.f, 0.f, 0.f, 0.f};
        cur = nxt; cA = nA; cB = nB; ++ui;
        if constexpr (ALIGN_EPI) { if (wr == 1) PG8_BAR; }
    }
    PG8_WAIT_V(0);
    if constexpr (!ALIGN_EPI) { if (wr == 0) PG8_BAR; }
    PG8_BAR;
    if constexpr (Epi::AFTER_DRAIN) { E.fused(acc, cur, wr, wc, fr, fq, lds, wid, lane); S.done(cur); }
#undef PG8_SA
#undef PG8_SB
#undef PG8_STAGE
#undef PG8_LDA
#undef PG8_LDB
#undef PG8_MMA
#undef PG8_WAIT_V
#undef PG8_WAIT_L
#undef PG8_BAR
#undef PG8_SCHED
}
}

struct Params {
    const float *x, *c, *ada_w, *ada_b, *norm1_g, *w_in, *na_rpb, *ong_na, *ong_dil, *w_out, *norm2_g, *peer_wq, *peer_sk, *peer_u, *peer_v, *final_g;
    float* out; unsigned char* ws; int ph_lo, ph_hi;
};
constexpr int NPHASE = 13;
__device__ __forceinline__ unsigned q8_pack4(float x0, float x1, float x2, float x3, float inv) {
    const unsigned y0 = __float_as_uint(__builtin_fmaf(x0, inv, 12582912.f)), y1 = __float_as_uint(__builtin_fmaf(x1, inv, 12582912.f));
    const unsigned y2 = __float_as_uint(__builtin_fmaf(x2, inv, 12582912.f)), y3 = __float_as_uint(__builtin_fmaf(x3, inv, 12582912.f));
    return __builtin_amdgcn_perm(__builtin_amdgcn_perm(y3, y2, 0x0c0c0400u), __builtin_amdgcn_perm(y1, y0, 0x0c0c0400u), 0x05040100u);
}

__device__ __forceinline__ void p0_mod(const Params& p, LAS unsigned char* lds, int tid, int lane, int wave) {
    LAS float* s = (LAS float*)lds;
    LAS float* red = (LAS float*)(lds + 65536);
    float wv[64];
    {
        const int c = lane & 31, kq = lane >> 5; const float* wp0 = p.ada_w + (size_t)(wave * 128 + kq) * 6144 + (blockIdx.x < 256 ? blockIdx.x : 0) * 24 + (c < 24 ? c : 0);
#pragma unroll
        for (int i = 0; i < 64; ++i) wv[i] = __builtin_nontemporal_load(wp0 + (size_t)i * 2 * 6144);
    }
    __builtin_amdgcn_sched_barrier(0);
    {
        float cv[32];
#pragma unroll
        for (int i = 0; i < 32; ++i) cv[i] = p.c[tid + 512 * i];
#pragma unroll
        for (int i = 0; i < 32; ++i) { const int idx = tid + 512 * i, b = idx >> 10, k = idx & 1023; s[k * 16 + b] = cv[i] / (1.f + __expf(-cv[i])); }
    }
    __syncthreads();
    float* mod = (float*)(p.ws + WS_MOD);
    for (int it = blockIdx.x; it < 256; it += gridDim.x) {
        const int j0 = it * 24, c = lane & 31, kq = lane >> 5; const bool act = c < 24;
        float acc[16];
#pragma unroll
        for (int b = 0; b < 16; ++b) acc[b] = 0.f;
        const float* wp = p.ada_w + (size_t)(wave * 128 + kq) * 6144 + j0 + (act ? c : 0);
        if (it != (int)blockIdx.x) {
#pragma unroll
            for (int i = 0; i < 64; ++i) wv[i] = __builtin_nontemporal_load(wp + (size_t)i * 2 * 6144);
        }
        __builtin_amdgcn_sched_barrier(0);
#pragma unroll
        for (int i = 0; i < 64; ++i) {
            const int k = wave * 128 + 2 * i + kq;
            const LAS f32x4* sp = (const LAS f32x4*)(s + k * 16);
            const f32x4 s0 = sp[0], s1 = sp[1], s2 = sp[2], s3 = sp[3];
#pragma unroll
            for (int e = 0; e < 4; ++e) { acc[e] += s0[e] * wv[i]; acc[4 + e] += s1[e] * wv[i]; acc[8 + e] += s2[e] * wv[i]; acc[12 + e] += s3[e] * wv[i]; }
        }
#pragma unroll
        for (int b = 0; b < 16; ++b) red[((wave * 2 + kq) * 16 + b) * 32 + c] = acc[b];
        __syncthreads();
        if (tid < 384) { const int b = tid / 24, cc = tid - b * 24; float sum = p.ada_b[j0 + cc];
#pragma unroll
            for (int pp = 0; pp < 16; ++pp) sum += red[(pp * 16 + b) * 32 + cc];
            mod[(size_t)b * 6144 + j0 + cc] = sum; }
        __syncthreads();
    }
}
__device__ __forceinline__ void p0_wsc(const Params& p, LAS unsigned char* lds, int tid) {
    constexpr int RS = 272;
    LAS unsigned char* wq_s = lds;
    LAS unsigned char* sk_s = lds + 64 * RS;
    bf16_t* WscT = (bf16_t*)(p.ws + WS_WSC);
    const int lane = tid & 63, wave = tid >> 6, m = lane & 15, g = lane >> 4;
    for (int it = blockIdx.x; it < 256; it += gridDim.x) {
        const int hp = it >> 4, kc = it & 15, pp = hp & 1, k0 = kc * 64;
        f32x4 a[4], b[8];
#pragma unroll
        for (int i = 0; i < 4; ++i) { const int e = tid + 512 * i, r = e >> 5, c4 = e & 31; a[i] = *(const f32x4*)(p.peer_wq + (size_t)(k0 + r) * 2048 + hp * 128 + c4 * 4); }
#pragma unroll
        for (int i = 0; i < 8; ++i) { const int e = tid + 512 * i, r = e >> 5, c4 = e & 31; b[i] = *(const f32x4*)(p.peer_sk + (size_t)pp * 16384 + r * 128 + c4 * 4); }
#pragma unroll
        for (int i = 0; i < 4; ++i) { const int e = tid + 512 * i, r = e >> 5, c4 = e & 31; *(LAS u32x2*)(wq_s + r * RS + c4 * 8) = (u32x2){pkbf(a[i][0], a[i][1]), pkbf(a[i][2], a[i][3])}; }
#pragma unroll
        for (int i = 0; i < 8; ++i) { const int e = tid + 512 * i, r = e >> 5, c4 = e & 31; *(LAS u32x2*)(sk_s + r * RS + c4 * 8) = (u32x2){pkbf(b[i][0], b[i][1]), pkbf(b[i][2], b[i][3])}; }
        __syncthreads();
        bf16x8 bf[4];
#pragma unroll
        for (int ks = 0; ks < 4; ++ks) bf[ks] = *(const LAS bf16x8*)(sk_s + (16 * wave + m) * RS + 64 * ks + 16 * g);
        bf16_t* op = WscT + (size_t)(hp * 128 + 16 * wave + m) * 1024 + k0 + 4 * g;
#pragma unroll
        for (int rt = 0; rt < 4; ++rt) {
            f32x4 acc = {0.f, 0.f, 0.f, 0.f};
#pragma unroll
            for (int ks = 0; ks < 4; ++ks) { const bf16x8 af = *(const LAS bf16x8*)(wq_s + (16 * rt + m) * RS + 64 * ks + 16 * g); acc = __builtin_amdgcn_mfma_f32_16x16x32_bf16(af, bf[ks], acc, 0, 0, 0); }
            *(u32x2*)(op + 16 * rt) = (u32x2){pkbf(acc[0], acc[1]), pkbf(acc[2], acc[3])};
        }
        __syncthreads();
    }
}
__device__ __forceinline__ void p0_transpose_item(const float* W, int K, int N, bf16_t* WT, const float* ks0, const float* ks1, LAS float* scr, int item, int lane) {
    const int nblk = N / 32, kb = item / nblk, nb = item % nblk, k0 = 64 * kb, n0 = 32 * nb;
    float wv[32];
#pragma unroll
    for (int i = 0; i < 32; ++i) wv[i] = W[(size_t)(k0 + 2 * i + (lane >> 5)) * N + n0 + (lane & 31)];
    if (ks0) {
        const float* gp = (k0 < 512 ? ks0 + k0 : ks1 + (k0 - 512)) + (lane >> 5);
        float gs[32];
#pragma unroll
        for (int i = 0; i < 32; ++i) gs[i] = gp[2 * i];
#pragma unroll
        for (int i = 0; i < 32; ++i) wv[i] *= gs[i];
    }
#pragma unroll
    for (int i = 0; i < 32; ++i) scr[(2 * i + (lane >> 5)) * 33 + (lane & 31)] = wv[i];
    asm volatile("s_waitcnt lgkmcnt(0)" ::: "memory");
    const int c = lane & 7;
#pragma unroll
    for (int j = 0; j < 4; ++j) { const int n = (lane >> 3) + 8 * j; const LAS float* s = scr + (8 * c) * 33 + n;
        u32x4 o; o.x = pkbf(s[0 * 33], s[1 * 33]); o.y = pkbf(s[2 * 33], s[3 * 33]); o.z = pkbf(s[4 * 33], s[5 * 33]); o.w = pkbf(s[6 * 33], s[7 * 33]);
        *(u32x4*)(WT + (size_t)(n0 + n) * K + k0 + 8 * c) = o; }
    asm volatile("s_waitcnt lgkmcnt(0)" ::: "memory");
}
__device__ __forceinline__ void p0_weights(const Params& p, LAS unsigned char* lds, int tid, int lane, int wave) {
    p0_wsc(p, lds, tid);
    const int G = gridDim.x, gw = blockIdx.x * 8 + wave, NGW = G * 8;
    LAS float* scr = (LAS float*)(lds + wave * 16384);
    constexpr int I_IN = (DM / 64) * (NQKV / 32), I_OUT = (DM / 64) * (DM / 32);
    for (int it = gw; it < I_IN + I_OUT; it += NGW) {
        if (it < I_IN) p0_transpose_item(p.w_in, DM, NQKV, (bf16_t*)(p.ws + WS_WIN), nullptr, nullptr, scr, it, lane);
        else p0_transpose_item(p.w_out, DM, DM, (bf16_t*)(p.ws + WS_WOUT), p.ong_na, p.ong_dil, scr, it - I_IN, lane);
    }
}

template <bool ZADD>
__device__ __forceinline__ void norm_rows(const float* src, const bf16_t* zadd, const float* gain, const float* mod, int sh_off, int sc_off, unsigned char* dst8, float* scale8, int gw, int NGW, int lane) {
    constexpr bool Q8 = ZADD;
    for (int it = gw; it < TOK / 16; it += NGW) {
        const int t0 = it * 16, b = t0 >> 11; const float* mb = mod + (size_t)b * 6144;
        f32x4 Gv[4], Sv[4];
#pragma unroll
        for (int j = 0; j < 4; ++j) { const int k = 4 * lane + 256 * j; const f32x4 g = *(const f32x4*)(gain + k), sc = *(const f32x4*)(mb + sc_off + k); Gv[j] = g * (1.f + sc); Sv[j] = *(const f32x4*)(mb + sh_off + k); }
        f32x4 n1[4], n2[4], n3[4];
#pragma unroll
        for (int j = 0; j < 4; ++j) { n1[j] = __builtin_nontemporal_load((const f32x4*)(src + (size_t)t0 * DM) + lane + 64 * j); n2[j] = __builtin_nontemporal_load((const f32x4*)(src + (size_t)(t0 + 1) * DM) + lane + 64 * j); n3[j] = __builtin_nontemporal_load((const f32x4*)(src + (size_t)(t0 + 2) * DM) + lane + 64 * j); }
        u32x2 z1[4], z2[4], z3[4];
        if (ZADD) {
#pragma unroll
            for (int j = 0; j < 4; ++j) { z1[j] = __builtin_nontemporal_load((const u32x2*)(zadd + (size_t)t0 * DM) + lane + 64 * j); z2[j] = __builtin_nontemporal_load((const u32x2*)(zadd + (size_t)(t0 + 1) * DM) + lane + 64 * j); z3[j] = __builtin_nontemporal_load((const u32x2*)(zadd + (size_t)(t0 + 2) * DM) + lane + 64 * j); }
        }
#pragma unroll 4
        for (int r = 0; r < 16; ++r) {
            f32x4 v[4]; float ss = 0.f;
            const f32x4* xn = (const f32x4*)(src + (size_t)(t0 + (r + 3 < 16 ? r + 3 : 15)) * DM) + lane;
#pragma unroll
            for (int j = 0; j < 4; ++j) { v[j] = n1[j]; n1[j] = n2[j]; n2[j] = n3[j]; n3[j] = __builtin_nontemporal_load(xn + 64 * j);
                if (Q8) { const u32x2 zz = z1[j]; v[j] = v[j] + (f32x4){bf_lo(zz.x), bf_hi(zz.x), bf_lo(zz.y), bf_hi(zz.y)}; z1[j] = z2[j]; z2[j] = z3[j]; z3[j] = __builtin_nontemporal_load((const u32x2*)(zadd + (size_t)(t0 + (r + 3 < 16 ? r + 3 : 15)) * DM) + lane + 64 * j); }
                ss += (v[j][0] * v[j][0] + v[j][1] * v[j][1]) + (v[j][2] * v[j][2] + v[j][3] * v[j][3]); }
            const float rs = rsqrtf(wave_sum(ss) * (1.f / DM) + EPS);
            float am = 0.f;
#pragma unroll
            for (int j = 0; j < 4; ++j) { const f32x4 h = v[j] * rs * Gv[j] + Sv[j]; v[j] = h;
                am = fmaxf(fmaxf(am, fmaxf(fabsf(h[0]), fabsf(h[1]))), fmaxf(fabsf(h[2]), fabsf(h[3]))); }
            {
am = wave_max(am);
                const float inv = am > 0.f ? 127.f / am : 0.f;
                unsigned* q8 = (unsigned*)(dst8 + (size_t)(t0 + r) * DM) + lane;
#pragma unroll
                for (int j = 0; j < 4; ++j) q8[64 * j] = q8_pack4(v[j][0], v[j][1], v[j][2], v[j][3], inv);
                if (lane == 0) scale8[t0 + r] = am * (1.f / 127.f);
            }
        }
    }
}

struct TabRow { f32x4 v[4]; };
__device__ __forceinline__ void tab_row_load(const Params& p, int row, int lane, TabRow& r) {
    const bool second = row >= NEXP; const int e = second ? row - NEXP : row;
    const f32x4* src = (const f32x4*)((second ? p.peer_v : p.peer_u) + (size_t)e * 1024) + lane;
#pragma unroll
    for (int j = 0; j < 4; ++j) r.v[j] = __builtin_nontemporal_load(src + 64 * j);
}
__device__ __forceinline__ void tab_row_finish(const Params& p, int row, int lane, const TabRow& r) {
    asm volatile("" : "+v"(lane));
    const bool second = row >= NEXP; const int e = second ? row - NEXP : row;
    float am = 0.f;
#pragma unroll
    for (int j = 0; j < 4; ++j) am = fmaxf(fmaxf(am, fmaxf(fabsf(r.v[j][0]), fabsf(r.v[j][1]))), fmaxf(fabsf(r.v[j][2]), fabsf(r.v[j][3])));
am = wave_max(am);
    const float inv = am > 0.f ? 127.f / am : 0.f;
    unsigned char* tb_ = p.ws + (second ? WS_VH : WS_UH) + (size_t)e * 128 + 4 * (lane & 31);
#pragma unroll
    for (int j = 0; j < 4; ++j) {
        *(unsigned*)(tb_ + (size_t)(2 * j + (lane >> 5)) * NEXP * 128) = q8_pack4(r.v[j][0], r.v[j][1], r.v[j][2], r.v[j][3], inv); }
    if (lane == 0) ((float*)(p.ws + WS_SU))[2 * e + (second ? 1 : 0)] = am * (1.f / 127.f);
}


constexpr int VROW = 160;
constexpr int RPB_OFF = 98304;
constexpr int NUNIT_NA = 2048, NUNIT_DIL = 6144;


template <int NCH> __device__ __forceinline__ void softmax_pack(f32x4 (&S)[NCH][2], bf16x8 (&pa)[NCH], float& mx_out, float& l_out) {
    float mx = -1e30f, mx2 = -1e30f;
#pragma unroll
    for (int ch = 0; ch < NCH; ++ch)
#pragma unroll
        for (int xy = 0; xy < 2; ++xy) { mx = fmaxf(mx, fmaxf(S[ch][xy][0], S[ch][xy][1])); mx2 = fmaxf(mx2, fmaxf(S[ch][xy][2], S[ch][xy][3])); }
    mx = fmaxf(mx, mx2);
    mx = xrow_max(mx);
    float l = 0.f;
#pragma unroll
    for (int ch = 0; ch < NCH; ++ch) {
#pragma unroll
        for (int xy = 0; xy < 2; ++xy)
#pragma unroll
            for (int r = 0; r < 4; ++r) { const float e = __builtin_amdgcn_exp2f(S[ch][xy][r] - mx); S[ch][xy][r] = e; l += e; }
        u32x4 w; w.x = pkbf(S[ch][0][0], S[ch][0][1]); w.y = pkbf(S[ch][0][2], S[ch][0][3]); w.z = pkbf(S[ch][1][0], S[ch][1][1]); w.w = pkbf(S[ch][1][2], S[ch][1][3]);
        pa[ch] = __builtin_bit_cast(bf16x8, w);
    }
    l = xrow_sum(l);
    mx_out = mx; l_out = l;
}
template <int NCH, int CSB, bool PIPE = true> __device__ __forceinline__ void pv_accum(const LAS unsigned char* vb, const bf16x8 (&pa)[NCH], f32x4 (&o)[4]) {
    if constexpr (!PIPE) {
        v4i16_t r[4][2];
#define PV_LD1(i) do { r[(i) & 3][0] = __builtin_amdgcn_ds_read_tr16_b64_v4i16((LAS v4i16_t*)(vb + ((i) >> 2) * CSB + ((i) & 3) * 32)); \
        r[(i) & 3][1] = __builtin_amdgcn_ds_read_tr16_b64_v4i16((LAS v4i16_t*)(vb + ((i) >> 2) * CSB + 16 * VROW + ((i) & 3) * 32)); } while (0)
        PV_LD1(0); PV_LD1(1); PV_LD1(2);
#pragma unroll
        for (int i = 0; i < 4 * NCH; ++i) {
            if (i + 3 < 4 * NCH) PV_LD1(i + 3);
            __builtin_amdgcn_sched_barrier(0);
            const v4i16_t t0 = r[i & 3][0], t1 = r[i & 3][1];
            const bf16x8 vf = {t0[0], t0[1], t0[2], t0[3], t1[0], t1[1], t1[2], t1[3]};
            o[i & 3] = __builtin_amdgcn_mfma_f32_16x16x32_bf16(vf, pa[i >> 2], o[i & 3], 0, 0, 0);
            __builtin_amdgcn_sched_barrier(0);
        }
#undef PV_LD1
        return;
    }
    v4i16_t t[2][4][2];
#define PV_LD(ch) do { _Pragma("unroll") for (int nt_ = 0; nt_ < 4; ++nt_) { t[(ch) & 1][nt_][0] = __builtin_amdgcn_ds_read_tr16_b64_v4i16((LAS v4i16_t*)(vb + (ch) * CSB + nt_ * 32)); \
        t[(ch) & 1][nt_][1] = __builtin_amdgcn_ds_read_tr16_b64_v4i16((LAS v4i16_t*)(vb + (ch) * CSB + 16 * VROW + nt_ * 32)); } } while (0)
    PV_LD(0);
#pragma unroll
    for (int ch = 0; ch < NCH; ++ch) {
        if (ch + 1 < NCH) PV_LD(ch + 1);
        __builtin_amdgcn_sched_barrier(0);
#pragma unroll
        for (int nt = 0; nt < 4; ++nt) {
            const v4i16_t t0 = t[ch & 1][nt][0], t1 = t[ch & 1][nt][1];
            const bf16x8 vf = {t0[0], t0[1], t0[2], t0[3], t1[0], t1[1], t1[2], t1[3]};
            o[nt] = __builtin_amdgcn_mfma_f32_16x16x32_bf16(vf, pa[ch], o[nt], 0, 0, 0);
        }
        __builtin_amdgcn_sched_barrier(0);
    }
#undef PV_LD
}
template <int NCH, int CSB> __device__ __forceinline__ void s_accum(const LAS unsigned char* kb, const bf16x8 qf0, const bf16x8 qf1, f32x4 (&S)[NCH][2]) {
    bf16x8 f[2][2][2];
#define S_LD(ch) do { _Pragma("unroll") for (int xy_ = 0; xy_ < 2; ++xy_) { f[(ch) & 1][xy_][0] = *(const LAS bf16x8*)(kb + (ch) * CSB + 16 * xy_ * VROW); f[(ch) & 1][xy_][1] = *(const LAS bf16x8*)(kb + (ch) * CSB + 16 * xy_ * VROW + 64); } } while (0)
    S_LD(0);
#pragma unroll
    for (int ch = 0; ch < NCH; ++ch) {
        if (ch + 1 < NCH) S_LD(ch + 1);
        __builtin_amdgcn_sched_barrier(0);
#pragma unroll
        for (int xy = 0; xy < 2; ++xy) {
            S[ch][xy] = __builtin_amdgcn_mfma_f32_16x16x32_bf16(f[ch & 1][xy][0], qf0, (f32x4){0.f, 0.f, 0.f, 0.f}, 0, 0, 0);
            S[ch][xy] = __builtin_amdgcn_mfma_f32_16x16x32_bf16(f[ch & 1][xy][1], qf1, S[ch][xy], 0, 0, 0);
        }
        __builtin_amdgcn_sched_barrier(0);
    }
#undef S_LD
}

__device__ __forceinline__ void o_store16(__amdgpu_buffer_rsrc_t rs, size_t elem_off  , const f32x4 (&o)[4], float inv, int g) {
    const bool odd = (g & 1) != 0;
#pragma unroll
    for (int pr = 0; pr < 2; ++pr) {
        const unsigned x0 = pkbf(o[2 * pr][0] * inv, o[2 * pr][1] * inv), x1 = pkbf(o[2 * pr][2] * inv, o[2 * pr][3] * inv);
        const unsigned y0 = pkbf(o[2 * pr + 1][0] * inv, o[2 * pr + 1][1] * inv), y1 = pkbf(o[2 * pr + 1][2] * inv, o[2 * pr + 1][3] * inv);
        auto r0 = __builtin_amdgcn_permlane16_swap(x0, y0, false, false), r1 = __builtin_amdgcn_permlane16_swap(x1, y1, false, false);
        const u32x4 w = {r0[0], r1[0], r0[1], r1[1]};
        const int d0 = 16 * (2 * pr + (odd ? 1 : 0)) + 4 * (g & ~1);
        pg8::wt_store16(rs, (elem_off + d0) * 2, w);
    }
}

__device__ __forceinline__ void lds_barrier() { asm volatile("s_waitcnt lgkmcnt(0)\n\ts_barrier" ::: "memory"); }
struct NaGeo { int b, h, rp, rr, cg, r0, cw; };
__device__ __forceinline__ NaGeo na_geo(int u, int wave) {
    NaGeo z; z.b = u >> 7; z.h = (u >> 4) & 7; z.rp = u & 15; z.rr = 2 * z.rp + (wave >> 2); z.cg = wave & 3;
    z.r0 = min(max(z.rr - 4, 0), 24); z.cw = min(max(16 * z.cg - 8, 0), 32); return z;
}
__device__ __forceinline__ void na_qload(const bf16_t* QKV, const NaGeo& z, int lane, bf16x8& qf0, bf16x8& qf1) {
    const bf16_t* qp = QKV + (((size_t)z.b * 48 + z.h) * SEQ + z.rr * 64 + 16 * z.cg + (lane & 15)) * 64 + 8 * (lane >> 4);
    qf0 = *(const bf16x8*)qp; qf1 = *(const bf16x8*)(qp + 32);
}
__device__ __forceinline__ void na_rows_load(const bf16_t* QKV, int u, int slot0, int tid, u32x4 (&reg)[9]) {
    const int b = u >> 7, h = (u >> 4) & 7, rp = u & 15, vbase = min(max(2 * rp - 4, 0), 24), vr = tid >> 3, vpiece = tid & 7;
#pragma unroll
    for (int ps = 0; ps < 9; ++ps) { const int kr = min(vbase + ps, 31);
        reg[ps] = *(const u32x4*)(QKV + (((size_t)b * 48 + slot0 + h) * SEQ + kr * 64 + vr) * 64 + vpiece * 8); }
}
__device__ __forceinline__ void na_rows_store(LAS unsigned char* lds, int tid, const u32x4 (&reg)[9]) {
    const int vr = tid >> 3, vpiece = tid & 7;
#pragma unroll
    for (int ps = 0; ps < 9; ++ps) *(LAS u32x4*)(lds + (ps * 64 + vr) * VROW + vpiece * 16) = reg[ps];
}
struct NaRegs { u32x4 k[9], v[9]; bf16x8 qf0, qf1; };
__device__ __forceinline__ void na_unit(const Params& p, LAS unsigned char* lds, int u, int un, int tid, int lane, int wave, NaRegs& R) {
    const bf16_t* QKV = (const bf16_t*)(p.ws + WS_QKV);
    const LAS float* rpb = (const LAS float*)(lds + RPB_OFF) + 64;
    const NaGeo z = na_geo(u, wave);
    const int b = z.b, h = z.h, rp = z.rp, rr = z.rr, cg = z.cg, r0 = z.r0, cw = z.cw;
    const int q = lane & 15, g = lane >> 4, c = 16 * cg + q, c0 = min(max(c - 8, 0), 48);
    const int vbase = min(max(2 * rp - 4, 0), 24);
    const size_t tb = (size_t)b * SEQ;
    lds_barrier();
    na_rows_store(lds, tid, R.k);
    __builtin_amdgcn_sched_barrier(0);
    na_rows_load(QKV, un, 8, tid, R.k);
    __builtin_amdgcn_sched_barrier(0);
    lds_barrier();
    f32x4 S[8][2];
    s_accum<8, 64 * VROW>(lds + ((r0 - vbase) * 64 + cw + q) * VROW + 16 * g, R.qf0, R.qf1, S);
    __builtin_amdgcn_sched_barrier(0);
    { const NaGeo zn = na_geo(un, wave); na_qload(QKV, zn, lane, R.qf0, R.qf1); }
    lds_barrier();
    na_rows_store(lds, tid, R.v);
    __builtin_amdgcn_sched_barrier(0);
    na_rows_load(QKV, un, 16, tid, R.v);
    __builtin_amdgcn_sched_barrier(0);
    const int thr = c0 - cw;
    const int bbase = h * 465 + (r0 - rr + 7) * 31 + (cw + 4 * g - c + 15);
    bool ux[4]; int bi[4];
#pragma unroll
    for (int r = 0; r < 4; ++r) { ux[r] = (4 * g + r) >= thr; bi[r] = bbase + r + (ux[r] ? 0 : 16); }
    f32x4 Sm[8];
#pragma unroll
    for (int ch = 0; ch < 8; ++ch)
#pragma unroll
        for (int r = 0; r < 4; ++r) Sm[ch][r] = (ux[r] ? S[ch][0][r] : S[ch][1][r]) + rpb[bi[r] + ch * 31];
    bf16x8 pa[8]; float mx, l;
    {
        float m0 = -1e30f, m1 = -1e30f;
#pragma unroll
        for (int ch = 0; ch < 8; ++ch) { m0 = fmaxf(m0, fmaxf(Sm[ch][0], Sm[ch][1])); m1 = fmaxf(m1, fmaxf(Sm[ch][2], Sm[ch][3])); }
        mx = fmaxf(m0, m1);
        mx = xrow_max(mx);
        l = 0.f;
#pragma unroll
        for (int ch = 0; ch < 8; ++ch) {
            float ex[4], ey[4];
#pragma unroll
            for (int r = 0; r < 4; ++r) { const float e = __builtin_amdgcn_exp2f(Sm[ch][r] - mx); l += e; ex[r] = ux[r] ? e : 0.f; ey[r] = ux[r] ? 0.f : e; }
            u32x4 w; w.x = pkbf(ex[0], ex[1]); w.y = pkbf(ex[2], ex[3]); w.z = pkbf(ey[0], ey[1]); w.w = pkbf(ey[2], ey[3]);
            pa[ch] = __builtin_bit_cast(bf16x8, w);
        }
        l = xrow_sum(l);
    }
    lds_barrier();
    f32x4 o[4];
#pragma unroll
    for (int nt = 0; nt < 4; ++nt) o[nt] = (f32x4){0.f, 0.f, 0.f, 0.f};
    const int i16 = lane & 15, qq = i16 >> 2, pp = i16 & 3;
    const LAS unsigned char* vb = lds + ((r0 - vbase) * 64 + cw + 4 * g + qq) * VROW + pp * 8;
    pv_accum<8, 64 * VROW>(vb, pa, o);
    const float inv = 1.f / l;
    o_store16(pg8::wt_rsrc(p.ws + WS_ONA), (tb + rr * 64 + c) * 512 + h * 64, o, inv, g);
}

struct DilGeo { int b, h, cfg, Dl, L, rho, m0; };
__device__ __forceinline__ DilGeo dil_geo(int v) {
    DilGeo z; z.b = v / 384; int rem = v - z.b * 384; z.h = rem / 48; rem -= z.h * 48; z.cfg = rem >> 4; const int sub = rem & 15;
    z.Dl = z.cfg * 2; z.L = SEQ >> z.Dl; const int nbl = 4 - z.Dl; z.rho = sub >> nbl; z.m0 = (sub & ((1 << nbl) - 1)) * 128; return z;
}
constexpr bool DIL_PV_PIPE = false;
constexpr int DIL_KOFF = 0, DIL_VOFF = 272 * VROW;
struct DilRegs { u32x4 k[4], v[4]; bf16x8 qf0, qf1; };
template <int PART>
__device__ __forceinline__ void dil_prefetch(const bf16_t* QKV, const DilGeo& z, int tid, int lane, int wave, DilRegs& R) {
    const int vr = tid >> 3, vpiece = tid & 7;
#pragma unroll
    for (int ps = 0; ps < 4; ++ps) { const int j = ps * 64 + vr; const int mm = min(max(z.m0 - 64 + j, 0), z.L - 1);
        const size_t tok = ((size_t)mm << z.Dl) + z.rho;
        if (PART != 1) R.k[ps] = *(const u32x4*)(QKV + (((size_t)z.b * 48 + 32 + z.h) * SEQ + tok) * 64 + vpiece * 8);
        if (PART != 0) R.v[ps] = *(const u32x4*)(QKV + (((size_t)z.b * 48 + 40 + z.h) * SEQ + tok) * 64 + vpiece * 8); }
    if (PART != 0) {
        const int mq = z.m0 + 16 * wave + (lane & 15);
        const bf16_t* qp = QKV + (((size_t)z.b * 48 + 24 + z.h) * SEQ + ((size_t)mq << z.Dl) + z.rho) * 64 + 8 * (lane >> 4);
        R.qf0 = *(const bf16x8*)qp; R.qf1 = *(const bf16x8*)(qp + 32);
    }
}
__device__ __forceinline__ void dil_unit(const Params& p, LAS unsigned char* lds, int v, int vn, int tid, int lane, int wave, DilRegs& R) {
    const bf16_t* QKV = (const bf16_t*)(p.ws + WS_QKV);
    const DilGeo z = dil_geo(v);
    const int h = z.h, cfg = z.cfg, Dl = z.Dl, L = z.L, rho = z.rho, m0 = z.m0;
    const int q = lane & 15, g = lane >> 4;
    const size_t tb = (size_t)z.b * SEQ;
    const int mq = m0 + 16 * wave + q;
    const int vr = tid >> 3, vpiece = tid & 7;
    lds_barrier();
#pragma unroll
    for (int ps = 0; ps < 4; ++ps) { const int j = ps * 64 + vr;
        *(LAS u32x4*)(lds + DIL_KOFF + j * VROW + vpiece * 16) = R.k[ps]; *(LAS u32x4*)(lds + DIL_VOFF + j * VROW + vpiece * 16) = R.v[ps]; }
    const bf16x8 qf0 = R.qf0, qf1 = R.qf1;
    lds_barrier();
    TabRow trw; const bool tconv = v < 2 * NEXP / 8;
    tab_row_load(p, tconv ? 8 * v + wave : 0, lane, trw);
    const DilGeo zn = dil_geo(vn);
    dil_prefetch<0>(QKV, zn, tid, lane, wave, R);
    __builtin_amdgcn_sched_barrier(0);
    f32x4 S[5][2];
    s_accum<5, 32 * VROW>(lds + DIL_KOFF + (16 * wave + q) * VROW + 16 * g, qf0, qf1, S);
    const float slope2 = __builtin_amdgcn_exp2f(-(float)(h + 1)) * (float)(1 << Dl) * LOG2E;
    {
        const float fq = (float)(4 * g - q);
#pragma unroll
        for (int ch = 0; ch < 5; ++ch)
#pragma unroll
            for (int xy = 0; xy < 2; ++xy)
#pragma unroll
                for (int r = 0; r < 4; ++r) { const float t = fq + (float)(32 * ch + 16 * xy + r - 64); const float sv = S[ch][xy][r] - slope2 * fabsf(t);
                    S[ch][xy][r] = (ch == 0) ? (t >= -64.f ? sv : -1e30f) : (ch == 4) ? (t <= 64.f ? sv : -1e30f) : sv; }
    }
    if (!(m0 + 16 * wave - 64 >= 0 && m0 + 16 * wave + 95 < L)) {
        const int kp = m0 + 16 * wave - 64 + 4 * g;
#pragma unroll
        for (int ch = 0; ch < 5; ++ch)
#pragma unroll
            for (int xy = 0; xy < 2; ++xy)
#pragma unroll
                for (int r = 0; r < 4; ++r) S[ch][xy][r] = ((unsigned)(kp + 32 * ch + 16 * xy + r) < (unsigned)L) ? S[ch][xy][r] : -1e30f;
    }
    __builtin_amdgcn_sched_barrier(0);
    dil_prefetch<1>(QKV, zn, tid, lane, wave, R);
    __builtin_amdgcn_sched_barrier(0);
    bf16x8 pa[5]; float mx, l;
    softmax_pack<5>(S, pa, mx, l);
    f32x4 o[4];
#pragma unroll
    for (int nt = 0; nt < 4; ++nt) o[nt] = (f32x4){0.f, 0.f, 0.f, 0.f};
    const int i16 = lane & 15, qq = i16 >> 2, pp = i16 & 3;
    const LAS unsigned char* vb = lds + DIL_VOFF + (16 * wave + 4 * g + qq) * VROW + pp * 8;
    pv_accum<5, 32 * VROW, DIL_PV_PIPE>(vb, pa, o);
    const float inv = 1.f / l;
    int g7 = g; asm volatile("" : "+v"(g7));
    const size_t tq = tb + ((size_t)(m0 + 16 * wave + (lane & 15)) << Dl) + rho;
    o_store16(pg8::wt_rsrc(p.ws + WS_OD), (size_t)cfg * TOK * 512 + tq * 512 + h * 64, o, inv, g7);
    if (g7 == 0) ((float*)(p.ws + WS_LSE))[((size_t)cfg * TOK + tq) * 8 + h] = mx + __builtin_amdgcn_logf(l);
    if (tconv) tab_row_finish(p, 8 * v + wave, lane, trw);
}

__device__ __forceinline__ void attn_phase(const Params& p, LAS unsigned char* lds, int tid, int lane, int wave, int vcu, int G) {
    const bf16_t* QKV = (const bf16_t*)(p.ws + WS_QKV);
    LAS float* rp = (LAS float*)(lds + RPB_OFF);
    {
        float rv[8];
#pragma unroll
        for (int u = 0; u < 8; ++u) { const int k = tid + 512 * u - 64; rv[u] = (k >= 0 && k < 8 * 465) ? p.na_rpb[k] : 0.f; }
#pragma unroll
        for (int u = 0; u < 8; ++u) { const int i = tid + 512 * u; if (i < 64 + 8 * 465 + 64) rp[i] = rv[u] * LOG2E; }
    }
    __syncthreads();
    {
        NaRegs R;
        int u = vcu;
        if (u < NUNIT_NA) { const NaGeo z = na_geo(u, wave); na_qload(QKV, z, lane, R.qf0, R.qf1); na_rows_load(QKV, u, 8, tid, R.k); na_rows_load(QKV, u, 16, tid, R.v); }
        for (; u < NUNIT_NA; u += G) na_unit(p, lds, u, (u + G < NUNIT_NA) ? u + G : u, tid, lane, wave, R);
    }
    {
        DilRegs R0, R1;
        int v = vcu;
        lds_barrier();
        if (tid < 16 * 8) { const int j = 256 + (tid >> 3); *(LAS u32x4*)(lds + DIL_KOFF + j * VROW + (tid & 7) * 16) = (u32x4){0u, 0u, 0u, 0u}; *(LAS u32x4*)(lds + DIL_VOFF + j * VROW + (tid & 7) * 16) = (u32x4){0u, 0u, 0u, 0u}; }
        if (v < NUNIT_DIL) { const DilGeo z = dil_geo(v); dil_prefetch<2>(QKV, z, tid, lane, wave, R0); }
        if (v + G < NUNIT_DIL) { const DilGeo z = dil_geo(v + G); dil_prefetch<2>(QKV, z, tid, lane, wave, R1); }
        for (; v < NUNIT_DIL; v += 2 * G) {
            dil_unit(p, lds, v, (v + 2 * G < NUNIT_DIL) ? v + 2 * G : v, tid, lane, wave, R0);
            if (v + G < NUNIT_DIL) dil_unit(p, lds, v + G, (v + 3 * G < NUNIT_DIL) ? v + 3 * G : v + G, tid, lane, wave, R1);
        }
    }
}

__device__ __forceinline__ void unpack8(const u32x4 w, float (&f)[8]) { f[0] = bf_lo(w.x); f[1] = bf_hi(w.x); f[2] = bf_lo(w.y); f[3] = bf_hi(w.y); f[4] = bf_lo(w.z); f[5] = bf_hi(w.z); f[6] = bf_lo(w.w); f[7] = bf_hi(w.w); }
__device__ __forceinline__ void quant_rows(const bf16_t* W, unsigned char* Q, float* S, int R, int gw, int NGW, int lane) {
    for (int n = gw; n < R; n += NGW) {
        float f[16]; { float a[8], b[8]; unpack8(*((const u32x4*)(W + (size_t)n * DM) + 2 * lane), a); unpack8(*((const u32x4*)(W + (size_t)n * DM) + 2 * lane + 1), b);
#pragma unroll
            for (int e = 0; e < 8; ++e) { f[e] = a[e]; f[8 + e] = b[e]; } }
        float am = 0.f;
#pragma unroll
        for (int e = 0; e < 16; ++e) am = fmaxf(am, fabsf(f[e]));
am = wave_max(am);
        const float inv = am > 0.f ? 127.f / am : 0.f;
        u32x4 w;
#pragma unroll
        for (int c = 0; c < 4; ++c) w[c] = q8_pack4(f[4 * c], f[4 * c + 1], f[4 * c + 2], f[4 * c + 3], inv);
        *((u32x4*)(Q + (size_t)n * DM) + lane) = w;
        if (lane == 0) S[n] = am * (1.f / 127.f);
    }
}
__device__ __forceinline__ void merge_norm(const Params& p, int gw, int NGW, int lane) {
    const bf16_t* ONA = (const bf16_t*)(p.ws + WS_ONA); const bf16_t* OD = (const bf16_t*)(p.ws + WS_OD); const float* LSE = (const float*)(p.ws + WS_LSE);
    unsigned char* Hn = p.ws + WS_H; float* SHB = (float*)(p.ws + WS_SHB);
    const int hh = lane >> 3;
    u32x4 ra[2][4]; float rl[2][3];
#define MN_LOAD(slot, tok) do { const size_t t_ = (size_t)((tok) < TOK ? (tok) : TOK - 1); \
        ra[slot][0] = __builtin_nontemporal_load((const u32x4*)(ONA + t_ * 512 + 8 * lane)); ra[slot][1] = __builtin_nontemporal_load((const u32x4*)(OD + t_ * 512 + 8 * lane)); \
        ra[slot][2] = __builtin_nontemporal_load((const u32x4*)(OD + ((size_t)TOK + t_) * 512 + 8 * lane)); ra[slot][3] = __builtin_nontemporal_load((const u32x4*)(OD + ((size_t)2 * TOK + t_) * 512 + 8 * lane)); \
        rl[slot][0] = LSE[t_ * 8 + hh]; rl[slot][1] = LSE[((size_t)TOK + t_) * 8 + hh]; rl[slot][2] = LSE[((size_t)2 * TOK + t_) * 8 + hh]; } while (0)
    MN_LOAD(0, gw); MN_LOAD(1, gw + NGW);
    for (int t0 = gw; t0 < TOK; t0 += 2 * NGW)
#pragma unroll
    for (int sl = 0; sl < 2; ++sl) { const int t = t0 + sl * NGW; if (t >= TOK) break;
        float na[8], d0[8], d1[8], d2[8];
        unpack8(ra[sl][0], na); unpack8(ra[sl][1], d0); unpack8(ra[sl][2], d1); unpack8(ra[sl][3], d2);
        const float l0 = rl[sl][0], l1 = rl[sl][1], l2 = rl[sl][2];
        MN_LOAD(sl, t + 2 * NGW);
        const float m = fmaxf(l0, fmaxf(l1, l2));
        const float e0 = __builtin_amdgcn_exp2f(l0 - m), e1 = __builtin_amdgcn_exp2f(l1 - m), e2 = __builtin_amdgcn_exp2f(l2 - m), ie = 1.f / (e0 + e1 + e2);
        const float al0 = e0 * ie, al1 = e1 * ie, al2 = e2 * ie;
        float ssa = 0.f, ssb = 0.f, dl[8];
#pragma unroll
        for (int k = 0; k < 8; ++k) { dl[k] = al0 * d0[k] + al1 * d1[k] + al2 * d2[k]; ssa += na[k] * na[k]; ssb += dl[k] * dl[k]; }
        const float rsa = rsqrtf(wave_sum(ssa) * (1.f / 512.f) + EPS), rsb = rsqrtf(wave_sum(ssb) * (1.f / 512.f) + EPS);
        float am = 0.f;
#pragma unroll
        for (int k = 0; k < 8; ++k) { na[k] *= rsa; dl[k] *= rsb; am = fmaxf(am, fmaxf(fabsf(na[k]), fabsf(dl[k]))); }
am = wave_max(am);
        const float inv = am > 0.f ? 127.f / am : 0.f;
        u32x2 wa, wb;
#pragma unroll
        for (int c = 0; c < 2; ++c) {
            wa[c] = q8_pack4(na[4 * c], na[4 * c + 1], na[4 * c + 2], na[4 * c + 3], inv);
            wb[c] = q8_pack4(dl[4 * c], dl[4 * c + 1], dl[4 * c + 2], dl[4 * c + 3], inv); }
        *(u32x2*)(Hn + (size_t)t * DM + 8 * lane) = wa;
        *(u32x2*)(Hn + (size_t)t * DM + 512 + 8 * lane) = wb;
        if (lane == 0) SHB[t] = am * (1.f / 127.f);
    }
#undef MN_LOAD
}

__device__ __forceinline__ void ce(float& a, float& b) { const float hi = fmaxf(a, b), lo = fminf(a, b); a = hi; b = lo; }
template <int N> __device__ __forceinline__ void bitonic_sort_desc(float (&v)[N]) {
#pragma unroll
    for (int k = 2; k <= N; k <<= 1)
#pragma unroll
        for (int j = k >> 1; j > 0; j >>= 1)
#pragma unroll
            for (int i = 0; i < N; ++i) { const int l = i ^ j; if (l > i) { if ((i & k) == 0) ce(v[i], v[l]); else ce(v[l], v[i]); } }
}
__device__ __forceinline__ void sort16_desc(float (&v)[16]) {
    ce(v[0], v[1]); ce(v[2], v[3]); ce(v[0], v[2]); ce(v[1], v[3]); ce(v[1], v[2]); ce(v[4], v[5]); ce(v[6], v[7]); ce(v[4], v[6]); ce(v[5], v[7]); ce(v[5], v[6]); ce(v[0], v[4]); ce(v[2], v[6]); ce(v[2], v[4]); ce(v[1], v[5]); ce(v[3], v[7]); ce(v[3], v[5]); ce(v[1], v[2]); ce(v[3], v[4]); ce(v[5], v[6]); ce(v[8], v[9]); ce(v[10], v[11]); ce(v[8], v[10]); ce(v[9], v[11]); ce(v[9], v[10]); ce(v[12], v[13]); ce(v[14], v[15]); ce(v[12], v[14]); ce(v[13], v[15]); ce(v[13], v[14]); ce(v[8], v[12]); ce(v[10], v[14]); ce(v[10], v[12]); ce(v[9], v[13]); ce(v[11], v[15]); ce(v[11], v[13]); ce(v[9], v[10]); ce(v[11], v[12]); ce(v[13], v[14]); ce(v[0], v[8]); ce(v[4], v[12]); ce(v[4], v[8]); ce(v[2], v[10]); ce(v[6], v[14]); ce(v[6], v[10]); ce(v[2], v[4]); ce(v[6], v[8]); ce(v[10], v[12]); ce(v[1], v[9]); ce(v[5], v[13]); ce(v[5], v[9]); ce(v[3], v[11]); ce(v[7], v[15]); ce(v[7], v[11]); ce(v[3], v[5]); ce(v[7], v[9]); ce(v[11], v[13]); ce(v[1], v[2]); ce(v[3], v[4]); ce(v[5], v[6]); ce(v[7], v[8]); ce(v[9], v[10]); ce(v[11], v[12]); ce(v[13], v[14]);
}
template <int N> __device__ __forceinline__ void bitonic_merge_desc(float (&v)[N]) {
#pragma unroll
    for (int j = N >> 1; j > 0; j >>= 1)
#pragma unroll
        for (int i = 0; i < N; ++i) if ((i & j) == 0) ce(v[i], v[i | j]);
}
__device__ __forceinline__ float h2f_lo(unsigned u) { return (float)__builtin_bit_cast(_Float16, (unsigned short)(u & 0xffffu)); }
__device__ __forceinline__ float h2f_hi(unsigned u) { return (float)__builtin_bit_cast(_Float16, (unsigned short)(u >> 16)); }
__device__ __forceinline__ void top16_of_128(const LAS unsigned char* row, float (&run)[16]) {
#pragma unroll
    for (int gi = 0; gi < 8; ++gi) {
        float grp[16];
#pragma unroll
        for (int q4 = 0; q4 < 2; ++q4) { const u32x4 v = *(const LAS u32x4*)(row + gi * 32 + q4 * 16);
#pragma unroll
            for (int e = 0; e < 4; ++e) {
                grp[8 * q4 + 2 * e] = __uint_as_float(__float_as_uint(h2f_lo(v[e])) | (unsigned)(gi * 16 + 8 * q4 + 2 * e));
                grp[8 * q4 + 2 * e + 1] = __uint_as_float(__float_as_uint(h2f_hi(v[e])) | (unsigned)(gi * 16 + 8 * q4 + 2 * e + 1)); } }
        sort16_desc(grp);
        if (gi == 0) {
#pragma unroll
            for (int i = 0; i < 16; ++i) run[i] = grp[i];
        } else {
#pragma unroll
            for (int i = 0; i < 16; ++i) run[i] = fmaxf(run[i], grp[15 - i]);
            bitonic_merge_desc<16>(run);
        }
    }
}
#define CAND(i, j) __uint_as_float((__float_as_uint(v1[i] + v2[j]) & ~0xFFu) | (unsigned)((i) * 16 + (j)))
constexpr int TK_ROW = 272;
__device__ __forceinline__ void tk_stage(const _Float16* SC, LAS unsigned char* wb, int t0, int col0, int lane) {
    u32x4 v[16];
#pragma unroll
    for (int i = 0; i < 16; ++i) { const int pi = i * 64 + lane, row = pi >> 4, ch = pi & 15; v[i] = __builtin_nontemporal_load((const u32x4*)(SC + (size_t)(t0 + (row >> 3)) * NPQ + (row & 7) * 256 + col0 + ch * 8)); }
#pragma unroll
    for (int i = 0; i < 16; ++i) { const int pi = i * 64 + lane, row = pi >> 4, ch = pi & 15; *(LAS u32x4*)(wb + row * TK_ROW + ch * 16) = v[i]; }
}
__device__ __forceinline__ void topk_phase(const Params& p, LAS unsigned char* lds, int gw, int NGW, int lane, int wave) {
    const _Float16* SC = (const _Float16*)(p.ws + WS_SC);
    unsigned* IDS = (unsigned*)(p.ws + WS_IDS); unsigned* GATES = (unsigned*)(p.ws + WS_GATES);
    LAS unsigned char* wb = lds + wave * (64 * TK_ROW);
    LAS unsigned char* my = wb + lane * TK_ROW;
    const float NEG = -3.0e38f;
    for (int wi = gw; wi < (TOK / 64) * 8; wi += NGW) {
        const int t0 = wi * 8, hh = lane & 7, it = (t0 + (lane >> 3)) * 8 + hh;
        float v1[16], v2[16];
        tk_stage(SC, wb, t0, 0, lane);
        top16_of_128(my, v1);
        tk_stage(SC, wb, t0, 128, lane);
        top16_of_128(my, v2);
        {
            u32x4 w1, w2;
#define PK4(v, o) ((__float_as_uint(v[o]) & 0x7Fu) | ((__float_as_uint(v[o + 1]) & 0x7Fu) << 8) | ((__float_as_uint(v[o + 2]) & 0x7Fu) << 16) | ((__float_as_uint(v[o + 3]) & 0x7Fu) << 24))
            w1.x = PK4(v1, 0); w1.y = PK4(v1, 4); w1.z = PK4(v1, 8); w1.w = PK4(v1, 12);
            w2.x = PK4(v2, 0); w2.y = PK4(v2, 4); w2.z = PK4(v2, 8); w2.w = PK4(v2, 12);
#undef PK4
            *(LAS u32x4*)my = w1; *(LAS u32x4*)(my + 16) = w2;
        }
        float best[16], grp[16];
        best[0] = CAND(0, 0); best[1] = CAND(0, 1); best[2] = CAND(0, 2); best[3] = CAND(0, 3); best[4] = CAND(0, 4); best[5] = CAND(0, 5); best[6] = CAND(0, 6); best[7] = CAND(0, 7);
        best[8] = CAND(0, 8); best[9] = CAND(0, 9); best[10] = CAND(0, 10); best[11] = CAND(0, 11); best[12] = CAND(0, 12); best[13] = CAND(0, 13); best[14] = CAND(0, 14); best[15] = CAND(0, 15);
        sort16_desc(best);
        grp[0] = CAND(1, 0); grp[1] = CAND(1, 1); grp[2] = CAND(1, 2); grp[3] = CAND(1, 3); grp[4] = CAND(1, 4); grp[5] = CAND(1, 5); grp[6] = CAND(1, 6); grp[7] = CAND(1, 7);
        grp[8] = CAND(2, 0); grp[9] = CAND(2, 1); grp[10] = CAND(2, 2); grp[11] = CAND(2, 3); grp[12] = CAND(2, 4); grp[13] = CAND(3, 0); grp[14] = CAND(3, 1); grp[15] = CAND(3, 2);
        sort16_desc(grp);
#pragma unroll
        for (int i = 0; i < 16; ++i) best[i] = fmaxf(best[i], grp[15 - i]);
        bitonic_merge_desc<16>(best);
        grp[0] = CAND(3, 3); grp[1] = CAND(4, 0); grp[2] = CAND(4, 1); grp[3] = CAND(4, 2); grp[4] = CAND(5, 0); grp[5] = CAND(5, 1); grp[6] = CAND(6, 0); grp[7] = CAND(6, 1);
        grp[8] = CAND(7, 0); grp[9] = CAND(7, 1); grp[10] = CAND(8, 0); grp[11] = CAND(9, 0); grp[12] = CAND(10, 0); grp[13] = CAND(11, 0); grp[14] = CAND(12, 0); grp[15] = CAND(13, 0);
        sort16_desc(grp);
#pragma unroll
        for (int i = 0; i < 16; ++i) best[i] = fmaxf(best[i], grp[15 - i]);
        bitonic_merge_desc<16>(best);
        grp[0] = CAND(14, 0); grp[1] = CAND(15, 0);
#pragma unroll
        for (int i = 2; i < 16; ++i) grp[i] = NEG;
        sort16_desc(grp);
#pragma unroll
        for (int i = 0; i < 16; ++i) best[i] = fmaxf(best[i], grp[15 - i]);
        bitonic_merge_desc<16>(best);
        float e[16], sum = 0.f;
#pragma unroll
        for (int k = 0; k < 16; ++k) { e[k] = __expf(best[k] - best[0]); sum += e[k]; }
        const float isum = 1.f / sum;
        int idv[16];
        asm volatile("s_waitcnt lgkmcnt(0)" ::: "memory");
#pragma unroll
        for (int k = 0; k < 16; ++k) { const unsigned code = __float_as_uint(best[k]) & 0xFFu; const unsigned i1 = my[code >> 4], i2 = my[16 + (code & 15u)]; idv[k] = (int)(i1 * 128u + i2); }
        const int tt = it >> 3;
        unsigned* ip = IDS + (size_t)tt * 64 + hh; unsigned* gp = GATES + (size_t)tt * 64 + hh;
#pragma unroll
        for (int j = 0; j < 8; ++j) {
            ip[8 * j] = (unsigned)idv[j] | ((unsigned)idv[j + 8] << 16);
            gp[8 * j] = pkh(e[j] * isum, e[j + 8] * isum);
        }
    }
}
#undef CAND

constexpr int PE_SEG_AUX = 1;
struct Topo { int xi, nx, rank, nloc; };
constexpr int CW_XCNT = 8192;
__device__ __forceinline__ unsigned pack4(int a, int b, int c, int d) { return ((unsigned)a & 255u) | (((unsigned)b & 255u) << 8) | (((unsigned)c & 255u) << 16) | ((unsigned)d << 24); }
template <int CTRL> __device__ __forceinline__ int dppi(int v) { return __builtin_amdgcn_update_dpp(0, v, CTRL, 0xF, 0xF, false); }

#define PE_LOAD_IDS(ids, tok) do { const u32x4* ip_ = (const u32x4*)(IDST + (size_t)(tok) * 64 + 8 * j); ids[0] = ip_[0]; ids[1] = ip_[1]; } while (0)
#define PE_LOAD_SEGS(seg, ids, tab) do { _Pragma("unroll") for (int i_ = 0; i_ < 16; ++i_) seg[i_] = __builtin_amdgcn_raw_buffer_load_b128(tab##_rs, (((i_ & 1) ? (ids[i_ >> 3][(i_ >> 1) & 3] >> 16) : (ids[i_ >> 3][(i_ >> 1) & 3] & 0xffffu)) << 7) + 16u * (unsigned)q, 0, PE_SEG_AUX); } while (0)

__device__ __forceinline__ void pe_u_compute(const u32x4 (&seg)[16], const u32x4 h8, unsigned* dst, bool live, int lane) {
    int a[16];
#pragma unroll
    for (int i = 0; i < 16; ++i) { int s_ = 0;
#pragma unroll
        for (int w = 0; w < 4; ++w) s_ = __builtin_amdgcn_sdot4((int)seg[i][w], (int)h8[w], s_, false);
        a[i] = s_; }
    const bool q2 = (lane & 4) != 0, q1 = (lane & 2) != 0, q0 = (lane & 1) != 0;
    int c[8], d[4], e[2];
#pragma unroll
    for (int i = 0; i < 8; ++i) { const int keep = q2 ? a[i + 8] : a[i], send = q2 ? a[i] : a[i + 8]; c[i] = keep + dppi<0x141>(send); }
#pragma unroll
    for (int i = 0; i < 4; ++i) { const int keep = q1 ? c[i + 4] : c[i], send = q1 ? c[i] : c[i + 4]; d[i] = keep + dppi<0x4E>(send); }
#pragma unroll
    for (int i = 0; i < 2; ++i) { const int keep = q0 ? d[i + 2] : d[i], send = q0 ? d[i] : d[i + 2]; e[i] = keep + dppi<0xB1>(send); }
    if (live) *dst = pkh((float)e[0] * (1.f / 64.f), (float)e[1] * (1.f / 64.f));
}
__device__ __forceinline__ void peer_u_phase(const Params& p, const Topo& tp, int lane, int wave) {
    const unsigned* IDST = (const unsigned*)(p.ws + WS_IDS); const unsigned char* H8 = p.ws + WS_H8; unsigned* PART = (unsigned*)(p.ws + WS_PART);
    const int j = lane >> 3, q = lane & 7;
    const int wv = __builtin_amdgcn_readfirstlane(tp.rank * 8 + wave), nwv = __builtin_amdgcn_readfirstlane(tp.nloc * 8);
    for (int s = tp.xi; s < 8; s += tp.nx) {
        const __amdgpu_buffer_rsrc_t tab_rs = __builtin_amdgcn_make_buffer_rsrc(p.ws + WS_UH + (size_t)s * NEXP * 128, 0, NEXP * 128, 0x00020000);
        const unsigned char* hb = H8 + 128 * s + 16 * q;
        unsigned* pb = PART + (size_t)s * TOK * 64 + j * 8 + q;
        u32x4 idsA[2], idsB[2], segA[16], segB[16], h8A, h8B;
        int t = wv;
#define TC(x) ((x) < TOK ? (x) : TOK - 1)
        PE_LOAD_IDS(idsA, TC(t));
        PE_LOAD_IDS(idsB, TC(t + nwv));
        PE_LOAD_SEGS(segA, idsA, tab); h8A = *(const u32x4*)(hb + (size_t)TC(t) * 1024);
        for (; t < TOK; t += 8 * nwv) {
            PE_LOAD_IDS(idsA, TC(t + (2 + 0) * nwv));
            __builtin_amdgcn_sched_barrier(0);
            PE_LOAD_SEGS(segB, idsB, tab); h8B = *(const u32x4*)(hb + (size_t)TC(t + (1 + 0) * nwv) * 1024);
            __builtin_amdgcn_sched_barrier(0);
            pe_u_compute(segA, h8A, pb + (size_t)TC(t + (0) * nwv) * 64, t + (0) * nwv < TOK, lane);
            PE_LOAD_IDS(idsB, TC(t + (3 + 0) * nwv));
            __builtin_amdgcn_sched_barrier(0);
            PE_LOAD_SEGS(segA, idsA, tab); h8A = *(const u32x4*)(hb + (size_t)TC(t + (2 + 0) * nwv) * 1024);
            __builtin_amdgcn_sched_barrier(0);
            pe_u_compute(segB, h8B, pb + (size_t)TC(t + (1 + 0) * nwv) * 64, t + (1 + 0) * nwv < TOK, lane);
            PE_LOAD_IDS(idsA, TC(t + (2 + 2) * nwv));
            __builtin_amdgcn_sched_barrier(0);
            PE_LOAD_SEGS(segB, idsB, tab); h8B = *(const u32x4*)(hb + (size_t)TC(t + (1 + 2) * nwv) * 1024);
            __builtin_amdgcn_sched_barrier(0);
            pe_u_compute(segA, h8A, pb + (size_t)TC(t + (2) * nwv) * 64, t + (2) * nwv < TOK, lane);
            PE_LOAD_IDS(idsB, TC(t + (3 + 2) * nwv));
            __builtin_amdgcn_sched_barrier(0);
            PE_LOAD_SEGS(segA, idsA, tab); h8A = *(const u32x4*)(hb + (size_t)TC(t + (2 + 2) * nwv) * 1024);
            __builtin_amdgcn_sched_barrier(0);
            pe_u_compute(segB, h8B, pb + (size_t)TC(t + (1 + 2) * nwv) * 64, t + (1 + 2) * nwv < TOK, lane);
            PE_LOAD_IDS(idsA, TC(t + (2 + 4) * nwv));
            __builtin_amdgcn_sched_barrier(0);
            PE_LOAD_SEGS(segB, idsB, tab); h8B = *(const u32x4*)(hb + (size_t)TC(t + (1 + 4) * nwv) * 1024);
            __builtin_amdgcn_sched_barrier(0);
            pe_u_compute(segA, h8A, pb + (size_t)TC(t + (4) * nwv) * 64, t + (4) * nwv < TOK, lane);
            PE_LOAD_IDS(idsB, TC(t + (3 + 4) * nwv));
            __builtin_amdgcn_sched_barrier(0);
            PE_LOAD_SEGS(segA, idsA, tab); h8A = *(const u32x4*)(hb + (size_t)TC(t + (2 + 4) * nwv) * 1024);
            __builtin_amdgcn_sched_barrier(0);
            pe_u_compute(segB, h8B, pb + (size_t)TC(t + (1 + 4) * nwv) * 64, t + (1 + 4) * nwv < TOK, lane);
            PE_LOAD_IDS(idsA, TC(t + (2 + 6) * nwv));
            __builtin_amdgcn_sched_barrier(0);
            PE_LOAD_SEGS(segB, idsB, tab); h8B = *(const u32x4*)(hb + (size_t)TC(t + (1 + 6) * nwv) * 1024);
            __builtin_amdgcn_sched_barrier(0);
            pe_u_compute(segA, h8A, pb + (size_t)TC(t + (6) * nwv) * 64, t + (6) * nwv < TOK, lane);
            PE_LOAD_IDS(idsB, TC(t + (3 + 6) * nwv));
            __builtin_amdgcn_sched_barrier(0);
            PE_LOAD_SEGS(segA, idsA, tab); h8A = *(const u32x4*)(hb + (size_t)TC(t + (2 + 6) * nwv) * 1024);
            __builtin_amdgcn_sched_barrier(0);
            pe_u_compute(segB, h8B, pb + (size_t)TC(t + (1 + 6) * nwv) * 64, t + (1 + 6) * nwv < TOK, lane);
        }
    }
}
__device__ __forceinline__ void peer_w_phase(const Params& p, int gw, int NGW, int lane) {
    const unsigned* IDST = (const unsigned*)(p.ws + WS_IDS); const unsigned* GT = (const unsigned*)(p.ws + WS_GATES); const unsigned* PART = (const unsigned*)(p.ws + WS_PART);
    const f32x2_t* SUV = (const f32x2_t*)(p.ws + WS_SU); const float* SH = (const float*)(p.ws + WS_SH);
    unsigned short* W8 = (unsigned short*)(p.ws + WS_W8); float* SW = (float*)(p.ws + WS_SW);
    unsigned rp[2][8], rid[2], rg[2]; float rsh[2];
#define PW_LOAD(slot, tok) do { const size_t t_ = (size_t)((tok) < TOK ? (tok) : TOK - 1), i_ = t_ * 64 + lane; \
        _Pragma("unroll") for (int s_ = 0; s_ < 8; ++s_) rp[slot][s_] = __builtin_nontemporal_load(PART + (size_t)s_ * TOK * 64 + i_); rid[slot] = IDST[i_]; rg[slot] = GT[i_]; rsh[slot] = SH[t_]; } while (0)
    PW_LOAD(0, gw); PW_LOAD(1, gw + NGW);
    for (int t0 = gw; t0 < TOK; t0 += 2 * NGW)
#pragma unroll
    for (int sl = 0; sl < 2; ++sl) { const int t = t0 + sl * NGW; if (t >= TOK) break;
        const size_t ix = (size_t)t * 128 + 2 * lane;
        float a0 = 0.f, a1 = 0.f;
#pragma unroll
        for (int s = 0; s < 8; ++s) { const unsigned v = rp[sl][s]; a0 += h2f_lo(v); a1 += h2f_hi(v); }
        const unsigned idp = rid[sl]; const u32x2 id = {idp & 0xffffu, idp >> 16}; const unsigned gpk = rg[sl]; const f32x2_t g = {h2f_lo(gpk), h2f_hi(gpk)};
        const float sh = rsh[sl];
        const f32x2_t sc0 = SUV[id.x], sc1 = SUV[id.y];
        PW_LOAD(sl, t + 2 * NGW);
        const float x0 = a0 * 64.f * sc0.x * sh, x1 = a1 * 64.f * sc1.x * sh;
        const float w0 = g.x * 0.5f * x0 * (1.f + erff(x0 * 0.70710678118654752f)) * sc0.y;
        const float w1 = g.y * 0.5f * x1 * (1.f + erff(x1 * 0.70710678118654752f)) * sc1.y;
        const float wm = wave_max(fmaxf(fabsf(w0), fabsf(w1)));
        const float inv = wm > 0.f ? 127.f / wm : 0.f;
        W8[ix >> 1] = (unsigned short)(((unsigned)((int)rintf(w0 * inv)) & 255u) | (((unsigned)((int)rintf(w1 * inv)) & 255u) << 8));
        if (lane == 0) SW[t] = wm * (1.f / 127.f);
    }
#undef PW_LOAD
}
__device__ __forceinline__ void pe_v_compute(const u32x4 (&seg)[16], const u32x4 w8, float sw, bf16_t* dst, bool live, int lane) {
    int o[16];
#pragma unroll
    for (int i = 0; i < 16; ++i) o[i] = 0;
#pragma unroll
    for (int qd = 0; qd < 4; ++qd)
#pragma unroll
        for (int w = 0; w < 4; ++w) {
            const unsigned ra = seg[4 * qd][w], rb = seg[4 * qd + 1][w], rc = seg[4 * qd + 2][w], rd = seg[4 * qd + 3][w];
            const unsigned abl = __builtin_amdgcn_perm(rb, ra, 0x05010400u), abh = __builtin_amdgcn_perm(rb, ra, 0x07030602u);
            const unsigned cdl = __builtin_amdgcn_perm(rd, rc, 0x05010400u), cdh = __builtin_amdgcn_perm(rd, rc, 0x07030602u);
            o[4 * w + 0] = __builtin_amdgcn_sdot4((int)__builtin_amdgcn_perm(cdl, abl, 0x05040100u), (int)w8[qd], o[4 * w + 0], false);
            o[4 * w + 1] = __builtin_amdgcn_sdot4((int)__builtin_amdgcn_perm(cdl, abl, 0x07060302u), (int)w8[qd], o[4 * w + 1], false);
            o[4 * w + 2] = __builtin_amdgcn_sdot4((int)__builtin_amdgcn_perm(cdh, abh, 0x05040100u), (int)w8[qd], o[4 * w + 2], false);
            o[4 * w + 3] = __builtin_amdgcn_sdot4((int)__builtin_amdgcn_perm(cdh, abh, 0x07060302u), (int)w8[qd], o[4 * w + 3], false);
        }
    int b[8], c[4], d[2];
#pragma unroll
    for (int m = 0; m < 8; ++m) { auto r = __builtin_amdgcn_permlane32_swap((unsigned)o[m], (unsigned)o[m + 8], false, false); b[m] = (int)r[0] + (int)r[1]; }
#pragma unroll
    for (int m = 0; m < 4; ++m) { auto r = __builtin_amdgcn_permlane16_swap((unsigned)b[m], (unsigned)b[m + 4], false, false); c[m] = (int)r[0] + (int)r[1]; }
    const bool b3 = (lane & 8) != 0;
#pragma unroll
    for (int m = 0; m < 2; ++m) { const int keep = b3 ? c[m + 2] : c[m], send = b3 ? c[m] : c[m + 2]; d[m] = keep + dppi<0x128>(send); }
    if (live) *(unsigned*)dst = pkbf((float)d[0] * sw, (float)d[1] * sw);
}
__device__ __forceinline__ void peer_v_phase(const Params& p, const Topo& tp, int lane, int wave) {
    const unsigned* IDST = (const unsigned*)(p.ws + WS_IDS); const unsigned char* W8 = p.ws + WS_W8; const float* SW = (const float*)(p.ws + WS_SW); bf16_t* PEER = (bf16_t*)(p.ws + WS_PEER);
    const int j = lane >> 3, q = lane & 7;
    const int wv = __builtin_amdgcn_readfirstlane(tp.rank * 8 + wave), nwv = __builtin_amdgcn_readfirstlane(tp.nloc * 8);
    for (int s = tp.xi; s < 8; s += tp.nx) {
        const __amdgpu_buffer_rsrc_t tab_rs = __builtin_amdgcn_make_buffer_rsrc(p.ws + WS_VH + (size_t)s * NEXP * 128, 0, NEXP * 128, 0x00020000);
        const unsigned char* wb = W8 + 16 * j;
        bf16_t* ob = PEER + 128 * s + 16 * q + 2 * j;
        u32x4 idsA[2], idsB[2], segA[16], segB[16], w8A, w8B; float swA, swB;
        int t = wv;
        PE_LOAD_IDS(idsA, TC(t));
        PE_LOAD_IDS(idsB, TC(t + nwv));
        PE_LOAD_SEGS(segA, idsA, tab); w8A = *(const u32x4*)(wb + (size_t)TC(t) * 128); swA = SW[TC(t)];
        for (; t < TOK; t += 8 * nwv) {
            PE_LOAD_IDS(idsA, TC(t + (2 + 0) * nwv));
            __builtin_amdgcn_sched_barrier(0);
            PE_LOAD_SEGS(segB, idsB, tab); w8B = *(const u32x4*)(wb + (size_t)TC(t + (1 + 0) * nwv) * 128); swB = SW[TC(t + (1 + 0) * nwv)];
            __builtin_amdgcn_sched_barrier(0);
            pe_v_compute(segA, w8A, swA, ob + (size_t)TC(t + (0) * nwv) * DM, t + (0) * nwv < TOK, lane);
            PE_LOAD_IDS(idsB, TC(t + (3 + 0) * nwv));
            __builtin_amdgcn_sched_barrier(0);
            PE_LOAD_SEGS(segA, idsA, tab); w8A = *(const u32x4*)(wb + (size_t)TC(t + (2 + 0) * nwv) * 128); swA = SW[TC(t + (2 + 0) * nwv)];
            __builtin_amdgcn_sched_barrier(0);
            pe_v_compute(segB, w8B, swB, ob + (size_t)TC(t + (1 + 0) * nwv) * DM, t + (1 + 0) * nwv < TOK, lane);
            PE_LOAD_IDS(idsA, TC(t + (2 + 2) * nwv));
            __builtin_amdgcn_sched_barrier(0);
            PE_LOAD_SEGS(segB, idsB, tab); w8B = *(const u32x4*)(wb + (size_t)TC(t + (1 + 2) * nwv) * 128); swB = SW[TC(t + (1 + 2) * nwv)];
            __builtin_amdgcn_sched_barrier(0);
            pe_v_compute(segA, w8A, swA, ob + (size_t)TC(t + (2) * nwv) * DM, t + (2) * nwv < TOK, lane);
            PE_LOAD_IDS(idsB, TC(t + (3 + 2) * nwv));
            __builtin_amdgcn_sched_barrier(0);
            PE_LOAD_SEGS(segA, idsA, tab); w8A = *(const u32x4*)(wb + (size_t)TC(t + (2 + 2) * nwv) * 128); swA = SW[TC(t + (2 + 2) * nwv)];
            __builtin_amdgcn_sched_barrier(0);
            pe_v_compute(segB, w8B, swB, ob + (size_t)TC(t + (1 + 2) * nwv) * DM, t + (1 + 2) * nwv < TOK, lane);
            PE_LOAD_IDS(idsA, TC(t + (2 + 4) * nwv));
            __builtin_amdgcn_sched_barrier(0);
            PE_LOAD_SEGS(segB, idsB, tab); w8B = *(const u32x4*)(wb + (size_t)TC(t + (1 + 4) * nwv) * 128); swB = SW[TC(t + (1 + 4) * nwv)];
            __builtin_amdgcn_sched_barrier(0);
            pe_v_compute(segA, w8A, swA, ob + (size_t)TC(t + (4) * nwv) * DM, t + (4) * nwv < TOK, lane);
            PE_LOAD_IDS(idsB, TC(t + (3 + 4) * nwv));
            __builtin_amdgcn_sched_barrier(0);
            PE_LOAD_SEGS(segA, idsA, tab); w8A = *(const u32x4*)(wb + (size_t)TC(t + (2 + 4) * nwv) * 128); swA = SW[TC(t + (2 + 4) * nwv)];
            __builtin_amdgcn_sched_barrier(0);
            pe_v_compute(segB, w8B, swB, ob + (size_t)TC(t + (1 + 4) * nwv) * DM, t + (1 + 4) * nwv < TOK, lane);
            PE_LOAD_IDS(idsA, TC(t + (2 + 6) * nwv));
            __builtin_amdgcn_sched_barrier(0);
            PE_LOAD_SEGS(segB, idsB, tab); w8B = *(const u32x4*)(wb + (size_t)TC(t + (1 + 6) * nwv) * 128); swB = SW[TC(t + (1 + 6) * nwv)];
            __builtin_amdgcn_sched_barrier(0);
            pe_v_compute(segA, w8A, swA, ob + (size_t)TC(t + (6) * nwv) * DM, t + (6) * nwv < TOK, lane);
            PE_LOAD_IDS(idsB, TC(t + (3 + 6) * nwv));
            __builtin_amdgcn_sched_barrier(0);
            PE_LOAD_SEGS(segA, idsA, tab); w8A = *(const u32x4*)(wb + (size_t)TC(t + (2 + 6) * nwv) * 128); swA = SW[TC(t + (2 + 6) * nwv)];
            __builtin_amdgcn_sched_barrier(0);
            pe_v_compute(segB, w8B, swB, ob + (size_t)TC(t + (1 + 6) * nwv) * DM, t + (1 + 6) * nwv < TOK, lane);
        }
    }
}
#undef TC
#undef PE_LOAD_IDS
#undef PE_LOAD_SEGS
__device__ __forceinline__ void final_phase(const Params& p, float* dstbase, int gw, int NGW, int lane) {
    const float* mod = (const float*)(p.ws + WS_MOD); const bf16_t* PEER = (const bf16_t*)(p.ws + WS_PEER);
    f32x4 fg[4];
#pragma unroll
    for (int j = 0; j < 4; ++j) fg[j] = *(const f32x4*)(p.final_g + 4 * lane + 256 * j);
    const __amdgpu_buffer_rsrc_t ors = pg8::wt_rsrc(dstbase);
    for (int t = gw; t < TOK; t += NGW) {
        const float* mb = mod + (size_t)(t >> 11) * 6144 + 5120;
        const f32x4* xr = (const f32x4*)(p.x + (size_t)t * DM) + lane; const u32x2* pr = (const u32x2*)(PEER + (size_t)t * DM) + lane; const u32x2* zr = (const u32x2*)((const bf16_t*)(p.ws + WS_Z) + (size_t)t * DM) + lane;
        f32x4* xw = (f32x4*)(dstbase + (size_t)t * DM) + lane;
        f32x4 x2[4]; float ss = 0.f;
#pragma unroll
        for (int j = 0; j < 4; ++j) { const f32x4 g2 = *(const f32x4*)(mb + 4 * lane + 256 * j); const u32x2 pv = __builtin_nontemporal_load(pr + 64 * j), zv = __builtin_nontemporal_load(zr + 64 * j); x2[j] = __builtin_nontemporal_load(xr + 64 * j) + (f32x4){bf_lo(zv.x), bf_hi(zv.x), bf_lo(zv.y), bf_hi(zv.y)} + g2 * (f32x4){bf_lo(pv.x), bf_hi(pv.x), bf_lo(pv.y), bf_hi(pv.y)};
            ss += (x2[j][0] * x2[j][0] + x2[j][1] * x2[j][1]) + (x2[j][2] * x2[j][2] + x2[j][3] * x2[j][3]); }
        const float rs = rsqrtf(wave_sum(ss) * (1.f / DM) + EPS);
#pragma unroll
        for (int j = 0; j < 4; ++j) pg8::wt_store16(ors, ((size_t)t * DM + 4 * lane + 256 * j) * 4, __builtin_bit_cast(u32x4, x2[j] * rs * fg[j]));
    }
}

__global__ void __launch_bounds__(512, 2) mk_fwd(Params p) {
    extern __shared__ __attribute__((aligned(16))) unsigned char lds_raw[];
    LAS unsigned char* lds = (LAS unsigned char*)lds_raw;
    const int tid = threadIdx.x, lane = tid & 63, wave = __builtin_amdgcn_readfirstlane(tid >> 6);
    const int G = gridDim.x, bx = blockIdx.x;
    const int vcu = (G % 8 == 0) ? (bx % 8) * (G / 8) + bx / 8 : bx;
    const int gw = vcu * 8 + wave, NGW = G * 8;
    const float* mod = (const float*)(p.ws + WS_MOD);
#if MK_COOP
    volatile LAS unsigned* bst = (volatile LAS unsigned*)(lds + LDS_BYTES - 16);
    if (tid < 4) bst[tid] = 0u;
    __syncthreads();
    const XcdBarrier xb = xcd_barrier_post((unsigned*)(p.ws + WS_CTL) + 1024, bst);
    if (tid == 0) bst[2] = __hip_atomic_fetch_add((unsigned*)(p.ws + WS_CTL) + CW_XCNT + 64 * xb.x, 1u, __ATOMIC_RELAXED, __HIP_MEMORY_SCOPE_AGENT);
#define PHASE_END(k) do { if ((k) + 1 < p.ph_hi) xcd_barrier(xb); } while (0)
#else
#define PHASE_END(k) do { } while (0)
#endif
#define IN(k) (p.ph_lo <= (k) && (k) < p.ph_hi)
    if (IN(0)) { p0_mod(p, lds, tid, lane, wave); p0_weights(p, lds, tid, lane, wave); PHASE_END(0); }
    if (IN(1)) {
        quant_rows((const bf16_t*)(p.ws + WS_WIN), p.ws + WS_W8IN, (float*)(p.ws + WS_SWIN), NQKV, gw, NGW, lane);
        quant_rows((const bf16_t*)(p.ws + WS_WOUT), p.ws + WS_W8OUT, (float*)(p.ws + WS_SWOUT), DM, gw, NGW, lane);
        quant_rows((const bf16_t*)(p.ws + WS_WSC), p.ws + WS_W8SC, (float*)(p.ws + WS_SWN), NPQ, NGW - 1 - gw, NGW, lane);
        norm_rows<false>(p.x, nullptr, p.norm1_g, mod, 0, 1024, p.ws + WS_H, (float*)(p.ws + WS_SHA), gw, NGW, lane); PHASE_END(1);
    }
    if (IN(2)) {
        pg8::Gemm g{(const bf16_t*)(p.ws + WS_H), (const bf16_t*)(p.ws + WS_W8IN), TOK, NQKV, DM}; pg8::StaticOrder S; S.init(TOK, NQKV, G, bx);
        pg8::EpiQKV8 E{(bf16_t*)(p.ws + WS_QKV), QSCALE, (const float*)(p.ws + WS_SHA), (const float*)(p.ws + WS_SWIN)};
        pg8::gemm_phase<pg8::EpiQKV8, pg8::StaticOrder, true, true, true>(lds, g, S, E);
        PHASE_END(2);
    }
    if (IN(3)) { attn_phase(p, lds, tid, lane, wave, vcu, G); PHASE_END(3); }
    if (IN(4)) { merge_norm(p, gw, NGW, lane); PHASE_END(4); }
    if (IN(5)) {
        pg8::Gemm g{(const bf16_t*)(p.ws + WS_H), (const bf16_t*)(p.ws + WS_W8OUT), TOK, DM, DM}; pg8::StaticOrder S; S.init(TOK, DM, G, bx);
        pg8::EpiZ8 E{(bf16_t*)(p.ws + WS_Z), mod, (const float*)(p.ws + WS_SHB), (const float*)(p.ws + WS_SWOUT)};
        pg8::gemm_phase<pg8::EpiZ8, pg8::StaticOrder, true, true, true>(lds, g, S, E);
        PHASE_END(5);
    }
    if (IN(6)) { norm_rows<true>(p.x, (const bf16_t*)(p.ws + WS_Z), p.norm2_g, mod, 3072, 4096, p.ws + WS_H8, (float*)(p.ws + WS_SH), gw, NGW, lane); PHASE_END(6); }
    if (IN(7)) {
        pg8::Gemm g{(const bf16_t*)(p.ws + WS_H8), (const bf16_t*)(p.ws + WS_W8SC), TOK, NPQ, DM}; pg8::StaticOrder S; S.init(TOK, NPQ, G, bx);
        pg8::EpiSC8 E{(_Float16*)(p.ws + WS_SC), NPQ, (const float*)(p.ws + WS_SH), (const float*)(p.ws + WS_SWN)};
        pg8::gemm_phase<pg8::EpiSC8, pg8::StaticOrder, true, true, true>(lds, g, S, E);
        PHASE_END(7);
    }
    if (IN(8)) { topk_phase(p, lds, gw, NGW, lane, wave); PHASE_END(8); }
    Topo tp; tp.xi = 0; tp.nx = 1; tp.rank = bx; tp.nloc = G;
#if MK_COOP
    if (IN(9) || IN(11)) {
        const unsigned* xc = (const unsigned*)(p.ws + WS_CTL) + CW_XCNT; int nx = 0, xi = 0, nloc = 1;
        for (int jx = 0; jx < 16; ++jx) { const unsigned cnt = __hip_atomic_load(xc + 64 * jx, __ATOMIC_RELAXED, __HIP_MEMORY_SCOPE_AGENT); if (cnt) { if (jx < (int)xb.x) ++xi; if (jx == (int)xb.x) nloc = (int)cnt; ++nx; } }
        tp.xi = __builtin_amdgcn_readfirstlane(xi); tp.nx = __builtin_amdgcn_readfirstlane(nx > 0 ? nx : 1); tp.rank = __builtin_amdgcn_readfirstlane((int)bst[2]); tp.nloc = __builtin_amdgcn_readfirstlane(nloc);
    }
#endif
    if (IN(9)) { peer_u_phase(p, tp, lane, wave); PHASE_END(9); }
    if (IN(10)) { peer_w_phase(p, gw, NGW, lane); PHASE_END(10); }
    if (IN(11)) { peer_v_phase(p, tp, lane, wave); PHASE_END(11); }
    if (IN(12)) { final_phase(p, p.out, gw, NGW, lane); }
#undef IN
#undef PHASE_END
}

extern "C" void kernel_launch(void* const* d_in, const int* in_sizes, int n_in, void* d_out, int out_size, void* d_ws, size_t ws_size, hipStream_t stream) {
    static int grid = 0;
    if (grid == 0) {
        if (n_in != 16 || in_sizes[0] != TOK * DM || out_size != TOK * DM || ws_size < WS_END) {
            fprintf(stderr, "kernel_launch: unexpected shapes (n_in %d, in0 %d, out %d, ws %zu)\n", n_in, n_in > 0 ? in_sizes[0] : -1, out_size, ws_size); grid = -1; return; }
        int dev = 0, cus = 0, per_cu = 0;
        if (hipGetDevice(&dev) != hipSuccess || hipDeviceGetAttribute(&cus, hipDeviceAttributeMultiprocessorCount, dev) != hipSuccess) { grid = -1; return; }
        if (hipFuncSetAttribute((const void*)mk_fwd, hipFuncAttributeMaxDynamicSharedMemorySize, LDS_BYTES) != hipSuccess) { fprintf(stderr, "kernel_launch: hipFuncSetAttribute failed\n"); grid = -1; return; }
        if (hipOccupancyMaxActiveBlocksPerMultiprocessor(&per_cu, (const void*)mk_fwd, 512, LDS_BYTES) != hipSuccess || per_cu < 1) { fprintf(stderr, "kernel_launch: occupancy query says %d blocks per CU\n", per_cu); per_cu = 1; }
        (void)hipGetLastError();
        grid = cus;
        if (grid > 2048) { fprintf(stderr, "kernel_launch: %d CUs: the attention phase's table-conversion schedule assumes at most 2048 workgroups\n", grid); grid = -1; return; }
    }
    if (grid < 0) return;
    Params p{};
    p.x = (const float*)d_in[0]; p.c = (const float*)d_in[1]; p.ada_w = (const float*)d_in[2]; p.ada_b = (const float*)d_in[3]; p.norm1_g = (const float*)d_in[4];
    p.w_in = (const float*)d_in[5]; p.na_rpb = (const float*)d_in[6]; p.ong_na = (const float*)d_in[7]; p.ong_dil = (const float*)d_in[8]; p.w_out = (const float*)d_in[9];
    p.norm2_g = (const float*)d_in[10]; p.peer_wq = (const float*)d_in[11]; p.peer_sk = (const float*)d_in[12]; p.peer_u = (const float*)d_in[13]; p.peer_v = (const float*)d_in[14];
    p.final_g = (const float*)d_in[15]; p.out = (float*)d_out; p.ws = (unsigned char*)d_ws;
#if MK_COOP
    if (hipMemsetAsync((char*)d_ws + WS_CTL, 0, 65536, stream) != hipSuccess) { fprintf(stderr, "kernel_launch: memset of the barrier words failed\n"); return; }
    p.ph_lo = 0; p.ph_hi = NPHASE;
    void* args[] = {&p};
    const hipError_t e = hipLaunchCooperativeKernel((const void*)mk_fwd, dim3(grid), dim3(512), args, LDS_BYTES, stream);
    if (e != hipSuccess) fprintf(stderr, "kernel_launch: cooperative launch failed: %s (grid %d)\n", hipGetErrorString(e), grid);
#else
    for (int k = 0; k < NPHASE; ++k) { p.ph_lo = k; p.ph_hi = k + 1; hipLaunchKernelGGL(mk_fwd, dim3(grid), dim3(512), LDS_BYTES, stream, p); }
#endif
}
```
